# Optimizing an MI355X kernel written in HIP

```python
import math
import jax, jax.numpy as jnp
from jax import lax
import numpy as np

D_MODEL = 1024
BATCH = 8
SEQ = 2048
DEPTH = 1
DEC_BATCH = 128
DEC_SEQ = 1
PAST_LEN = 16384
PAGE_SIZE = 128

HEAD_A = 64
C_A = D_MODEL // 2
H_A = C_A // HEAD_A
LORA_W = 64
LORA_A = 64
LORA_G = 128
A_COLS = 3 * C_A + LORA_W + LORA_A + LORA_G
DK = 128
DV = 128
H_B = (D_MODEL // 2) // DV
C_BK = H_B * DK
C_BV = H_B * DV
CONV_W = 4
CONV_CH = 2 * C_BK + C_BV
B_COLS = CONV_CH + C_BV + 2 * H_B
GDN_CHUNK = 64
IN_COLS = A_COLS + B_COLS + 2 * D_MODEL
D_FF = -(-8 * D_MODEL // (3 * 256)) * 256
PLE_DIM = 256
NORM_EPS = 1e-6
GN_EPS = 64e-5

kernel_name = "rwkv7_gdn_gated_hybrid_step"


def rmsnorm(x, gain):
    xf = x.astype(jnp.float32)
    y = xf * lax.rsqrt(jnp.mean(xf * xf, axis=-1, keepdims=True) + NORM_EPS)
    return (y * gain.astype(jnp.float32)).astype(x.dtype)


def l2norm(x):
    return x * lax.rsqrt(jnp.sum(x * x, axis=-1, keepdims=True) + 1e-6)


def rwkv7_scan(r, decay, k, v, a_in, b_in, s0):
    def step(S, inp):
        r_t, w_t, k_t, v_t, a_t, b_t = inp
        sa = jnp.einsum('bhvk,bhk->bhv', S, a_t)
        S = S * w_t[:, :, None, :] + sa[..., None] * b_t[:, :, None, :] + v_t[..., None] * k_t[:, :, None, :]
        return S, jnp.einsum('bhvk,bhk->bhv', S, r_t)
    xs = tuple(jnp.moveaxis(t, 1, 0) for t in (r, decay, k, v, a_in, b_in))
    S, ys = lax.scan(step, s0, xs)
    return jnp.moveaxis(ys, 0, 1), S


def gated_delta_chunked(q, k, v, g, beta, s0):
    Bn, T, H, _ = q.shape
    V = v.shape[-1]
    C = min(GDN_CHUNK, T)
    n = -(-T // C)
    pad = n * C - T

    def blocks(t):
        t = jnp.pad(t, [(0, 0), (0, pad)] + [(0, 0)] * (t.ndim - 2))
        t = t.reshape((Bn, n, C) + t.shape[2:])
        return jnp.moveaxis(jnp.moveaxis(t, 1, 0), 3, 2)

    q, k, v, g, beta = (blocks(t) for t in (q, k, v, g, beta))
    gc = jnp.cumsum(g, axis=-1)
    tril = jnp.tril(jnp.ones((C, C), bool))
    strict = jnp.tril(jnp.ones((C, C), bool), -1)
    diff = gc[..., :, None] - gc[..., None, :]
    decay = jnp.where(tril, jnp.exp(jnp.where(tril, diff, 0.0)), 0.0)
    kb = k * beta[..., None]
    vb = v * beta[..., None]
    lmat = jnp.where(strict, jnp.einsum('nbhik,nbhjk->nbhij', kb, k) * decay, 0.0)
    eye = jnp.eye(C, dtype=lmat.dtype)
    tinv = lax.linalg.triangular_solve(eye + lmat, jnp.broadcast_to(eye, lmat.shape),
                                       left_side=True, lower=True, unit_diagonal=True)
    u = tinv @ vb
    w = tinv @ (kb * jnp.exp(gc)[..., None])
    qk = jnp.where(tril, jnp.einsum('nbhik,nbhjk->nbhij', q, k) * decay, 0.0)
    qg = q * jnp.exp(gc)[..., None]
    kd = k * jnp.exp(gc[..., -1:] - gc)[..., None]
    glast = jnp.exp(gc[..., -1])

    def step(S, inp):
        u_c, w_c, qk_c, qg_c, kd_c, gl_c = inp
        v_new = u_c - w_c @ S
        o = qg_c @ S + qk_c @ v_new
        S = S * gl_c[..., None, None] + jnp.einsum('bhck,bhcv->bhkv', kd_c, v_new)
        return S, o

    S, o = lax.scan(step, s0, (u, w, qk, qg, kd, glast))
    o = jnp.swapaxes(jnp.moveaxis(o, 0, 1), 2, 3).reshape(Bn, n * C, H, V)[:, :T]
    return o, S


def hybrid_layer(h, pe, shift0, wkv0, conv0, gdn0,
                 norm_mix, w_in, mu_shift, rw_w0, rw_w2, rw_a0, rw_a2, rw_g2, rw_kk, rw_ka, rw_rk,
                 rw_ln_w, rw_ln_b, gdn_conv, gdn_a_log, gdn_dt_bias, gdn_norm,
                 w_branch_a, w_branch_b, w_out, norm_ffn, w_ffn_gate, w_ffn_up, w_ffn_down,
                 norm_ple, w_ple_gate, w_ple_proj):
    f32 = jnp.float32
    Bn, T, _ = h.shape
    act = h.dtype
    u = rmsnorm(h, norm_mix)
    proj = u @ w_in
    pa = proj[..., :A_COLS]
    pb = proj[..., A_COLS:A_COLS + B_COLS]
    pg = proj[..., A_COLS + B_COLS:]

    prev = jnp.concatenate([shift0.astype(act), pa[:, :-1]], axis=1)
    xa = (pa + (prev - pa) * mu_shift).astype(f32)
    new_shift = pa[:, -1:].astype(shift0.dtype)
    r, k, v, xw, xaa, xg = jnp.split(
        xa, [C_A, 2 * C_A, 3 * C_A, 3 * C_A + LORA_W, 3 * C_A + LORA_W + LORA_A], axis=-1)
    w_log = -jax.nn.softplus(-(rw_w0 + jnp.tanh(xw) @ rw_w2)) - 0.5
    decay = jnp.exp(-jnp.exp(w_log))
    a = jax.nn.sigmoid(rw_a0 + xaa @ rw_a2)
    g = jax.nn.sigmoid(xg) @ rw_g2
    heads = lambda t: t.reshape(Bn, T, H_A, HEAD_A)
    kk = l2norm(heads(k * rw_kk))
    k = k * (1.0 + (a - 1.0) * rw_ka)
    rh, kh, vh = heads(r), heads(k), heads(v)
    y, wkv = rwkv7_scan(rh, heads(decay), kh, vh, -kk, kk * heads(a), wkv0.astype(f32))
    mean = jnp.mean(y, axis=-1, keepdims=True)
    var = jnp.mean(jnp.square(y - mean), axis=-1, keepdims=True)
    yn = ((y - mean) * lax.rsqrt(var + GN_EPS)).reshape(Bn, T, C_A) * rw_ln_w + rw_ln_b
    bonus = (jnp.sum(rh * kh * rw_rk, axis=-1, keepdims=True) * vh).reshape(Bn, T, C_A)
    o_a = (yn + bonus) * g

    qkv = pb[..., :CONV_CH].astype(f32)
    z = pb[..., CONV_CH:CONV_CH + C_BV].astype(f32)
    b_raw = pb[..., CONV_CH + C_BV:CONV_CH + C_BV + H_B].astype(f32)
    a_raw = pb[..., CONV_CH + C_BV + H_B:].astype(f32)
    xp = jnp.concatenate([conv0.astype(f32), qkv], axis=1)
    acc = xp[:, :T] * gdn_conv[0]
    for j in range(1, CONV_W):
        acc = acc + xp[:, j:j + T] * gdn_conv[j]
    c = jax.nn.silu(acc)
    new_conv = xp[:, T:].astype(conv0.dtype)
    qb = l2norm(c[..., :C_BK].reshape(Bn, T, H_B, DK)) * (DK ** -0.5)
    kb_ = l2norm(c[..., C_BK:2 * C_BK].reshape(Bn, T, H_B, DK))
    vb_ = c[..., 2 * C_BK:].reshape(Bn, T, H_B, DV)
    beta = jax.nn.sigmoid(b_raw)
    glog = -jnp.exp(gdn_a_log.astype(f32)) * jax.nn.softplus(a_raw + gdn_dt_bias)
    ob, gdn = gated_delta_chunked(qb, kb_, vb_, glog, beta, gdn0.astype(f32))
    ob = ob * lax.rsqrt(jnp.mean(ob * ob, axis=-1, keepdims=True) + NORM_EPS) * gdn_norm
    o_b = (ob * jax.nn.silu(z.reshape(Bn, T, H_B, DV))).reshape(Bn, T, C_BV)

    gate_a = jax.nn.sigmoid(pg[..., :D_MODEL])
    gate_b = jax.nn.sigmoid(pg[..., D_MODEL:])
    mix = gate_a * (o_a.astype(act) @ w_branch_a) + gate_b * (o_b.astype(act) @ w_branch_b)
    h = h + mix @ w_out

    u2 = rmsnorm(h, norm_ffn)
    h = h + (jax.nn.silu(u2 @ w_ffn_gate) * (u2 @ w_ffn_up)) @ w_ffn_down

    h = h + jax.nn.sigmoid(rmsnorm(h, norm_ple) @ w_ple_gate) * (pe.astype(act) @ w_ple_proj)
    return h, new_shift, wkv.astype(wkv0.dtype), new_conv, gdn.astype(gdn0.dtype)


def setup_inputs(seed: int = 0) -> dict:
    key = jax.random.key(seed)
    ks = iter(jax.random.split(key, 48))
    nrm = lambda shape, s: jax.random.normal(next(ks), shape, jnp.float32) * s
    unif = lambda shape, lo, hi: jax.random.uniform(next(ks), shape, jnp.float32, lo, hi)
    L = DEPTH
    dt_init = jnp.exp(unif((L, H_B), math.log(1e-3), math.log(1e-1)))
    return {
        'x_prompt': nrm((BATCH, SEQ, D_MODEL), 1.0),
        'x_sample': nrm((DEC_BATCH, DEC_SEQ, D_MODEL), 1.0),
        'p_prompt': nrm((L, BATCH, SEQ, PLE_DIM), 1.0),
        'p_sample': nrm((L, DEC_BATCH, DEC_SEQ, PLE_DIM), 1.0),
        'state_shift': nrm((L, DEC_BATCH, 1, A_COLS), 1.0),
        'state_wkv': nrm((L, DEC_BATCH, H_A, HEAD_A, HEAD_A), 0.5),
        'state_conv': nrm((L, DEC_BATCH, CONV_W - 1, CONV_CH), 1.0),
        'state_gdn': nrm((L, DEC_BATCH, H_B, DK, DV), 0.5),
        'norm_mix': 1.0 + nrm((L, D_MODEL), 0.01),
        'w_in': nrm((L, D_MODEL, IN_COLS), D_MODEL ** -0.5),
        'mu_shift': unif((L, A_COLS), 0.0, 1.0),
        'rw_w0': unif((L, C_A), -6.0, -1.0),
        'rw_w2': nrm((L, LORA_W, C_A), 0.1),
        'rw_a0': nrm((L, C_A), 0.1),
        'rw_a2': nrm((L, LORA_A, C_A), 0.5 * LORA_A ** -0.5),
        'rw_g2': nrm((L, LORA_G, C_A), LORA_G ** -0.5),
        'rw_kk': 0.85 + nrm((L, C_A), 0.02),
        'rw_ka': 1.0 + nrm((L, C_A), 0.02),
        'rw_rk': nrm((L, H_A, HEAD_A), 0.1),
        'rw_ln_w': 1.0 + nrm((L, C_A), 0.01),
        'rw_ln_b': nrm((L, C_A), 0.01),
        'gdn_conv': nrm((L, CONV_W, CONV_CH), 0.5),
        'gdn_a_log': jnp.log(unif((L, H_B), 1.0, 16.0)),
        'gdn_dt_bias': dt_init + jnp.log(-jnp.expm1(-dt_init)),
        'gdn_norm': 1.0 + nrm((L, DV), 0.01),
        'w_branch_a': nrm((L, C_A, D_MODEL), C_A ** -0.5),
        'w_branch_b': nrm((L, C_BV, D_MODEL), C_BV ** -0.5),
        'w_out': nrm((L, D_MODEL, D_MODEL), D_MODEL ** -0.5),
        'norm_ffn': 1.0 + nrm((L, D_MODEL), 0.01),
        'w_ffn_gate': nrm((L, D_MODEL, D_FF), D_MODEL ** -0.5),
        'w_ffn_up': nrm((L, D_MODEL, D_FF), D_MODEL ** -0.5),
        'w_ffn_down': nrm((L, D_FF, D_MODEL), D_FF ** -0.5),
        'norm_ple': 1.0 + nrm((L, D_MODEL), 0.01),
        'w_ple_gate': nrm((L, D_MODEL, D_MODEL), D_MODEL ** -0.5),
        'w_ple_proj': nrm((L, PLE_DIM, D_MODEL), PLE_DIM ** -0.5),
        'norm_final': 1.0 + nrm((D_MODEL,), 0.01),
    }


def reference(x_prompt, x_sample, p_prompt, p_sample, state_shift, state_wkv, state_conv, state_gdn,
              norm_mix, w_in, mu_shift, rw_w0, rw_w2, rw_a0, rw_a2, rw_g2, rw_kk, rw_ka, rw_rk,
              rw_ln_w, rw_ln_b, gdn_conv, gdn_a_log, gdn_dt_bias, gdn_norm,
              w_branch_a, w_branch_b, w_out, norm_ffn, w_ffn_gate, w_ffn_up, w_ffn_down,
              norm_ple, w_ple_gate, w_ple_proj, norm_final):
    hp, hs = x_prompt, x_sample
    bp = x_prompt.shape[0]
    st_p, st_s = [], []
    for i in range(DEPTH):
        lw = (norm_mix[i], w_in[i], mu_shift[i], rw_w0[i], rw_w2[i], rw_a0[i], rw_a2[i], rw_g2[i],
              rw_kk[i], rw_ka[i], rw_rk[i], rw_ln_w[i], rw_ln_b[i], gdn_conv[i], gdn_a_log[i],
              gdn_dt_bias[i], gdn_norm[i], w_branch_a[i], w_branch_b[i], w_out[i], norm_ffn[i],
              w_ffn_gate[i], w_ffn_up[i], w_ffn_down[i], norm_ple[i], w_ple_gate[i], w_ple_proj[i])
        z_shift = jnp.zeros((bp, 1, A_COLS), state_shift.dtype)
        z_wkv = jnp.zeros((bp, H_A, HEAD_A, HEAD_A), state_wkv.dtype)
        z_conv = jnp.zeros((bp, CONV_W - 1, CONV_CH), state_conv.dtype)
        z_gdn = jnp.zeros((bp, H_B, DK, DV), state_gdn.dtype)
        hp, *sp = hybrid_layer(hp, p_prompt[i], z_shift, z_wkv, z_conv, z_gdn, *lw)
        hs, *ss = hybrid_layer(hs, p_sample[i], state_shift[i], state_wkv[i], state_conv[i], state_gdn[i], *lw)
        st_p.append(sp)
        st_s.append(ss)
    y_prompt = rmsnorm(hp, norm_final)
    y_sample = rmsnorm(hs, norm_final)
    shift_prompt = jnp.stack([s[0] for s in st_p])
    wkv_prompt = jnp.stack([s[1] for s in st_p])
    conv_prompt = jnp.stack([s[2] for s in st_p])
    gdn_prompt = jnp.stack([s[3] for s in st_p])
    shift_sample = jnp.stack([s[0] for s in st_s])
    wkv_sample = jnp.stack([s[1] for s in st_s])
    conv_sample = jnp.stack([s[2] for s in st_s])
    gdn_sample = jnp.stack([s[3] for s in st_s])
    return (y_prompt, y_sample, shift_prompt, wkv_prompt, conv_prompt, gdn_prompt,
            shift_sample, wkv_sample, conv_sample, gdn_sample)
```

```cpp
#include <hip/hip_runtime.h>
#include <hip/hip_bf16.h>
#include <hip/hip_cooperative_groups.h>
#include <cstdio>
namespace cg = cooperative_groups;

typedef unsigned short u16;
using bf16x8 = __attribute__((ext_vector_type(8))) short;
using u16x4 = __attribute__((ext_vector_type(4))) unsigned short;
using f32x4 = __attribute__((ext_vector_type(4))) float;

constexpr int D = 1024, NP = 16384, NS = 128, MR = NP + NS;
constexpr int SEQ = 2048;
constexpr int A_COLS = 1792, PCOLS = 3848;
constexpr int IN_COLS = 5896, DFF = 2816;
constexpr float NORM_EPS = 1e-6f, GN_EPS = 64e-5f;

constexpr long OUT_Y = 0;
constexpr long OUT_SHIFT_P = (long)MR * D;
constexpr long OUT_WKV_P = OUT_SHIFT_P + 8 * 1792;
constexpr long OUT_CONV_P = OUT_WKV_P + 8L * 8 * 64 * 64;
constexpr long OUT_GDN_P = OUT_CONV_P + 8 * 3 * 1536;
constexpr long OUT_SHIFT_S = OUT_GDN_P + 8L * 4 * 128 * 128;
constexpr long OUT_WKV_S = OUT_SHIFT_S + 128 * 1792;
constexpr long OUT_CONV_S = OUT_WKV_S + 128L * 8 * 64 * 64;
constexpr long OUT_GDN_S = OUT_CONV_S + 128 * 3 * 1536;

constexpr size_t OFF_WINT = 0;
constexpr size_t OFF_WGI = OFF_WINT + (size_t)PCOLS * 1024 * 2;
constexpr size_t OFF_W2T = OFF_WGI + (size_t)2048 * 1024 * 2;
constexpr size_t OFF_A2T = OFF_W2T + 512 * 64 * 2;
constexpr size_t OFF_G2T = OFF_A2T + 512 * 64 * 2;
constexpr size_t OFF_WAT = OFF_G2T + 512 * 128 * 2;
constexpr size_t OFF_WBT = OFF_WAT + 1024 * 512 * 2;
constexpr size_t OFF_WOT = OFF_WBT + 1024 * 512 * 2;
constexpr size_t OFF_WGU = OFF_WOT + 1024 * 1024 * 2;
constexpr size_t OFF_WDT = OFF_WGU + (size_t)5632 * 1024 * 2;
constexpr size_t OFF_WPG = OFF_WDT + (size_t)1024 * 2816 * 2;
constexpr size_t OFF_WPP = OFF_WPG + 1024 * 1024 * 2;
constexpr size_t OFF_U = OFF_WPP + 1024 * 256 * 2;
constexpr size_t OFF_PROJ = OFF_U + (size_t)MR * 1024 * 2;
constexpr size_t OFF_DA = OFF_PROJ + (size_t)MR * PCOLS * 2;
constexpr size_t OFF_DE = OFF_DA + (size_t)MR * 512 * 2;
constexpr size_t OFF_DG = OFF_DE + (size_t)MR * 512 * 2;
constexpr size_t OFF_QK = OFF_DG + (size_t)MR * 512 * 2;
constexpr size_t OFF_LIN = OFF_QK + (size_t)1024 * 64 * 64 * 2;
constexpr size_t OFF_RSS = OFF_LIN + (size_t)MR * 256 * 2;
constexpr size_t OFF_AB = OFF_RSS + (size_t)3 * MR * 4;
constexpr size_t OFF_GL = OFF_AB + (size_t)MR * 8 * 4;
constexpr size_t OFF_END = OFF_GL + 4096;
constexpr size_t OFF_ACT = OFF_PROJ;
constexpr size_t OFF_PP = OFF_PROJ + (size_t)MR * DFF * 2;
static_assert(OFF_PP + (size_t)MR * 1024 * 2 <= OFF_DA, "pp overflow");
static_assert(OFF_END <= 268435456ull, "ws overflow");
constexpr size_t EO_UT = 0, EO_WN = 16777216, EO_QG = 33554432, EO_KDT = 50331648;

struct Params { const float* in[36]; float* out; unsigned char* ws; };

extern __shared__ __attribute__((aligned(16))) unsigned char smem[];
constexpr int LDS_BYTES = 71680;

__device__ __forceinline__ u16 f2bf(float f) { unsigned u = __float_as_uint(f); u += 0x7fffu + ((u >> 16) & 1u); return (u16)(u >> 16); }
__device__ __forceinline__ float bf2f(u16 h) { return __uint_as_float(((unsigned)h) << 16); }
__device__ __forceinline__ float sigmoidf_(float x) { return 1.f / (1.f + __expf(-x)); }
__device__ __forceinline__ float siluf_(float x) { return x / (1.f + __expf(-x)); }
__device__ __forceinline__ float softplusf_(float x) { return fmaxf(x, 0.f) + log1pf(__expf(-fabsf(x))); }
__device__ __forceinline__ float quad_sum(float x) {
  x += __int_as_float(__builtin_amdgcn_update_dpp(0, __float_as_int(x), 0xB1, 0xF, 0xF, true));
  x += __int_as_float(__builtin_amdgcn_update_dpp(0, __float_as_int(x), 0x4E, 0xF, 0xF, true));
  return x;
}
__device__ __forceinline__ float sum16(float x) {
  x += __shfl_xor(x, 1); x += __shfl_xor(x, 2); x += __shfl_xor(x, 4); x += __shfl_xor(x, 8); return x;
}
__device__ __forceinline__ float sum64(float x) { x = sum16(x); x += __shfl_xor(x, 16); x += __shfl_xor(x, 32); return x; }
__device__ __forceinline__ const float* xrow(const Params& p, int row) {
  return row < NP ? p.in[0] + (size_t)row * D : p.in[1] + (size_t)(row - NP) * D;
}

__device__ __forceinline__ void gemm_mainloop(const u16* __restrict__ A, long lda, const u16* __restrict__ Bt, long ldb, int K,
                                              f32x4 (&acc)[4][4]) {
  const int tid = threadIdx.x, lane = tid & 63, wid = tid >> 6, wr = wid >> 1, wc = wid & 1, fr = lane & 15, fq = lane >> 4;
  u16* SA = (u16*)smem; u16* SB = SA + 4096;
#pragma unroll
  for (int m = 0; m < 4; ++m)
#pragma unroll
    for (int n = 0; n < 4; ++n) acc[m][n] = f32x4{0.f, 0.f, 0.f, 0.f};
  const int nk = K >> 5;
  for (int kt = 0; kt < nk; ++kt) {
#pragma unroll
    for (int i = 0; i < 2; ++i) {
      const int b = tid * 16 + i * 4096, r = b >> 6, c = (b & 63) >> 1;
      __builtin_amdgcn_global_load_lds((const unsigned*)(A + (long)r * lda + kt * 32 + c), (unsigned*)((char*)SA + b), 16, 0, 0);
      __builtin_amdgcn_global_load_lds((const unsigned*)(Bt + (long)r * ldb + kt * 32 + c), (unsigned*)((char*)SB + b), 16, 0, 0);
    }
    asm volatile("s_waitcnt vmcnt(0)" ::: "memory");
    __syncthreads();
    bf16x8 a[4], b[4];
#pragma unroll
    for (int m = 0; m < 4; ++m) a[m] = *reinterpret_cast<const bf16x8*>((char*)SA + (wr * 64 + m * 16 + fr) * 64 + fq * 16);
#pragma unroll
    for (int n = 0; n < 4; ++n) b[n] = *reinterpret_cast<const bf16x8*>((char*)SB + (wc * 64 + n * 16 + fr) * 64 + fq * 16);
#pragma unroll
    for (int m = 0; m < 4; ++m)
#pragma unroll
      for (int n = 0; n < 4; ++n) acc[m][n] = __builtin_amdgcn_mfma_f32_16x16x32_bf16(a[m], b[n], acc[m][n], 0, 0, 0);
    __syncthreads();
  }
}
#define EPI_COORDS const int tid_ = threadIdx.x, lane_ = tid_ & 63, wid_ = tid_ >> 6, wr_ = wid_ >> 1, wc_ = wid_ & 1, fr_ = lane_ & 15, fq_ = lane_ >> 4; (void)wc_; (void)wr_; (void)fr_; (void)fq_;

struct TJob { const float* src; int ld_src; int K; int N; u16* dst; int ld_dst; int ilv; };
__device__ __forceinline__ TJob get_job(const Params& p, int j) {
  unsigned char* ws = p.ws; TJob t;
  switch (j) {
    case 0: t = TJob{p.in[9], IN_COLS, 1024, PCOLS, (u16*)(ws + OFF_WINT), 1024, 0}; break;
    case 1: t = TJob{p.in[9] + PCOLS, IN_COLS, 1024, 1024, (u16*)(ws + OFF_WGI), 1024, 1}; break;
    case 2: t = TJob{p.in[9] + PCOLS + 1024, IN_COLS, 1024, 1024, (u16*)(ws + OFF_WGI), 1024, 2}; break;
    case 3: t = TJob{p.in[12], 512, 64, 512, (u16*)(ws + OFF_W2T), 64, 0}; break;
    case 4: t = TJob{p.in[14], 512, 64, 512, (u16*)(ws + OFF_A2T), 64, 0}; break;
    case 5: t = TJob{p.in[15], 512, 128, 512, (u16*)(ws + OFF_G2T), 128, 0}; break;
    case 6: t = TJob{p.in[25], 1024, 512, 1024, (u16*)(ws + OFF_WAT), 512, 0}; break;
    case 7: t = TJob{p.in[26], 1024, 512, 1024, (u16*)(ws + OFF_WBT), 512, 0}; break;
    case 8: t = TJob{p.in[27], 1024, 1024, 1024, (u16*)(ws + OFF_WOT), 1024, 0}; break;
    case 9: t = TJob{p.in[29], DFF, 1024, DFF, (u16*)(ws + OFF_WGU), 1024, 1}; break;
    case 10: t = TJob{p.in[30], DFF, 1024, DFF, (u16*)(ws + OFF_WGU), 1024, 2}; break;
    case 11: t = TJob{p.in[31], 1024, DFF, 1024, (u16*)(ws + OFF_WDT), DFF, 0}; break;
    case 12: t = TJob{p.in[33], 1024, 1024, 1024, (u16*)(ws + OFF_WPG), 1024, 0}; break;
    default: t = TJob{p.in[34], 1024, 256, 1024, (u16*)(ws + OFF_WPP), 256, 0}; break;
  }
  return t;
}
__device__ __forceinline__ int job_tiles(const TJob& t) { return (t.K >> 6) * ((t.N + 63) >> 6); }

__device__ __forceinline__ void phase_prep(const Params& p) {
  const int tid = threadIdx.x;
  float* T = (float*)smem;
  int total = 0;
  for (int j = 0; j < 14; ++j) { TJob t = get_job(p, j); total += job_tiles(t); }
  for (int g = blockIdx.x; g < total; g += gridDim.x) {
    int j = 0, rem = g; TJob t = get_job(p, 0);
    for (;;) { int nt_ = job_tiles(t); if (rem < nt_) break; rem -= nt_; ++j; t = get_job(p, j); }
    const int nkt = t.K >> 6; const int kt = rem % nkt, nt = rem / nkt;
#pragma unroll
    for (int i = 0; i < 4; ++i) {
      const int k = (tid >> 4) + 16 * i, n4 = (tid & 15) * 4, n = nt * 64 + n4;
      float4 v = make_float4(0.f, 0.f, 0.f, 0.f);
      if (n < t.N) v = *reinterpret_cast<const float4*>(t.src + (long)(kt * 64 + k) * t.ld_src + n);
      T[k * 65 + n4 + 0] = v.x; T[k * 65 + n4 + 1] = v.y; T[k * 65 + n4 + 2] = v.z; T[k * 65 + n4 + 3] = v.w;
    }
    __syncthreads();
    {
      const int nl = tid >> 2, kq = (tid & 3) * 16, n = nt * 64 + nl;
      if (n < t.N) {
        const int drow = t.ilv ? ((((n >> 4) * 2 + (t.ilv - 1)) << 4) + (n & 15)) : n;
        bf16x8 o0, o1;
#pragma unroll
        for (int q = 0; q < 8; ++q) { o0[q] = (short)f2bf(T[(kq + q) * 65 + nl]); o1[q] = (short)f2bf(T[(kq + 8 + q) * 65 + nl]); }
        u16* d = t.dst + (long)drow * t.ld_dst + kt * 64 + kq;
        *reinterpret_cast<bf16x8*>(d) = o0; *reinterpret_cast<bf16x8*>(d + 8) = o1;
      }
    }
    __syncthreads();
  }
  {
    const int lane = tid & 63, gw = blockIdx.x * 4 + (tid >> 6), nw = gridDim.x * 4;
    u16* U = (u16*)(p.ws + OFF_U);
    const float* gain = p.in[8];
    for (int row = gw; row < MR; row += nw) {
      const float* x = xrow(p, row);
      float4 v[4]; float ss = 0.f;
#pragma unroll
      for (int i = 0; i < 4; ++i) { v[i] = *reinterpret_cast<const float4*>(x + i * 256 + lane * 4); ss += v[i].x * v[i].x + v[i].y * v[i].y + v[i].z * v[i].z + v[i].w * v[i].w; }
      ss = sum64(ss);
      const float rs = rsqrtf(ss * (1.f / 1024.f) + NORM_EPS);
#pragma unroll
      for (int i = 0; i < 4; ++i) {
        const float4 g4 = *reinterpret_cast<const float4*>(gain + i * 256 + lane * 4);
        u16x4 o; o[0] = f2bf(v[i].x * rs * g4.x); o[1] = f2bf(v[i].y * rs * g4.y); o[2] = f2bf(v[i].z * rs * g4.z); o[3] = f2bf(v[i].w * rs * g4.w);
        *reinterpret_cast<u16x4*>(U + (size_t)row * 1024 + i * 256 + lane * 4) = o;
      }
    }
  }
  {
    float* rss = (float*)(p.ws + OFF_RSS);
    const int gt = blockIdx.x * 256 + tid, nt = gridDim.x * 256;
    for (int i = gt; i < 3 * MR; i += nt) rss[i] = 0.f;
    const float* sc = p.in[6];
    for (int i = gt; i < 128 * 2 * 1536; i += nt) {
      const int b = i / 3072, r = i - b * 3072;
      p.out[OUT_CONV_S + (long)b * 4608 + r] = sc[(long)b * 4608 + 1536 + r];
    }
  }
}

__device__ __forceinline__ void phase_proj(const Params& p) {
  const u16* U = (const u16*)(p.ws + OFF_U); const u16* W = (const u16*)(p.ws + OFF_WINT);
  u16* PJ = (u16*)(p.ws + OFF_PROJ); float* AB = (float*)(p.ws + OFF_AB);
  constexpr int NCT = 31, NRT = MR / 128;
  for (int t = blockIdx.x; t < NCT * NRT; t += gridDim.x) {
    const int ct = t % NCT, rt = t / NCT; const int row0 = rt * 128, col0 = ct * 128;
    f32x4 acc[4][4];
    gemm_mainloop(U + (size_t)row0 * 1024, 1024, W + (size_t)col0 * 1024, 1024, 1024, acc);
    EPI_COORDS
#pragma unroll
    for (int m = 0; m < 4; ++m)
#pragma unroll
      for (int j = 0; j < 4; ++j) {
        const int row = row0 + wr_ * 64 + m * 16 + fq_ * 4 + j;
        int shift_b = -1; long shift_off = 0; int conv_j = -1; long conv_off = 0;
        if (row < NP) { const int tt = row & (SEQ - 1), b = row >> 11; if (tt == SEQ - 1) { shift_b = b; shift_off = OUT_SHIFT_P + (long)b * 1792; }
                        if (tt >= SEQ - 3) { conv_j = tt - (SEQ - 3); conv_off = OUT_CONV_P + ((long)b * 3 + conv_j) * 1536; } }
        else { const int b = row - NP; shift_b = b; shift_off = OUT_SHIFT_S + (long)b * 1792; conv_j = 2; conv_off = OUT_CONV_S + ((long)b * 3 + 2) * 1536; }
#pragma unroll
        for (int n = 0; n < 4; ++n) {
          const int col = col0 + wc_ * 64 + n * 16 + fr_;
          const float v = acc[m][n][j];
          if (col < PCOLS) {
            PJ[(size_t)row * PCOLS + col] = f2bf(v);
            if (col >= 3840) AB[(size_t)row * 8 + (col - 3840)] = v;
            if (shift_b >= 0 && col < A_COLS) p.out[shift_off + col] = v;
            if (conv_j >= 0 && col >= A_COLS && col < A_COLS + 1536) p.out[conv_off + (col - A_COLS)] = v;
          }
        }
      }
  }
}

__device__ __forceinline__ void phase_lora_in(const Params& p) {
  const u16* PJ = (const u16*)(p.ws + OFF_PROJ); u16* LIN = (u16*)(p.ws + OFF_LIN);
  const float* mu = p.in[10]; const float* sh = p.in[4];
  const int gt = blockIdx.x * 256 + threadIdx.x, nt = gridDim.x * 256;
  for (int i = gt; i < MR * 64; i += nt) {
    const int row = i >> 6, c4 = (i & 63) * 4, col = 1536 + c4;
    const u16x4 cur = *reinterpret_cast<const u16x4*>(PJ + (size_t)row * PCOLS + col);
    float pv[4];
    if (row < NP) {
      if ((row & (SEQ - 1)) > 0) { const u16x4 pr = *reinterpret_cast<const u16x4*>(PJ + (size_t)(row - 1) * PCOLS + col); for (int q = 0; q < 4; ++q) pv[q] = bf2f(pr[q]); }
      else { for (int q = 0; q < 4; ++q) pv[q] = 0.f; }
    } else { const float4 s4 = *reinterpret_cast<const float4*>(sh + (size_t)(row - NP) * 1792 + col); pv[0] = s4.x; pv[1] = s4.y; pv[2] = s4.z; pv[3] = s4.w; }
    const float4 m4 = *reinterpret_cast<const float4*>(mu + col);
    const float mm[4] = {m4.x, m4.y, m4.z, m4.w};
    u16x4 o;
#pragma unroll
    for (int q = 0; q < 4; ++q) {
      const float c = bf2f(cur[q]); float x = c + (pv[q] - c) * mm[q];
      if (c4 < 64) x = tanhf(x); else if (c4 >= 128) x = sigmoidf_(x);
      o[q] = f2bf(x);
    }
    *reinterpret_cast<u16x4*>(LIN + (size_t)row * 256 + c4) = o;
  }
}

__device__ __forceinline__ void gdn_prep_item(const Params& p, int item) {
  const int tid = threadIdx.x, lane = tid & 63, wid = tid >> 6, fr = lane & 15, fq = lane >> 4;
  const int n = item & 31, h = (item >> 5) & 3, b = item >> 7;
  const int rowb = b * SEQ + n * 64;
  const u16* PJ = (const u16*)(p.ws + OFF_PROJ);
  u16* qs = (u16*)smem; u16* ks = qs + 64 * 136; u16* vs = ks + 64 * 136;
  float* Ls = (float*)(smem + 3 * 64 * 136 * 2);
  float* gcs = Ls + 64 * 64; float* betas = gcs + 64; float* egcs = betas + 64;
  const float* cw = p.in[21];
  for (int it = tid; it < 64 * 48; it += 256) {
    const int t = it / 48, cg8 = it - t * 48; const int which = cg8 >> 4, cc = (cg8 & 15) * 8;
    const int ch = which * 512 + h * 128 + cc;
    float acc8[8];
#pragma unroll
    for (int q = 0; q < 8; ++q) acc8[q] = 0.f;
#pragma unroll
    for (int j = 0; j < 4; ++j) {
      const int tt = n * 64 + t - 3 + j;
      if (tt >= 0) {
        const bf16x8 xv = *reinterpret_cast<const bf16x8*>(PJ + (size_t)(b * SEQ + tt) * PCOLS + A_COLS + ch);
        const float4 w0 = *reinterpret_cast<const float4*>(cw + j * 1536 + ch), w1 = *reinterpret_cast<const float4*>(cw + j * 1536 + ch + 4);
        const float wv[8] = {w0.x, w0.y, w0.z, w0.w, w1.x, w1.y, w1.z, w1.w};
#pragma unroll
        for (int q = 0; q < 8; ++q) acc8[q] += bf2f((u16)xv[q]) * wv[q];
      }
    }
    bf16x8 o;
#pragma unroll
    for (int q = 0; q < 8; ++q) o[q] = (short)f2bf(siluf_(acc8[q]));
    u16* dst = (which == 0 ? qs : (which == 1 ? ks : vs)) + t * 136 + cc;
    *reinterpret_cast<bf16x8*>(dst) = o;
  }
  if (wid == 0) {
    const float* AB = (const float*)(p.ws + OFF_AB) + (size_t)(rowb + lane) * 8;
    const float braw = AB[h], araw = AB[4 + h];
    const float g = -__expf(p.in[22][h]) * softplusf_(araw + p.in[23][h]);
    float c = g;
#pragma unroll
    for (int o = 1; o < 64; o <<= 1) { const float up = __shfl_up(c, o); if (lane >= o) c += up; }
    gcs[lane] = c; betas[lane] = sigmoidf_(braw); egcs[lane] = __expf(c);
  }
  __syncthreads();
  {
    const int r = tid >> 2, part = tid & 3;
#pragma unroll
    for (int w2 = 0; w2 < 2; ++w2) {
      u16* base = (w2 == 0 ? qs : ks) + r * 136 + part * 32;
      float v[32]; float ss = 0.f;
#pragma unroll
      for (int q8 = 0; q8 < 4; ++q8) { const bf16x8 x = *reinterpret_cast<const bf16x8*>(base + q8 * 8);
#pragma unroll
        for (int q = 0; q < 8; ++q) { v[q8 * 8 + q] = bf2f((u16)x[q]); ss += v[q8 * 8 + q] * v[q8 * 8 + q]; } }
      ss = quad_sum(ss);
      const float sc = rsqrtf(ss + 1e-6f) * (w2 == 0 ? 0.08838834764831845f : 1.f);
#pragma unroll
      for (int q8 = 0; q8 < 4; ++q8) { bf16x8 o;
#pragma unroll
        for (int q = 0; q < 8; ++q) o[q] = (short)f2bf(v[q8 * 8 + q] * sc);
        *reinterpret_cast<bf16x8*>(base + q8 * 8) = o; }
    }
  }
  __syncthreads();
  {
    f32x4 aL[4], aQ[4];
#pragma unroll
    for (int nt = 0; nt < 4; ++nt) { aL[nt] = f32x4{0.f, 0.f, 0.f, 0.f}; aQ[nt] = f32x4{0.f, 0.f, 0.f, 0.f}; }
#pragma unroll
    for (int kk = 0; kk < 4; ++kk) {
      const bf16x8 ak = *reinterpret_cast<const bf16x8*>((char*)ks + (wid * 16 + fr) * 272 + kk * 64 + fq * 16);
      const bf16x8 aq = *reinterpret_cast<const bf16x8*>((char*)qs + (wid * 16 + fr) * 272 + kk * 64 + fq * 16);
#pragma unroll
      for (int nt = 0; nt < 4; ++nt) {
        const bf16x8 bk = *reinterpret_cast<const bf16x8*>((char*)ks + (nt * 16 + fr) * 272 + kk * 64 + fq * 16);
        aL[nt] = __builtin_amdgcn_mfma_f32_16x16x32_bf16(ak, bk, aL[nt], 0, 0, 0);
        aQ[nt] = __builtin_amdgcn_mfma_f32_16x16x32_bf16(aq, bk, aQ[nt], 0, 0, 0);
      }
    }
    u16* QK = (u16*)(p.ws + OFF_QK) + (size_t)item * 4096;
#pragma unroll
    for (int nt = 0; nt < 4; ++nt)
#pragma unroll
      for (int j = 0; j < 4; ++j) {
        const int i = wid * 16 + fq * 4 + j, jc = nt * 16 + fr;
        const float dec = (i >= jc) ? __expf(gcs[i] - gcs[jc]) : 0.f;
        Ls[i * 64 + jc] = (i > jc) ? betas[i] * aL[nt][j] * dec : 0.f;
        QK[i * 64 + jc] = f2bf(aQ[nt][j] * dec);
      }
  }
  __syncthreads();
  const size_t ebase = (size_t)item * 8192;
  u16* EUT = (u16*)((unsigned char*)p.out + EO_UT) + ebase; u16* EWN = (u16*)((unsigned char*)p.out + EO_WN) + ebase;
  u16* EQG = (u16*)((unsigned char*)p.out + EO_QG) + ebase; u16* EKD = (u16*)((unsigned char*)p.out + EO_KDT) + ebase;
  {
    float X[64];
    const bool isv = tid < 128; const u16* src = isv ? (vs + tid) : (ks + (tid - 128));
#pragma unroll
    for (int i = 0; i < 64; ++i) { float r = bf2f(src[i * 136]) * betas[i]; if (!isv) r *= egcs[i]; X[i] = r; }
#pragma unroll
    for (int i = 1; i < 64; ++i) {
      float s = X[i];
#pragma unroll
      for (int j4 = 0; j4 < (i + 3) / 4; ++j4) {
        const float4 l = *reinterpret_cast<const float4*>(Ls + i * 64 + j4 * 4);
        s -= l.x * X[4 * j4]; s -= l.y * X[4 * j4 + 1]; s -= l.z * X[4 * j4 + 2]; s -= l.w * X[4 * j4 + 3];
      }
      X[i] = s;
    }
    if (isv) {
#pragma unroll
      for (int q8 = 0; q8 < 8; ++q8) { bf16x8 o;
#pragma unroll
        for (int q = 0; q < 8; ++q) o[q] = (short)f2bf(X[q8 * 8 + q]);
        *reinterpret_cast<bf16x8*>(EUT + tid * 64 + q8 * 8) = o; }
    } else {
#pragma unroll
      for (int i = 0; i < 64; ++i) EWN[i * 128 + (tid - 128)] = f2bf(-X[i]);
    }
  }
  {
    const int i = tid >> 2, k0 = (tid & 3) * 32; const float eg = egcs[i];
#pragma unroll
    for (int q8 = 0; q8 < 4; ++q8) { const bf16x8 x = *reinterpret_cast<const bf16x8*>(qs + i * 136 + k0 + q8 * 8); bf16x8 o;
#pragma unroll
      for (int q = 0; q < 8; ++q) o[q] = (short)f2bf(bf2f((u16)x[q]) * eg);
      *reinterpret_cast<bf16x8*>(EQG + i * 128 + k0 + q8 * 8) = o; }
    const int k = tid >> 1, i0 = (tid & 1) * 32; const float gl = gcs[63];
#pragma unroll
    for (int q8 = 0; q8 < 4; ++q8) { bf16x8 o;
#pragma unroll
      for (int q = 0; q < 8; ++q) { const int ii = i0 + q8 * 8 + q; o[q] = (short)f2bf(bf2f(ks[ii * 136 + k]) * __expf(gl - gcs[ii])); }
      *reinterpret_cast<bf16x8*>(EKD + k * 64 + i0 + q8 * 8) = o; }
    if (tid == 0) ((float*)(p.ws + OFF_GL))[item] = __expf(gl);
  }
  __syncthreads();
}

__device__ __forceinline__ void phase_lora(const Params& p) {
  const u16* LIN = (const u16*)(p.ws + OFF_LIN);
  constexpr int NRT = MR / 128;
  for (int t = blockIdx.x; t < 3 * 4 * NRT; t += gridDim.x) {
    const int which = t / (4 * NRT), r2 = t - which * 4 * NRT; const int ct = r2 & 3, rt = r2 >> 2;
    const int row0 = rt * 128, col0 = ct * 128;
    f32x4 acc[4][4];
    const u16* A; const u16* Bt; int K; u16* O; const float* bias;
    if (which == 0) { A = LIN; Bt = (const u16*)(p.ws + OFF_W2T); K = 64; O = (u16*)(p.ws + OFF_DE); bias = p.in[11]; }
    else if (which == 1) { A = LIN + 64; Bt = (const u16*)(p.ws + OFF_A2T); K = 64; O = (u16*)(p.ws + OFF_DA); bias = p.in[13]; }
    else { A = LIN + 128; Bt = (const u16*)(p.ws + OFF_G2T); K = 128; O = (u16*)(p.ws + OFF_DG); bias = p.in[13]; }
    gemm_mainloop(A + (size_t)row0 * 256, 256, Bt + (size_t)col0 * K, K, K, acc);
    EPI_COORDS
#pragma unroll
    for (int n = 0; n < 4; ++n) {
      const int col = col0 + wc_ * 64 + n * 16 + fr_; const float bs = bias[col];
#pragma unroll
      for (int m = 0; m < 4; ++m)
#pragma unroll
        for (int j = 0; j < 4; ++j) {
          const int row = row0 + wr_ * 64 + m * 16 + fq_ * 4 + j; float v = acc[m][n][j];
          if (which == 0) { const float z = bs + v; v = __expf(-softplusf_(-z) - 0.5f); }
          else if (which == 1) v = sigmoidf_(bs + v);
          O[(size_t)row * 512 + col] = f2bf(v);
        }
    }
  }
}

struct RwRaw { u16x4 r, k, v, pr, pk, pv, e, a, g; float4 sr, sk, sv; };
template <bool samp>
__device__ __forceinline__ void rwkv_chain(const Params& p, int seq, int h) {
  const int tid = threadIdx.x;
  constexpr int T = samp ? 1 : SEQ; const int rowb = samp ? NP + (seq - 8) : seq * SEQ;
  const u16* PJ = (const u16*)(p.ws + OFF_PROJ); u16* DA = (u16*)(p.ws + OFF_DA);
  const u16* DE = (const u16*)(p.ws + OFF_DE); const u16* DG = (const u16*)(p.ws + OFF_DG);
  float* buf = (float*)smem;
  float* ybuf = buf + 2 * 16 * 384;
  const int vrow = tid >> 2, part = tid & 3;
  const int tt = tid >> 4, jg = (tid & 15) * 4, ch = h * 64 + jg;
  float S[16];
  if (samp) { const float* s0 = p.in[5] + ((size_t)(seq - 8) * 8 + h) * 4096 + vrow * 64 + part * 16;
#pragma unroll
    for (int q = 0; q < 4; ++q) { const float4 x = *reinterpret_cast<const float4*>(s0 + q * 4); S[q * 4] = x.x; S[q * 4 + 1] = x.y; S[q * 4 + 2] = x.z; S[q * 4 + 3] = x.w; } }
  else {
#pragma unroll
    for (int q = 0; q < 16; ++q) S[q] = 0.f; }
  const float4 mur = *reinterpret_cast<const float4*>(p.in[10] + ch), muk = *reinterpret_cast<const float4*>(p.in[10] + 512 + ch), muv = *reinterpret_cast<const float4*>(p.in[10] + 1024 + ch);
  const float4 ckk = *reinterpret_cast<const float4*>(p.in[16] + ch), cka = *reinterpret_cast<const float4*>(p.in[17] + ch), crk = *reinterpret_cast<const float4*>(p.in[18] + ch);
  const float4 lnw = *reinterpret_cast<const float4*>(p.in[19] + ch), lnb = *reinterpret_cast<const float4*>(p.in[20] + ch);
  constexpr int nchunks = (T + 15) >> 4;
  auto load_raw = [&](int c, RwRaw& R) {
    const int t = c * 16 + tt;
    if (t < T) {
      const size_t ro = (size_t)(rowb + t) * PCOLS;
      R.r = *reinterpret_cast<const u16x4*>(PJ + ro + ch); R.k = *reinterpret_cast<const u16x4*>(PJ + ro + 512 + ch); R.v = *reinterpret_cast<const u16x4*>(PJ + ro + 1024 + ch);
      if (t > 0) { const size_t po = ro - PCOLS; R.pr = *reinterpret_cast<const u16x4*>(PJ + po + ch); R.pk = *reinterpret_cast<const u16x4*>(PJ + po + 512 + ch); R.pv = *reinterpret_cast<const u16x4*>(PJ + po + 1024 + ch); }
      else if (samp) { const float* sh = p.in[4] + (size_t)(seq - 8) * 1792; R.sr = *reinterpret_cast<const float4*>(sh + ch); R.sk = *reinterpret_cast<const float4*>(sh + 512 + ch); R.sv = *reinterpret_cast<const float4*>(sh + 1024 + ch); }
      const size_t lo = (size_t)(rowb + t) * 512 + ch;
      R.e = *reinterpret_cast<const u16x4*>(DE + lo); R.a = *reinterpret_cast<const u16x4*>(DA + lo); R.g = *reinterpret_cast<const u16x4*>(DG + lo);
    }
  };
  auto prep_write = [&](int c, const RwRaw& R) {
    const int t = c * 16 + tt;
    if (t < T) {
      float r4[4], k4[4], v4[4], pr4[4], pk4[4], pv4[4];
      const float mr[4] = {mur.x, mur.y, mur.z, mur.w}, mk[4] = {muk.x, muk.y, muk.z, muk.w}, mv[4] = {muv.x, muv.y, muv.z, muv.w};
      const float kkc[4] = {ckk.x, ckk.y, ckk.z, ckk.w}, kac[4] = {cka.x, cka.y, cka.z, cka.w};
      if (t > 0) { for (int q = 0; q < 4; ++q) { pr4[q] = bf2f(R.pr[q]); pk4[q] = bf2f(R.pk[q]); pv4[q] = bf2f(R.pv[q]); } }
      else if (samp) { pr4[0] = R.sr.x; pr4[1] = R.sr.y; pr4[2] = R.sr.z; pr4[3] = R.sr.w; pk4[0] = R.sk.x; pk4[1] = R.sk.y; pk4[2] = R.sk.z; pk4[3] = R.sk.w; pv4[0] = R.sv.x; pv4[1] = R.sv.y; pv4[2] = R.sv.z; pv4[3] = R.sv.w; }
      else { for (int q = 0; q < 4; ++q) { pr4[q] = 0.f; pk4[q] = 0.f; pv4[q] = 0.f; } }
      float kr[4], ss = 0.f, a4[4], w4[4];
#pragma unroll
      for (int q = 0; q < 4; ++q) {
        const float cr = bf2f(R.r[q]), ck = bf2f(R.k[q]), cv = bf2f(R.v[q]);
        r4[q] = cr + (pr4[q] - cr) * mr[q]; k4[q] = ck + (pk4[q] - ck) * mk[q]; v4[q] = cv + (pv4[q] - cv) * mv[q];
        kr[q] = k4[q] * kkc[q]; ss += kr[q] * kr[q];
        a4[q] = bf2f(R.a[q]); w4[q] = __expf(-bf2f(R.e[q]));
      }
      ss = sum16(ss);
      const float rn = rsqrtf(ss + 1e-6f);
      float* dst = buf + ((c & 1) * 16 + tt) * 384 + jg;
      float4 o;
      o = make_float4(w4[0], w4[1], w4[2], w4[3]); *reinterpret_cast<float4*>(dst) = o;
      o = make_float4(-kr[0] * rn, -kr[1] * rn, -kr[2] * rn, -kr[3] * rn); *reinterpret_cast<float4*>(dst + 64) = o;
      o = make_float4(kr[0] * rn * a4[0], kr[1] * rn * a4[1], kr[2] * rn * a4[2], kr[3] * rn * a4[3]); *reinterpret_cast<float4*>(dst + 128) = o;
      o = make_float4(k4[0] * (1.f + (a4[0] - 1.f) * kac[0]), k4[1] * (1.f + (a4[1] - 1.f) * kac[1]), k4[2] * (1.f + (a4[2] - 1.f) * kac[2]), k4[3] * (1.f + (a4[3] - 1.f) * kac[3]));
      *reinterpret_cast<float4*>(dst + 192) = o;
      o = make_float4(r4[0], r4[1], r4[2], r4[3]); *reinterpret_cast<float4*>(dst + 256) = o;
      o = make_float4(v4[0], v4[1], v4[2], v4[3]); *reinterpret_cast<float4*>(dst + 320) = o;
    }
  };
  RwRaw R; load_raw(0, R);
  for (int c = 0; c < nchunks; ++c) {
    prep_write(c, R);
    const u16x4 gcur = R.g;
    if (c + 1 < nchunks) load_raw(c + 1, R);
    __syncthreads();
    const int nsteps = min(16, T - c * 16);
    const float* cb = buf + (c & 1) * 16 * 384;
#pragma unroll 2
    for (int s = 0; s < nsteps; ++s) {
      const float* sb = cb + s * 384 + part * 16;
      float w[16], a[16], bb[16], kk[16], rr[16];
#pragma unroll
      for (int q = 0; q < 4; ++q) {
        const float4 x0 = *reinterpret_cast<const float4*>(sb + q * 4); w[q * 4] = x0.x; w[q * 4 + 1] = x0.y; w[q * 4 + 2] = x0.z; w[q * 4 + 3] = x0.w;
        const float4 x1 = *reinterpret_cast<const float4*>(sb + 64 + q * 4); a[q * 4] = x1.x; a[q * 4 + 1] = x1.y; a[q * 4 + 2] = x1.z; a[q * 4 + 3] = x1.w;
        const float4 x2 = *reinterpret_cast<const float4*>(sb + 128 + q * 4); bb[q * 4] = x2.x; bb[q * 4 + 1] = x2.y; bb[q * 4 + 2] = x2.z; bb[q * 4 + 3] = x2.w;
        const float4 x3 = *reinterpret_cast<const float4*>(sb + 192 + q * 4); kk[q * 4] = x3.x; kk[q * 4 + 1] = x3.y; kk[q * 4 + 2] = x3.z; kk[q * 4 + 3] = x3.w;
        const float4 x4 = *reinterpret_cast<const float4*>(sb + 256 + q * 4); rr[q * 4] = x4.x; rr[q * 4 + 1] = x4.y; rr[q * 4 + 2] = x4.z; rr[q * 4 + 3] = x4.w;
      }
      const float vv = cb[s * 384 + 320 + vrow];
      float s0 = 0.f, s1 = 0.f, s2 = 0.f, s3 = 0.f;
#pragma unroll
      for (int q = 0; q < 4; ++q) { s0 += S[q * 4] * a[q * 4]; s1 += S[q * 4 + 1] * a[q * 4 + 1]; s2 += S[q * 4 + 2] * a[q * 4 + 2]; s3 += S[q * 4 + 3] * a[q * 4 + 3]; }
      const float sa = quad_sum((s0 + s1) + (s2 + s3));
      float y0 = 0.f, y1 = 0.f, y2 = 0.f, y3 = 0.f;
#pragma unroll
      for (int q = 0; q < 16; ++q) S[q] = fmaf(sa, bb[q], fmaf(S[q], w[q], vv * kk[q]));
#pragma unroll
      for (int q = 0; q < 4; ++q) { y0 += S[q * 4] * rr[q * 4]; y1 += S[q * 4 + 1] * rr[q * 4 + 1]; y2 += S[q * 4 + 2] * rr[q * 4 + 2]; y3 += S[q * 4 + 3] * rr[q * 4 + 3]; }
      const float y = quad_sum((y0 + y1) + (y2 + y3));
      if (part == 0) ybuf[s * 64 + vrow] = y;
    }
    __syncthreads();
    {
      const int t = c * 16 + tt;
      if (t < T) {
        const float4 y4 = *reinterpret_cast<const float4*>(ybuf + tt * 64 + jg);
        const float* tb = cb + tt * 384 + jg;
        const float4 kq = *reinterpret_cast<const float4*>(tb + 192), rq = *reinterpret_cast<const float4*>(tb + 256), vq = *reinterpret_cast<const float4*>(tb + 320);
        const float mean = sum16(y4.x + y4.y + y4.z + y4.w) * (1.f / 64.f);
        const float d0 = y4.x - mean, d1 = y4.y - mean, d2 = y4.z - mean, d3 = y4.w - mean;
        const float var = sum16(d0 * d0 + d1 * d1 + d2 * d2 + d3 * d3) * (1.f / 64.f);
        const float rstd = rsqrtf(var + GN_EPS);
        const float dot = sum16(rq.x * kq.x * crk.x + rq.y * kq.y * crk.y + rq.z * kq.z * crk.z + rq.w * kq.w * crk.w);
        u16x4 o;
        o[0] = f2bf((d0 * rstd * lnw.x + lnb.x + dot * vq.x) * bf2f(gcur[0]));
        o[1] = f2bf((d1 * rstd * lnw.y + lnb.y + dot * vq.y) * bf2f(gcur[1]));
        o[2] = f2bf((d2 * rstd * lnw.z + lnb.z + dot * vq.z) * bf2f(gcur[2]));
        o[3] = f2bf((d3 * rstd * lnw.w + lnb.w + dot * vq.w) * bf2f(gcur[3]));
        *reinterpret_cast<u16x4*>(DA + (size_t)(rowb + t) * 512 + ch) = o;
      }
    }
  }
  {
    float* so = p.out + (samp ? OUT_WKV_S + ((size_t)(seq - 8) * 8 + h) * 4096 : OUT_WKV_P + ((size_t)seq * 8 + h) * 4096) + vrow * 64 + part * 16;
#pragma unroll
    for (int q = 0; q < 4; ++q) *reinterpret_cast<float4*>(so + q * 4) = make_float4(S[q * 4], S[q * 4 + 1], S[q * 4 + 2], S[q * 4 + 3]);
  }
  __syncthreads();
}

__device__ __forceinline__ void gdn_scan_chain(const Params& p, int b, int h) {
  const int tid = threadIdx.x, lane = tid & 63, w = tid >> 6, fr = lane & 15, fq = lane >> 4;
  unsigned char* St = smem;
  unsigned char* Vt = smem + 128 * 272;
  u16* PJ = (u16*)(p.ws + OFF_PROJ);
  const float* gnorm = p.in[24];
  f32x4 Sacc[2][8];
#pragma unroll
  for (int m = 0; m < 2; ++m)
#pragma unroll
    for (int nt = 0; nt < 8; ++nt) Sacc[m][nt] = f32x4{0.f, 0.f, 0.f, 0.f};
  for (int i = tid; i < 128 * 272 / 16; i += 256) *reinterpret_cast<f32x4*>(St + i * 16) = f32x4{0.f, 0.f, 0.f, 0.f};
  __syncthreads();
  float gn[8];
#pragma unroll
  for (int nt = 0; nt < 8; ++nt) gn[nt] = gnorm[nt * 16 + fr];
  for (int n = 0; n < 32; ++n) {
    const int item = (b * 4 + h) * 32 + n; const size_t eb = (size_t)item * 8192;
    const u16* EUT = (const u16*)((const unsigned char*)p.out + EO_UT) + eb; const u16* EWN = (const u16*)((const unsigned char*)p.out + EO_WN) + eb;
    const u16* EQG = (const u16*)((const unsigned char*)p.out + EO_QG) + eb; const u16* EKD = (const u16*)((const unsigned char*)p.out + EO_KDT) + eb;
    const u16* QK = (const u16*)(p.ws + OFF_QK) + (size_t)item * 4096;
    const float gl = ((const float*)(p.ws + OFF_GL))[item];
    bf16x8 wn[4], qg[4], qk[2], kd[2][2];
#pragma unroll
    for (int kk = 0; kk < 4; ++kk) { wn[kk] = *reinterpret_cast<const bf16x8*>(EWN + (w * 16 + fr) * 128 + kk * 32 + fq * 8); qg[kk] = *reinterpret_cast<const bf16x8*>(EQG + (w * 16 + fr) * 128 + kk * 32 + fq * 8); }
#pragma unroll
    for (int k2 = 0; k2 < 2; ++k2) { qk[k2] = *reinterpret_cast<const bf16x8*>(QK + (w * 16 + fr) * 64 + k2 * 32 + fq * 8);
#pragma unroll
      for (int m = 0; m < 2; ++m) kd[m][k2] = *reinterpret_cast<const bf16x8*>(EKD + (w * 32 + m * 16 + fr) * 64 + k2 * 32 + fq * 8); }
    f32x4 Vacc[8], Oacc[8];
#pragma unroll
    for (int nt = 0; nt < 8; ++nt) {
      const u16x4 u4 = *reinterpret_cast<const u16x4*>(EUT + (nt * 16 + fr) * 64 + w * 16 + fq * 4);
      Vacc[nt] = f32x4{bf2f(u4[0]), bf2f(u4[1]), bf2f(u4[2]), bf2f(u4[3])}; Oacc[nt] = f32x4{0.f, 0.f, 0.f, 0.f};
    }
#pragma unroll
    for (int nt = 0; nt < 8; ++nt)
#pragma unroll
      for (int kk = 0; kk < 4; ++kk) {
        const bf16x8 sb = *reinterpret_cast<const bf16x8*>(St + (nt * 16 + fr) * 272 + kk * 64 + fq * 16);
        Vacc[nt] = __builtin_amdgcn_mfma_f32_16x16x32_bf16(wn[kk], sb, Vacc[nt], 0, 0, 0);
        Oacc[nt] = __builtin_amdgcn_mfma_f32_16x16x32_bf16(qg[kk], sb, Oacc[nt], 0, 0, 0);
      }
#pragma unroll
    for (int nt = 0; nt < 8; ++nt) {
      u16x4 o; o[0] = f2bf(Vacc[nt][0]); o[1] = f2bf(Vacc[nt][1]); o[2] = f2bf(Vacc[nt][2]); o[3] = f2bf(Vacc[nt][3]);
      *reinterpret_cast<u16x4*>(Vt + (nt * 16 + fr) * 144 + (w * 16 + fq * 4) * 2) = o;
    }
    __syncthreads();
#pragma unroll
    for (int m = 0; m < 2; ++m)
#pragma unroll
      for (int nt = 0; nt < 8; ++nt) Sacc[m][nt] *= gl;
#pragma unroll
    for (int nt = 0; nt < 8; ++nt)
#pragma unroll
      for (int k2 = 0; k2 < 2; ++k2) {
        const bf16x8 vb = *reinterpret_cast<const bf16x8*>(Vt + (nt * 16 + fr) * 144 + k2 * 64 + fq * 16);
        Oacc[nt] = __builtin_amdgcn_mfma_f32_16x16x32_bf16(qk[k2], vb, Oacc[nt], 0, 0, 0);
        Sacc[0][nt] = __builtin_amdgcn_mfma_f32_16x16x32_bf16(kd[0][k2], vb, Sacc[0][nt], 0, 0, 0);
        Sacc[1][nt] = __builtin_amdgcn_mfma_f32_16x16x32_bf16(kd[1][k2], vb, Sacc[1][nt], 0, 0, 0);
      }
#pragma unroll
    for (int m = 0; m < 2; ++m)
#pragma unroll
      for (int nt = 0; nt < 8; ++nt) {
        u16x4 o; o[0] = f2bf(Sacc[m][nt][0]); o[1] = f2bf(Sacc[m][nt][1]); o[2] = f2bf(Sacc[m][nt][2]); o[3] = f2bf(Sacc[m][nt][3]);
        *reinterpret_cast<u16x4*>(St + (nt * 16 + fr) * 272 + (w * 32 + m * 16 + fq * 4) * 2) = o;
      }
    {
      float ss[4] = {0.f, 0.f, 0.f, 0.f};
#pragma unroll
      for (int nt = 0; nt < 8; ++nt)
#pragma unroll
        for (int j = 0; j < 4; ++j) ss[j] += Oacc[nt][j] * Oacc[nt][j];
#pragma unroll
      for (int j = 0; j < 4; ++j) {
        const float rs = rsqrtf(sum16(ss[j]) * (1.f / 128.f) + NORM_EPS);
        const int row = b * SEQ + n * 64 + w * 16 + fq * 4 + j;
        u16* zp = PJ + (size_t)row * PCOLS + 3328 + h * 128;
#pragma unroll
        for (int nt = 0; nt < 8; ++nt) { const int v = nt * 16 + fr; const float z = bf2f(zp[v]); zp[v] = f2bf(Oacc[nt][j] * rs * gn[nt] * siluf_(z)); }
      }
    }
    __syncthreads();
  }
  float* so = p.out + OUT_GDN_P + ((size_t)b * 4 + h) * 16384;
#pragma unroll
  for (int m = 0; m < 2; ++m)
#pragma unroll
    for (int nt = 0; nt < 8; ++nt)
#pragma unroll
      for (int j = 0; j < 4; ++j) so[(w * 32 + m * 16 + fq * 4 + j) * 128 + nt * 16 + fr] = Sacc[m][nt][j];
}

__device__ __forceinline__ void gdn_sample_item(const Params& p, int b, int h) {
  const int tid = threadIdx.x, lane = tid & 63;
  float* cs = (float*)smem;
  float* red = cs + 384;
  float* sc = red + 512;
  const int row = NP + b;
  const u16* PJ = (const u16*)(p.ws + OFF_PROJ);
  const float* st = p.in[6] + (size_t)b * 4608; const float* cw = p.in[21];
  for (int i = tid; i < 384; i += 256) {
    const int which = i >> 7, c = i & 127, ch = which * 512 + h * 128 + c;
    float acc = st[ch] * cw[ch] + st[1536 + ch] * cw[1536 + ch] + st[3072 + ch] * cw[3072 + ch] + bf2f(PJ[(size_t)row * PCOLS + A_COLS + ch]) * cw[4608 + ch];
    cs[i] = siluf_(acc);
  }
  __syncthreads();
  if (tid < 128) {
    const int which = tid >> 6;
    const float x0 = cs[which * 128 + lane], x1 = cs[which * 128 + 64 + lane];
    const float ss = sum64(x0 * x0 + x1 * x1);
    const float s = rsqrtf(ss + 1e-6f) * (which == 0 ? 0.08838834764831845f : 1.f);
    cs[which * 128 + lane] = x0 * s; cs[which * 128 + 64 + lane] = x1 * s;
  }
  if (tid == 128) {
    const float* AB = (const float*)(p.ws + OFF_AB) + (size_t)row * 8;
    sc[0] = sigmoidf_(AB[h]); sc[1] = __expf(-__expf(p.in[22][h]) * softplusf_(AB[4 + h] + p.in[23][h]));
  }
  __syncthreads();
  if (tid < 64) { const float d = sum64(cs[lane] * cs[128 + lane] + cs[64 + lane] * cs[192 + lane]); if (lane == 0) sc[2] = d; }
  const int v = tid & 127, kh = tid >> 7;
  const float* S0 = p.in[7] + ((size_t)b * 4 + h) * 16384;
  float S[64]; float ks = 0.f, qs = 0.f;
#pragma unroll
  for (int k = 0; k < 64; ++k) { S[k] = S0[(kh * 64 + k) * 128 + v]; ks += cs[128 + kh * 64 + k] * S[k]; qs += cs[kh * 64 + k] * S[k]; }
  red[kh * 128 + v] = ks; red[256 + kh * 128 + v] = qs;
  __syncthreads();
  const float beta = sc[0], eg = sc[1], qk = sc[2];
  const float kS = red[v] + red[128 + v], qS = red[256 + v] + red[384 + v];
  const float vnew = beta * (cs[256 + v] - eg * kS);
  const float o = eg * qS + qk * vnew;
  float* so = p.out + OUT_GDN_S + ((size_t)b * 4 + h) * 16384;
#pragma unroll
  for (int k = 0; k < 64; ++k) so[(kh * 64 + k) * 128 + v] = S[k] * eg + cs[128 + kh * 64 + k] * vnew;
  __syncthreads();
  if (tid < 128) red[tid] = o * o;
  __syncthreads();
  if (tid < 64) { const float s = sum64(red[lane] + red[64 + lane]); if (lane == 0) sc[3] = s; }
  __syncthreads();
  if (tid < 128) {
    const float rs = rsqrtf(sc[3] * (1.f / 128.f) + NORM_EPS);
    u16* zp = (u16*)(p.ws + OFF_PROJ) + (size_t)row * PCOLS + 3328 + h * 128 + v;
    const float z = bf2f(*zp);
    *zp = f2bf(o * rs * p.in[24][v] * siluf_(z));
  }
  __syncthreads();
}

__device__ __forceinline__ void phase_branches(const Params& p) {
  constexpr int NRT = MR / 128;
  u16* PA = (u16*)(p.ws + OFF_DE); u16* PB = (u16*)p.out;
  for (int t = blockIdx.x; t < 2 * 8 * NRT; t += gridDim.x) {
    const int which = t / (8 * NRT), r2 = t - which * 8 * NRT; const int ct = r2 & 7, rt = r2 >> 3;
    const int row0 = rt * 128, col0 = ct * 128;
    f32x4 acc[4][4];
    if (which == 0) gemm_mainloop((const u16*)(p.ws + OFF_DA) + (size_t)row0 * 512, 512, (const u16*)(p.ws + OFF_WAT) + (size_t)col0 * 512, 512, 512, acc);
    else gemm_mainloop((const u16*)(p.ws + OFF_PROJ) + (size_t)row0 * PCOLS + 3328, PCOLS, (const u16*)(p.ws + OFF_WBT) + (size_t)col0 * 512, 512, 512, acc);
    u16* O = which == 0 ? PA : PB;
    EPI_COORDS
#pragma unroll
    for (int m = 0; m < 4; ++m)
#pragma unroll
      for (int j = 0; j < 4; ++j) {
        const int row = row0 + wr_ * 64 + m * 16 + fq_ * 4 + j;
#pragma unroll
        for (int n = 0; n < 4; ++n) O[(size_t)row * 1024 + col0 + wc_ * 64 + n * 16 + fr_] = f2bf(acc[m][n][j]);
      }
  }
  u16* PE = (u16*)(p.ws + OFF_LIN);
  const int gt = blockIdx.x * 256 + threadIdx.x, nt = gridDim.x * 256;
  for (int i = gt; i < MR * 64; i += nt) {
    const int row = i >> 6, c4 = (i & 63) * 4;
    const float* src = row < NP ? p.in[2] + (size_t)row * 256 : p.in[3] + (size_t)(row - NP) * 256;
    const float4 v = *reinterpret_cast<const float4*>(src + c4);
    u16x4 o; o[0] = f2bf(v.x); o[1] = f2bf(v.y); o[2] = f2bf(v.z); o[3] = f2bf(v.w);
    *reinterpret_cast<u16x4*>(PE + (size_t)row * 256 + c4) = o;
  }
}
__device__ __forceinline__ void phase_gates(const Params& p) {
  constexpr int NRT = MR / 128;
  u16* PA = (u16*)(p.ws + OFF_DE); const u16* PB = (const u16*)p.out;
  for (int t = blockIdx.x; t < 16 * NRT; t += gridDim.x) {
    const int ct = t & 15, rt = t >> 4; const int row0 = rt * 128, col0 = ct * 128;
    f32x4 acc[4][4];
    gemm_mainloop((const u16*)(p.ws + OFF_U) + (size_t)row0 * 1024, 1024, (const u16*)(p.ws + OFF_WGI) + (size_t)col0 * 1024, 1024, 1024, acc);
    EPI_COORDS
#pragma unroll
    for (int m = 0; m < 4; ++m)
#pragma unroll
      for (int j = 0; j < 4; ++j) {
        const int row = row0 + wr_ * 64 + m * 16 + fq_ * 4 + j;
#pragma unroll
        for (int q = 0; q < 2; ++q) {
          const int col = (col0 + wc_ * 64) / 2 + q * 16 + fr_;
          const size_t o = (size_t)row * 1024 + col;
          PA[o] = f2bf(sigmoidf_(acc[m][2 * q][j]) * bf2f(PA[o]) + sigmoidf_(acc[m][2 * q + 1][j]) * bf2f(PB[o]));
        }
      }
  }
}
__device__ __forceinline__ void phase_wout(const Params& p) {
  constexpr int NRT = MR / 128;
  u16* HG = (u16*)(p.ws + OFF_U); float* rss = (float*)(p.ws + OFF_RSS); const float* gain = p.in[28];
  for (int t = blockIdx.x; t < 8 * NRT; t += gridDim.x) {
    const int ct = t & 7, rt = t >> 3; const int row0 = rt * 128, col0 = ct * 128;
    f32x4 acc[4][4];
    gemm_mainloop((const u16*)(p.ws + OFF_DE) + (size_t)row0 * 1024, 1024, (const u16*)(p.ws + OFF_WOT) + (size_t)col0 * 1024, 1024, 1024, acc);
    EPI_COORDS
#pragma unroll
    for (int m = 0; m < 4; ++m)
#pragma unroll
      for (int j = 0; j < 4; ++j) {
        const int row = row0 + wr_ * 64 + m * 16 + fq_ * 4 + j; const float* xr = xrow(p, row); float ss = 0.f;
#pragma unroll
        for (int n = 0; n < 4; ++n) {
          const int col = col0 + wc_ * 64 + n * 16 + fr_;
          const float hv = xr[col] + acc[m][n][j];
          p.out[(size_t)row * 1024 + col] = hv; HG[(size_t)row * 1024 + col] = f2bf(hv * gain[col]); ss += hv * hv;
        }
        ss = sum16(ss);
        if (fr_ == 0) atomicAdd(rss + row, ss);
      }
  }
}
__device__ __forceinline__ void phase_ffn_up(const Params& p) {
  constexpr int NRT = MR / 128;
  u16* ACT = (u16*)(p.ws + OFF_ACT); const float* rss = (const float*)(p.ws + OFF_RSS);
  for (int t = blockIdx.x; t < 44 * NRT; t += gridDim.x) {
    const int ct = t % 44, rt = t / 44; const int row0 = rt * 128, col0 = ct * 128;
    f32x4 acc[4][4];
    gemm_mainloop((const u16*)(p.ws + OFF_U) + (size_t)row0 * 1024, 1024, (const u16*)(p.ws + OFF_WGU) + (size_t)col0 * 1024, 1024, 1024, acc);
    EPI_COORDS
#pragma unroll
    for (int m = 0; m < 4; ++m)
#pragma unroll
      for (int j = 0; j < 4; ++j) {
        const int row = row0 + wr_ * 64 + m * 16 + fq_ * 4 + j;
        const float rs = rsqrtf(rss[row] * (1.f / 1024.f) + NORM_EPS);
#pragma unroll
        for (int q = 0; q < 2; ++q) {
          const int col = (col0 + wc_ * 64) / 2 + q * 16 + fr_;
          ACT[(size_t)row * DFF + col] = f2bf(siluf_(rs * acc[m][2 * q][j]) * (rs * acc[m][2 * q + 1][j]));
        }
      }
  }
}
__device__ __forceinline__ void phase_ffn_down(const Params& p) {
  constexpr int NRT = MR / 128;
  u16* HG = (u16*)(p.ws + OFF_U); float* rss = (float*)(p.ws + OFF_RSS) + MR; const float* gain = p.in[32];
  u16* PP = (u16*)(p.ws + OFF_PP);
  for (int t = blockIdx.x; t < 16 * NRT; t += gridDim.x) {
    const int which = t / (8 * NRT), r2 = t - which * 8 * NRT; const int ct = r2 & 7, rt = r2 >> 3; const int row0 = rt * 128, col0 = ct * 128;
    f32x4 acc[4][4];
    if (which == 0) {
      gemm_mainloop((const u16*)(p.ws + OFF_ACT) + (size_t)row0 * DFF, DFF, (const u16*)(p.ws + OFF_WDT) + (size_t)col0 * DFF, DFF, DFF, acc);
      EPI_COORDS
#pragma unroll
      for (int m = 0; m < 4; ++m)
#pragma unroll
        for (int j = 0; j < 4; ++j) {
          const int row = row0 + wr_ * 64 + m * 16 + fq_ * 4 + j; float ss = 0.f;
#pragma unroll
          for (int n = 0; n < 4; ++n) {
            const int col = col0 + wc_ * 64 + n * 16 + fr_; const size_t o = (size_t)row * 1024 + col;
            const float hv = p.out[o] + acc[m][n][j];
            p.out[o] = hv; HG[o] = f2bf(hv * gain[col]); ss += hv * hv;
          }
          ss = sum16(ss);
          if (fr_ == 0) atomicAdd(rss + row, ss);
        }
    } else {
      gemm_mainloop((const u16*)(p.ws + OFF_LIN) + (size_t)row0 * 256, 256, (const u16*)(p.ws + OFF_WPP) + (size_t)col0 * 256, 256, 256, acc);
      EPI_COORDS
#pragma unroll
      for (int m = 0; m < 4; ++m)
#pragma unroll
        for (int j = 0; j < 4; ++j) {
          const int row = row0 + wr_ * 64 + m * 16 + fq_ * 4 + j;
#pragma unroll
          for (int n = 0; n < 4; ++n) PP[(size_t)row * 1024 + col0 + wc_ * 64 + n * 16 + fr_] = f2bf(acc[m][n][j]);
        }
    }
  }
}
__device__ __forceinline__ void phase_ple(const Params& p) {
  constexpr int NRT = MR / 128;
  const float* rss2 = (const float*)(p.ws + OFF_RSS) + MR; float* rss3 = (float*)(p.ws + OFF_RSS) + 2 * MR;
  const u16* PP = (const u16*)(p.ws + OFF_PP);
  for (int t = blockIdx.x; t < 8 * NRT; t += gridDim.x) {
    const int ct = t & 7, rt = t >> 3; const int row0 = rt * 128, col0 = ct * 128;
    f32x4 acc[4][4];
    gemm_mainloop((const u16*)(p.ws + OFF_U) + (size_t)row0 * 1024, 1024, (const u16*)(p.ws + OFF_WPG) + (size_t)col0 * 1024, 1024, 1024, acc);
    EPI_COORDS
#pragma unroll
    for (int m = 0; m < 4; ++m)
#pragma unroll
      for (int j = 0; j < 4; ++j) {
        const int row = row0 + wr_ * 64 + m * 16 + fq_ * 4 + j; float ss = 0.f;
        const float rs = rsqrtf(rss2[row] * (1.f / 1024.f) + NORM_EPS);
#pragma unroll
        for (int n = 0; n < 4; ++n) {
          const int col = col0 + wc_ * 64 + n * 16 + fr_; const size_t o = (size_t)row * 1024 + col;
          const float hv = p.out[o] + sigmoidf_(rs * acc[m][n][j]) * bf2f(PP[o]);
          p.out[o] = hv; ss += hv * hv;
        }
        ss = sum16(ss);
        if (fr_ == 0) atomicAdd(rss3 + row, ss);
      }
  }
}
__device__ __forceinline__ void phase_final(const Params& p) {
  const float* rss3 = (const float*)(p.ws + OFF_RSS) + 2 * MR; const float* gain = p.in[35];
  const int gt = blockIdx.x * 256 + threadIdx.x, nt = gridDim.x * 256;
  for (int i = gt; i < MR * 256; i += nt) {
    const int row = i >> 8, c4 = (i & 255) * 4;
    const float rs = rsqrtf(rss3[row] * (1.f / 1024.f) + NORM_EPS);
    float4 v = *reinterpret_cast<float4*>(p.out + (size_t)row * 1024 + c4);
    const float4 g = *reinterpret_cast<const float4*>(gain + c4);
    v.x *= rs * g.x; v.y *= rs * g.y; v.z *= rs * g.z; v.w *= rs * g.w;
    *reinterpret_cast<float4*>(p.out + (size_t)row * 1024 + c4) = v;
  }
}

__global__ void __launch_bounds__(256, 2) hybrid_fwd(Params p) {
  cg::grid_group grid = cg::this_grid();
  phase_prep(p);
  grid.sync();
  phase_proj(p);
  grid.sync();
  phase_lora_in(p);
  for (int it = blockIdx.x; it < 1024; it += gridDim.x) gdn_prep_item(p, it);
  grid.sync();
  phase_lora(p);
  grid.sync();
  {
    const int G = gridDim.x, bid = blockIdx.x;
    if (bid < 64) rwkv_chain<false>(p, bid >> 3, bid & 7);
    else if (bid < 96) gdn_scan_chain(p, (bid - 64) >> 2, (bid - 64) & 3);
    else {
      for (int it = bid - 96; it < 1024; it += G - 96) rwkv_chain<true>(p, 8 + (it >> 3), it & 7);
      for (int it = (G - 1 - bid); it < 512; it += G - 96) gdn_sample_item(p, it >> 2, it & 3);
    }
  }
  grid.sync();
  phase_branches(p);
  grid.sync();
  phase_gates(p);
  grid.sync();
  phase_wout(p);
  grid.sync();
  phase_ffn_up(p);
  grid.sync();
  phase_ffn_down(p);
  grid.sync();
  phase_ple(p);
  grid.sync();
  phase_final(p);
}

extern "C" void kernel_launch(void* const* d_in, const int* in_sizes, int n_in, void* d_out, int out_size, void* d_ws, size_t ws_size,
                              hipStream_t stream) {
  static int grid_blocks = 0;
  if (!grid_blocks) {
    int dev = 0, cus = 0, per_cu = 0;
    hipGetDevice(&dev);
    hipDeviceGetAttribute(&cus, hipDeviceAttributeMultiprocessorCount, dev);
    hipFuncSetAttribute((const void*)hybrid_fwd, hipFuncAttributeMaxDynamicSharedMemorySize, LDS_BYTES);
    hipOccupancyMaxActiveBlocksPerMultiprocessor(&per_cu, (const void*)hybrid_fwd, 256, LDS_BYTES);
    if (per_cu > 2) per_cu = 2;
    if (per_cu < 1) per_cu = 1;
    grid_blocks = cus * per_cu;
  }
  Params p{};
  for (int i = 0; i < 36; ++i) p.in[i] = (const float*)d_in[i];
  p.out = (float*)d_out; p.ws = (unsigned char*)d_ws;
  void* args[] = {&p};
  hipError_t e = hipLaunchCooperativeKernel((const void*)hybrid_fwd, dim3(grid_blocks), dim3(256), args, LDS_BYTES, stream);
  if (e != hipSuccess) fprintf(stderr, "cooperative launch failed: %s (grid %d)\n", hipGetErrorString(e), grid_blocks);
}
```

```cpp
#include <hip/hip_runtime.h>
#include <hip/hip_bf16.h>
#include <hip/hip_cooperative_groups.h>
#include <cstdio>
namespace cg = cooperative_groups;

typedef unsigned short u16;
using bf16x8 = __attribute__((ext_vector_type(8))) short;
using u16x4 = __attribute__((ext_vector_type(4))) unsigned short;
using f32x4 = __attribute__((ext_vector_type(4))) float;

constexpr int D = 1024, NP = 16384, NS = 128, MR = NP + NS;
constexpr int SEQ = 2048;
constexpr int A_COLS = 1792, PCOLS = 3848;
constexpr int IN_COLS = 5896, DFF = 2816;
constexpr float NORM_EPS = 1e-6f, GN_EPS = 64e-5f;

constexpr long OUT_Y = 0;
constexpr long OUT_SHIFT_P = (long)MR * D;
constexpr long OUT_WKV_P = OUT_SHIFT_P + 8 * 1792;
constexpr long OUT_CONV_P = OUT_WKV_P + 8L * 8 * 64 * 64;
constexpr long OUT_GDN_P = OUT_CONV_P + 8 * 3 * 1536;
constexpr long OUT_SHIFT_S = OUT_GDN_P + 8L * 4 * 128 * 128;
constexpr long OUT_WKV_S = OUT_SHIFT_S + 128 * 1792;
constexpr long OUT_CONV_S = OUT_WKV_S + 128L * 8 * 64 * 64;
constexpr long OUT_GDN_S = OUT_CONV_S + 128 * 3 * 1536;

constexpr size_t OFF_WINT = 0;
constexpr size_t OFF_WGI = OFF_WINT + (size_t)PCOLS * 1024 * 2;
constexpr size_t OFF_W2T = OFF_WGI + (size_t)2048 * 1024 * 2;
constexpr size_t OFF_A2T = OFF_W2T + 512 * 64 * 2;
constexpr size_t OFF_G2T = OFF_A2T + 512 * 64 * 2;
constexpr size_t OFF_WAT = OFF_G2T + 512 * 128 * 2;
constexpr size_t OFF_WBT = OFF_WAT + 1024 * 512 * 2;
constexpr size_t OFF_WOT = OFF_WBT + 1024 * 512 * 2;
constexpr size_t OFF_WGU = OFF_WOT + 1024 * 1024 * 2;
constexpr size_t OFF_WDT = OFF_WGU + (size_t)5632 * 1024 * 2;
constexpr size_t OFF_WPG = OFF_WDT + (size_t)1024 * 2816 * 2;
constexpr size_t OFF_WPP = OFF_WPG + 1024 * 1024 * 2;
constexpr size_t OFF_U = OFF_WPP + 1024 * 256 * 2;
constexpr size_t OFF_PROJ = OFF_U + (size_t)MR * 1024 * 2;
constexpr size_t OFF_DA = OFF_PROJ + (size_t)MR * PCOLS * 2;
constexpr size_t OFF_DE = OFF_DA + (size_t)MR * 512 * 2;
constexpr size_t OFF_DG = OFF_DE + (size_t)MR * 512 * 2;
constexpr size_t OFF_QK = OFF_DG + (size_t)MR * 512 * 2;
constexpr size_t OFF_LIN = OFF_QK + (size_t)1024 * 64 * 64 * 2;
constexpr size_t OFF_RSS = OFF_LIN + (size_t)MR * 256 * 2;
constexpr size_t OFF_AB = OFF_RSS + (size_t)3 * MR * 4;
constexpr size_t OFF_GL = OFF_AB + (size_t)MR * 8 * 4;
constexpr size_t OFF_BAR = OFF_GL + 4096;
constexpr size_t OFF_END = OFF_BAR + 16384;
constexpr size_t OFF_ACT = OFF_PROJ;
constexpr size_t OFF_PP = OFF_PROJ + (size_t)MR * DFF * 2;
static_assert(OFF_PP + (size_t)MR * 1024 * 2 <= OFF_DA, "pp overflow");
static_assert(OFF_END <= 268435456ull, "ws overflow");
constexpr size_t EO_UT = 0, EO_WN = 16777216, EO_QG = 33554432, EO_KDT = 50331648;

struct Params { const float* in[36]; float* out; unsigned char* ws; };

extern __shared__ __attribute__((aligned(16))) unsigned char smem[];
constexpr int LDS_BYTES = 72192;

__device__ __forceinline__ u16 f2bf(float f) { unsigned u = __float_as_uint(f); u += 0x7fffu + ((u >> 16) & 1u); return (u16)(u >> 16); }
__device__ __forceinline__ float bf2f(u16 h) { return __uint_as_float(((unsigned)h) << 16); }
__device__ __forceinline__ float sigmoidf_(float x) { return 1.f / (1.f + __expf(-x)); }
__device__ __forceinline__ float siluf_(float x) { return x / (1.f + __expf(-x)); }
__device__ __forceinline__ float softplusf_(float x) { return fmaxf(x, 0.f) + log1pf(__expf(-fabsf(x))); }
__device__ __forceinline__ float quad_sum(float x) {
  x += __int_as_float(__builtin_amdgcn_update_dpp(0, __float_as_int(x), 0xB1, 0xF, 0xF, true));
  x += __int_as_float(__builtin_amdgcn_update_dpp(0, __float_as_int(x), 0x4E, 0xF, 0xF, true));
  return x;
}
__device__ __forceinline__ float sum16(float x) {
  x += __shfl_xor(x, 1); x += __shfl_xor(x, 2); x += __shfl_xor(x, 4); x += __shfl_xor(x, 8); return x;
}
__device__ __forceinline__ float sum64(float x) { x = sum16(x); x += __shfl_xor(x, 16); x += __shfl_xor(x, 32); return x; }
__device__ __forceinline__ const float* xrow(const Params& p, int row) {
  return row < NP ? p.in[0] + (size_t)row * D : p.in[1] + (size_t)(row - NP) * D;
}

__device__ __forceinline__ void gemm_mainloop(const u16* __restrict__ A, long lda, const u16* __restrict__ Bt, long ldb, int K,
                                              f32x4 (&acc)[4][4]) {
  const int tid = threadIdx.x, lane = tid & 63, wid = tid >> 6, wr = wid >> 1, wc = wid & 1, fr = lane & 15, fq = lane >> 4;
  u16* SA = (u16*)smem; u16* SB = SA + 4096;
#pragma unroll
  for (int m = 0; m < 4; ++m)
#pragma unroll
    for (int n = 0; n < 4; ++n) acc[m][n] = f32x4{0.f, 0.f, 0.f, 0.f};
  const int nk = K >> 5;
  for (int kt = 0; kt < nk; ++kt) {
#pragma unroll
    for (int i = 0; i < 2; ++i) {
      const int b = tid * 16 + i * 4096, r = b >> 6, c = (b & 63) >> 1;
      __builtin_amdgcn_global_load_lds((const unsigned*)(A + (long)r * lda + kt * 32 + c), (unsigned*)((char*)SA + b), 16, 0, 0);
      __builtin_amdgcn_global_load_lds((const unsigned*)(Bt + (long)r * ldb + kt * 32 + c), (unsigned*)((char*)SB + b), 16, 0, 0);
    }
    asm volatile("s_waitcnt vmcnt(0)" ::: "memory");
    __syncthreads();
    bf16x8 a[4], b[4];
#pragma unroll
    for (int m = 0; m < 4; ++m) a[m] = *reinterpret_cast<const bf16x8*>((char*)SA + (wr * 64 + m * 16 + fr) * 64 + fq * 16);
#pragma unroll
    for (int n = 0; n < 4; ++n) b[n] = *reinterpret_cast<const bf16x8*>((char*)SB + (wc * 64 + n * 16 + fr) * 64 + fq * 16);
#pragma unroll
    for (int m = 0; m < 4; ++m)
#pragma unroll
      for (int n = 0; n < 4; ++n) acc[m][n] = __builtin_amdgcn_mfma_f32_16x16x32_bf16(a[m], b[n], acc[m][n], 0, 0, 0);
    __syncthreads();
  }
}
#define EPI_COORDS const int tid_ = threadIdx.x, lane_ = tid_ & 63, wid_ = tid_ >> 6, wr_ = wid_ >> 1, wc_ = wid_ & 1, fr_ = lane_ & 15, fq_ = lane_ >> 4; (void)wc_; (void)wr_; (void)fr_; (void)fq_;

struct TJob { const float* src; int ld_src; int K; int N; u16* dst; int ld_dst; int ilv; };
__device__ __forceinline__ TJob get_job(const Params& p, int j) {
  unsigned char* ws = p.ws; TJob t;
  switch (j) {
    case 0: t = TJob{p.in[9], IN_COLS, 1024, PCOLS, (u16*)(ws + OFF_WINT), 1024, 0}; break;
    case 1: t = TJob{p.in[9] + PCOLS, IN_COLS, 1024, 1024, (u16*)(ws + OFF_WGI), 1024, 1}; break;
    case 2: t = TJob{p.in[9] + PCOLS + 1024, IN_COLS, 1024, 1024, (u16*)(ws + OFF_WGI), 1024, 2}; break;
    case 3: t = TJob{p.in[12], 512, 64, 512, (u16*)(ws + OFF_W2T), 64, 0}; break;
    case 4: t = TJob{p.in[14], 512, 64, 512, (u16*)(ws + OFF_A2T), 64, 0}; break;
    case 5: t = TJob{p.in[15], 512, 128, 512, (u16*)(ws + OFF_G2T), 128, 0}; break;
    case 6: t = TJob{p.in[25], 1024, 512, 1024, (u16*)(ws + OFF_WAT), 512, 0}; break;
    case 7: t = TJob{p.in[26], 1024, 512, 1024, (u16*)(ws + OFF_WBT), 512, 0}; break;
    case 8: t = TJob{p.in[27], 1024, 1024, 1024, (u16*)(ws + OFF_WOT), 1024, 0}; break;
    case 9: t = TJob{p.in[29], DFF, 1024, DFF, (u16*)(ws + OFF_WGU), 1024, 1}; break;
    case 10: t = TJob{p.in[30], DFF, 1024, DFF, (u16*)(ws + OFF_WGU), 1024, 2}; break;
    case 11: t = TJob{p.in[31], 1024, DFF, 1024, (u16*)(ws + OFF_WDT), DFF, 0}; break;
    case 12: t = TJob{p.in[33], 1024, 1024, 1024, (u16*)(ws + OFF_WPG), 1024, 0}; break;
    default: t = TJob{p.in[34], 1024, 256, 1024, (u16*)(ws + OFF_WPP), 256, 0}; break;
  }
  return t;
}
__device__ __forceinline__ int job_tiles(const TJob& t) { return (t.K >> 6) * ((t.N + 63) >> 6); }

__device__ __forceinline__ void phase_prep(const Params& p) {
  const int tid = threadIdx.x;
  float* T = (float*)smem;
  int total = 0;
  for (int j = 0; j < 14; ++j) { TJob t = get_job(p, j); total += job_tiles(t); }
  for (int g = blockIdx.x; g < total; g += gridDim.x) {
    int j = 0, rem = g; TJob t = get_job(p, 0);
    for (;;) { int nt_ = job_tiles(t); if (rem < nt_) break; rem -= nt_; ++j; t = get_job(p, j); }
    const int nkt = t.K >> 6; const int kt = rem % nkt, nt = rem / nkt;
#pragma unroll
    for (int i = 0; i < 4; ++i) {
      const int k = (tid >> 4) + 16 * i, n4 = (tid & 15) * 4, n = nt * 64 + n4;
      float4 v = make_float4(0.f, 0.f, 0.f, 0.f);
      if (n < t.N) v = *reinterpret_cast<const float4*>(t.src + (long)(kt * 64 + k) * t.ld_src + n);
      T[k * 65 + n4 + 0] = v.x; T[k * 65 + n4 + 1] = v.y; T[k * 65 + n4 + 2] = v.z; T[k * 65 + n4 + 3] = v.w;
    }
    __syncthreads();
    {
      const int nl = tid >> 2, kq = (tid & 3) * 16, n = nt * 64 + nl;
      if (n < t.N) {
        const int drow = t.ilv ? ((((n >> 4) * 2 + (t.ilv - 1)) << 4) + (n & 15)) : n;
        bf16x8 o0, o1;
#pragma unroll
        for (int q = 0; q < 8; ++q) { o0[q] = (short)f2bf(T[(kq + q) * 65 + nl]); o1[q] = (short)f2bf(T[(kq + 8 + q) * 65 + nl]); }
        u16* d = t.dst + (long)drow * t.ld_dst + kt * 64 + kq;
        *reinterpret_cast<bf16x8*>(d) = o0; *reinterpret_cast<bf16x8*>(d + 8) = o1;
      }
    }
    __syncthreads();
  }
  {
    const int lane = tid & 63, gw = blockIdx.x * 4 + (tid >> 6), nw = gridDim.x * 4;
    u16* U = (u16*)(p.ws + OFF_U);
    const float* gain = p.in[8];
    for (int row = gw; row < MR; row += nw) {
      const float* x = xrow(p, row);
      float4 v[4]; float ss = 0.f;
#pragma unroll
      for (int i = 0; i < 4; ++i) { v[i] = *reinterpret_cast<const float4*>(x + i * 256 + lane * 4); ss += v[i].x * v[i].x + v[i].y * v[i].y + v[i].z * v[i].z + v[i].w * v[i].w; }
      ss = sum64(ss);
      const float rs = rsqrtf(ss * (1.f / 1024.f) + NORM_EPS);
#pragma unroll
      for (int i = 0; i < 4; ++i) {
        const float4 g4 = *reinterpret_cast<const float4*>(gain + i * 256 + lane * 4);
        u16x4 o; o[0] = f2bf(v[i].x * rs * g4.x); o[1] = f2bf(v[i].y * rs * g4.y); o[2] = f2bf(v[i].z * rs * g4.z); o[3] = f2bf(v[i].w * rs * g4.w);
        *reinterpret_cast<u16x4*>(U + (size_t)row * 1024 + i * 256 + lane * 4) = o;
      }
    }
  }
  {
    float* rss = (float*)(p.ws + OFF_RSS);
    const int gt = blockIdx.x * 256 + tid, nt = gridDim.x * 256;
    for (int i = gt; i < 3 * MR; i += nt) rss[i] = 0.f;
    const float* sc = p.in[6];
    for (int i = gt; i < 128 * 2 * 1536; i += nt) {
      const int b = i / 3072, r = i - b * 3072;
      p.out[OUT_CONV_S + (long)b * 4608 + r] = sc[(long)b * 4608 + 1536 + r];
    }
  }
}

__device__ __forceinline__ void phase_proj(const Params& p) {
  const u16* U = (const u16*)(p.ws + OFF_U); const u16* W = (const u16*)(p.ws + OFF_WINT);
  u16* PJ = (u16*)(p.ws + OFF_PROJ); float* AB = (float*)(p.ws + OFF_AB);
  constexpr int NCT = 31, NRT = MR / 128;
  for (int t = blockIdx.x; t < NCT * NRT; t += gridDim.x) {
    const int ct = t % NCT, rt = t / NCT; const int row0 = rt * 128, col0 = ct * 128;
    f32x4 acc[4][4];
    gemm_mainloop(U + (size_t)row0 * 1024, 1024, W + (size_t)col0 * 1024, 1024, 1024, acc);
    EPI_COORDS
#pragma unroll
    for (int m = 0; m < 4; ++m)
#pragma unroll
      for (int j = 0; j < 4; ++j) {
        const int row = row0 + wr_ * 64 + m * 16 + fq_ * 4 + j;
        int shift_b = -1; long shift_off = 0; int conv_j = -1; long conv_off = 0;
        if (row < NP) { const int tt = row & (SEQ - 1), b = row >> 11; if (tt == SEQ - 1) { shift_b = b; shift_off = OUT_SHIFT_P + (long)b * 1792; }
                        if (tt >= SEQ - 3) { conv_j = tt - (SEQ - 3); conv_off = OUT_CONV_P + ((long)b * 3 + conv_j) * 1536; } }
        else { const int b = row - NP; shift_b = b; shift_off = OUT_SHIFT_S + (long)b * 1792; conv_j = 2; conv_off = OUT_CONV_S + ((long)b * 3 + 2) * 1536; }
#pragma unroll
        for (int n = 0; n < 4; ++n) {
          const int col = col0 + wc_ * 64 + n * 16 + fr_;
          const float v = acc[m][n][j];
          if (col < PCOLS) {
            PJ[(size_t)row * PCOLS + col] = f2bf(v);
            if (col >= 3840) AB[(size_t)row * 8 + (col - 3840)] = v;
            if (shift_b >= 0 && col < A_COLS) p.out[shift_off + col] = v;
            if (conv_j >= 0 && col >= A_COLS && col < A_COLS + 1536) p.out[conv_off + (col - A_COLS)] = v;
          }
        }
      }
  }
}

__device__ __forceinline__ void phase_lora_in(const Params& p) {
  const u16* PJ = (const u16*)(p.ws + OFF_PROJ); u16* LIN = (u16*)(p.ws + OFF_LIN);
  const float* mu = p.in[10]; const float* sh = p.in[4];
  const int gt = blockIdx.x * 256 + threadIdx.x, nt = gridDim.x * 256;
  for (int i = gt; i < MR * 64; i += nt) {
    const int row = i >> 6, c4 = (i & 63) * 4, col = 1536 + c4;
    const u16x4 cur = *reinterpret_cast<const u16x4*>(PJ + (size_t)row * PCOLS + col);
    float pv[4];
    if (row < NP) {
      if ((row & (SEQ - 1)) > 0) { const u16x4 pr = *reinterpret_cast<const u16x4*>(PJ + (size_t)(row - 1) * PCOLS + col); for (int q = 0; q < 4; ++q) pv[q] = bf2f(pr[q]); }
      else { for (int q = 0; q < 4; ++q) pv[q] = 0.f; }
    } else { const float4 s4 = *reinterpret_cast<const float4*>(sh + (size_t)(row - NP) * 1792 + col); pv[0] = s4.x; pv[1] = s4.y; pv[2] = s4.z; pv[3] = s4.w; }
    const float4 m4 = *reinterpret_cast<const float4*>(mu + col);
    const float mm[4] = {m4.x, m4.y, m4.z, m4.w};
    u16x4 o;
#pragma unroll
    for (int q = 0; q < 4; ++q) {
      const float c = bf2f(cur[q]); float x = c + (pv[q] - c) * mm[q];
      if (c4 < 64) x = tanhf(x); else if (c4 >= 128) x = sigmoidf_(x);
      o[q] = f2bf(x);
    }
    *reinterpret_cast<u16x4*>(LIN + (size_t)row * 256 + c4) = o;
  }
}

__device__ __forceinline__ void gdn_prep_item(const Params& p, int item) {
  const int tid = threadIdx.x, lane = tid & 63, wid = tid >> 6, fr = lane & 15, fq = lane >> 4;
  const int n = item & 31, h = (item >> 5) & 3, b = item >> 7;
  const int rowb = b * SEQ + n * 64;
  const u16* PJ = (const u16*)(p.ws + OFF_PROJ);
  u16* qs = (u16*)smem; u16* ks = qs + 64 * 136; u16* vs = ks + 64 * 136;
  float* Ls = (float*)(smem + 3 * 64 * 136 * 2);
  float* gcs = Ls + 64 * 64; float* betas = gcs + 64; float* egcs = betas + 64;
  const float* cw = p.in[21];
  for (int it = tid; it < 64 * 48; it += 256) {
    const int t = it / 48, cg8 = it - t * 48; const int which = cg8 >> 4, cc = (cg8 & 15) * 8;
    const int ch = which * 512 + h * 128 + cc;
    float acc8[8];
#pragma unroll
    for (int q = 0; q < 8; ++q) acc8[q] = 0.f;
#pragma unroll
    for (int j = 0; j < 4; ++j) {
      const int tt = n * 64 + t - 3 + j;
      if (tt >= 0) {
        const bf16x8 xv = *reinterpret_cast<const bf16x8*>(PJ + (size_t)(b * SEQ + tt) * PCOLS + A_COLS + ch);
        const float4 w0 = *reinterpret_cast<const float4*>(cw + j * 1536 + ch), w1 = *reinterpret_cast<const float4*>(cw + j * 1536 + ch + 4);
        const float wv[8] = {w0.x, w0.y, w0.z, w0.w, w1.x, w1.y, w1.z, w1.w};
#pragma unroll
        for (int q = 0; q < 8; ++q) acc8[q] += bf2f((u16)xv[q]) * wv[q];
      }
    }
    bf16x8 o;
#pragma unroll
    for (int q = 0; q < 8; ++q) o[q] = (short)f2bf(siluf_(acc8[q]));
    u16* dst = (which == 0 ? qs : (which == 1 ? ks : vs)) + t * 136 + cc;
    *reinterpret_cast<bf16x8*>(dst) = o;
  }
  if (wid == 0) {
    const float* AB = (const float*)(p.ws + OFF_AB) + (size_t)(rowb + lane) * 8;
    const float braw = AB[h], araw = AB[4 + h];
    const float g = -__expf(p.in[22][h]) * softplusf_(araw + p.in[23][h]);
    float c = g;
#pragma unroll
    for (int o = 1; o < 64; o <<= 1) { const float up = __shfl_up(c, o); if (lane >= o) c += up; }
    gcs[lane] = c; betas[lane] = sigmoidf_(braw); egcs[lane] = __expf(c);
  }
  __syncthreads();
  {
    const int r = tid >> 2, part = tid & 3;
#pragma unroll
    for (int w2 = 0; w2 < 2; ++w2) {
      u16* base = (w2 == 0 ? qs : ks) + r * 136 + part * 32;
      float v[32]; float ss = 0.f;
#pragma unroll
      for (int q8 = 0; q8 < 4; ++q8) { const bf16x8 x = *reinterpret_cast<const bf16x8*>(base + q8 * 8);
#pragma unroll
        for (int q = 0; q < 8; ++q) { v[q8 * 8 + q] = bf2f((u16)x[q]); ss += v[q8 * 8 + q] * v[q8 * 8 + q]; } }
      ss = quad_sum(ss);
      const float sc = rsqrtf(ss + 1e-6f) * (w2 == 0 ? 0.08838834764831845f : 1.f);
#pragma unroll
      for (int q8 = 0; q8 < 4; ++q8) { bf16x8 o;
#pragma unroll
        for (int q = 0; q < 8; ++q) o[q] = (short)f2bf(v[q8 * 8 + q] * sc);
        *reinterpret_cast<bf16x8*>(base + q8 * 8) = o; }
    }
  }
  __syncthreads();
  {
    f32x4 aL[4], aQ[4];
#pragma unroll
    for (int nt = 0; nt < 4; ++nt) { aL[nt] = f32x4{0.f, 0.f, 0.f, 0.f}; aQ[nt] = f32x4{0.f, 0.f, 0.f, 0.f}; }
#pragma unroll
    for (int kk = 0; kk < 4; ++kk) {
      const bf16x8 ak = *reinterpret_cast<const bf16x8*>((char*)ks + (wid * 16 + fr) * 272 + kk * 64 + fq * 16);
      const bf16x8 aq = *reinterpret_cast<const bf16x8*>((char*)qs + (wid * 16 + fr) * 272 + kk * 64 + fq * 16);
#pragma unroll
      for (int nt = 0; nt < 4; ++nt) {
        const bf16x8 bk = *reinterpret_cast<const bf16x8*>((char*)ks + (nt * 16 + fr) * 272 + kk * 64 + fq * 16);
        aL[nt] = __builtin_amdgcn_mfma_f32_16x16x32_bf16(ak, bk, aL[nt], 0, 0, 0);
        aQ[nt] = __builtin_amdgcn_mfma_f32_16x16x32_bf16(aq, bk, aQ[nt], 0, 0, 0);
      }
    }
    u16* QK = (u16*)(p.ws + OFF_QK) + (size_t)item * 4096;
#pragma unroll
    for (int nt = 0; nt < 4; ++nt)
#pragma unroll
      for (int j = 0; j < 4; ++j) {
        const int i = wid * 16 + fq * 4 + j, jc = nt * 16 + fr;
        const float dec = (i >= jc) ? __expf(gcs[i] - gcs[jc]) : 0.f;
        Ls[i * 64 + jc] = (i > jc) ? betas[i] * aL[nt][j] * dec : 0.f;
        QK[i * 64 + jc] = f2bf(aQ[nt][j] * dec);
      }
  }
  __syncthreads();
  const size_t ebase = (size_t)item * 8192;
  u16* EUT = (u16*)((unsigned char*)p.out + EO_UT) + ebase; u16* EWN = (u16*)((unsigned char*)p.out + EO_WN) + ebase;
  u16* EQG = (u16*)((unsigned char*)p.out + EO_QG) + ebase; u16* EKD = (u16*)((unsigned char*)p.out + EO_KDT) + ebase;
  {
    float X[64];
    const bool isv = tid < 128; const u16* src = isv ? (vs + tid) : (ks + (tid - 128));
#pragma unroll
    for (int i = 0; i < 64; ++i) { float r = bf2f(src[i * 136]) * betas[i]; if (!isv) r *= egcs[i]; X[i] = r; }
#pragma unroll
    for (int i = 1; i < 64; ++i) {
      float s = X[i];
#pragma unroll
      for (int j4 = 0; j4 < (i + 3) / 4; ++j4) {
        const float4 l = *reinterpret_cast<const float4*>(Ls + i * 64 + j4 * 4);
        s -= l.x * X[4 * j4]; s -= l.y * X[4 * j4 + 1]; s -= l.z * X[4 * j4 + 2]; s -= l.w * X[4 * j4 + 3];
      }
      X[i] = s;
    }
    if (isv) {
#pragma unroll
      for (int q8 = 0; q8 < 8; ++q8) { bf16x8 o;
#pragma unroll
        for (int q = 0; q < 8; ++q) o[q] = (short)f2bf(X[q8 * 8 + q]);
        *reinterpret_cast<bf16x8*>(EUT + tid * 64 + q8 * 8) = o; }
    } else {
#pragma unroll
      for (int i = 0; i < 64; ++i) EWN[i * 128 + (tid - 128)] = f2bf(-X[i]);
    }
  }
  {
    const int i = tid >> 2, k0 = (tid & 3) * 32; const float eg = egcs[i];
#pragma unroll
    for (int q8 = 0; q8 < 4; ++q8) { const bf16x8 x = *reinterpret_cast<const bf16x8*>(qs + i * 136 + k0 + q8 * 8); bf16x8 o;
#pragma unroll
      for (int q = 0; q < 8; ++q) o[q] = (short)f2bf(bf2f((u16)x[q]) * eg);
      *reinterpret_cast<bf16x8*>(EQG + i * 128 + k0 + q8 * 8) = o; }
    const int k = tid >> 1, i0 = (tid & 1) * 32; const float gl = gcs[63];
#pragma unroll
    for (int q8 = 0; q8 < 4; ++q8) { bf16x8 o;
#pragma unroll
      for (int q = 0; q < 8; ++q) { const int ii = i0 + q8 * 8 + q; o[q] = (short)f2bf(bf2f(ks[ii * 136 + k]) * __expf(gl - gcs[ii])); }
      *reinterpret_cast<bf16x8*>(EKD + k * 64 + i0 + q8 * 8) = o; }
    if (tid == 0) ((float*)(p.ws + OFF_GL))[item] = __expf(gl);
  }
  __syncthreads();
}

__device__ __forceinline__ void phase_lora(const Params& p) {
  const u16* LIN = (const u16*)(p.ws + OFF_LIN);
  constexpr int NRT = MR / 128;
  for (int t = blockIdx.x; t < 3 * 4 * NRT; t += gridDim.x) {
    const int which = t / (4 * NRT), r2 = t - which * 4 * NRT; const int ct = r2 & 3, rt = r2 >> 2;
    const int row0 = rt * 128, col0 = ct * 128;
    f32x4 acc[4][4];
    const u16* A; const u16* Bt; int K; u16* O; const float* bias;
    if (which == 0) { A = LIN; Bt = (const u16*)(p.ws + OFF_W2T); K = 64; O = (u16*)(p.ws + OFF_DE); bias = p.in[11]; }
    else if (which == 1) { A = LIN + 64; Bt = (const u16*)(p.ws + OFF_A2T); K = 64; O = (u16*)(p.ws + OFF_DA); bias = p.in[13]; }
    else { A = LIN + 128; Bt = (const u16*)(p.ws + OFF_G2T); K = 128; O = (u16*)(p.ws + OFF_DG); bias = p.in[13]; }
    gemm_mainloop(A + (size_t)row0 * 256, 256, Bt + (size_t)col0 * K, K, K, acc);
    EPI_COORDS
#pragma unroll
    for (int n = 0; n < 4; ++n) {
      const int col = col0 + wc_ * 64 + n * 16 + fr_; const float bs = bias[col];
#pragma unroll
      for (int m = 0; m < 4; ++m)
#pragma unroll
        for (int j = 0; j < 4; ++j) {
          const int row = row0 + wr_ * 64 + m * 16 + fq_ * 4 + j; float v = acc[m][n][j];
          if (which == 0) { const float z = bs + v; v = __expf(-softplusf_(-z) - 0.5f); }
          else if (which == 1) v = sigmoidf_(bs + v);
          O[(size_t)row * 512 + col] = f2bf(v);
        }
    }
  }
}

struct RwRaw { u16x4 r, k, v, pr, pk, pv, e, a, g; float4 sr, sk, sv; };
template <bool samp>
__device__ __forceinline__ void rwkv_chain(const Params& p, int seq, int h) {
  const int tid = threadIdx.x;
  constexpr int T = samp ? 1 : SEQ; const int rowb = samp ? NP + (seq - 8) : seq * SEQ;
  const u16* PJ = (const u16*)(p.ws + OFF_PROJ); u16* DA = (u16*)(p.ws + OFF_DA);
  const u16* DE = (const u16*)(p.ws + OFF_DE); const u16* DG = (const u16*)(p.ws + OFF_DG);
  float* buf = (float*)smem;
  float* ybuf = buf + 2 * 16 * 384;
  const int vrow = tid >> 2, part = tid & 3;
  const int tt = tid >> 4, jg = (tid & 15) * 4, ch = h * 64 + jg;
  float S[16];
  if (samp) { const float* s0 = p.in[5] + ((size_t)(seq - 8) * 8 + h) * 4096 + vrow * 64 + part * 16;
#pragma unroll
    for (int q = 0; q < 4; ++q) { const float4 x = *reinterpret_cast<const float4*>(s0 + q * 4); S[q * 4] = x.x; S[q * 4 + 1] = x.y; S[q * 4 + 2] = x.z; S[q * 4 + 3] = x.w; } }
  else {
#pragma unroll
    for (int q = 0; q < 16; ++q) S[q] = 0.f; }
  const float4 mur = *reinterpret_cast<const float4*>(p.in[10] + ch), muk = *reinterpret_cast<const float4*>(p.in[10] + 512 + ch), muv = *reinterpret_cast<const float4*>(p.in[10] + 1024 + ch);
  const float4 ckk = *reinterpret_cast<const float4*>(p.in[16] + ch), cka = *reinterpret_cast<const float4*>(p.in[17] + ch), crk = *reinterpret_cast<const float4*>(p.in[18] + ch);
  const float4 lnw = *reinterpret_cast<const float4*>(p.in[19] + ch), lnb = *reinterpret_cast<const float4*>(p.in[20] + ch);
  constexpr int nchunks = (T + 15) >> 4;
  auto load_raw = [&](int c, RwRaw& R) {
    const int t = c * 16 + tt;
    if (t < T) {
      const size_t ro = (size_t)(rowb + t) * PCOLS;
      R.r = *reinterpret_cast<const u16x4*>(PJ + ro + ch); R.k = *reinterpret_cast<const u16x4*>(PJ + ro + 512 + ch); R.v = *reinterpret_cast<const u16x4*>(PJ + ro + 1024 + ch);
      if (t > 0) { const size_t po = ro - PCOLS; R.pr = *reinterpret_cast<const u16x4*>(PJ + po + ch); R.pk = *reinterpret_cast<const u16x4*>(PJ + po + 512 + ch); R.pv = *reinterpret_cast<const u16x4*>(PJ + po + 1024 + ch); }
      else if (samp) { const float* sh = p.in[4] + (size_t)(seq - 8) * 1792; R.sr = *reinterpret_cast<const float4*>(sh + ch); R.sk = *reinterpret_cast<const float4*>(sh + 512 + ch); R.sv = *reinterpret_cast<const float4*>(sh + 1024 + ch); }
      const size_t lo = (size_t)(rowb + t) * 512 + ch;
      R.e = *reinterpret_cast<const u16x4*>(DE + lo); R.a = *reinterpret_cast<const u16x4*>(DA + lo); R.g = *reinterpret_cast<const u16x4*>(DG + lo);
    }
  };
  auto prep_write = [&](int c, const RwRaw& R) {
    const int t = c * 16 + tt;
    if (t < T) {
      float r4[4], k4[4], v4[4], pr4[4], pk4[4], pv4[4];
      const float mr[4] = {mur.x, mur.y, mur.z, mur.w}, mk[4] = {muk.x, muk.y, muk.z, muk.w}, mv[4] = {muv.x, muv.y, muv.z, muv.w};
      const float kkc[4] = {ckk.x, ckk.y, ckk.z, ckk.w}, kac[4] = {cka.x, cka.y, cka.z, cka.w};
      if (t > 0) { for (int q = 0; q < 4; ++q) { pr4[q] = bf2f(R.pr[q]); pk4[q] = bf2f(R.pk[q]); pv4[q] = bf2f(R.pv[q]); } }
      else if (samp) { pr4[0] = R.sr.x; pr4[1] = R.sr.y; pr4[2] = R.sr.z; pr4[3] = R.sr.w; pk4[0] = R.sk.x; pk4[1] = R.sk.y; pk4[2] = R.sk.z; pk4[3] = R.sk.w; pv4[0] = R.sv.x; pv4[1] = R.sv.y; pv4[2] = R.sv.z; pv4[3] = R.sv.w; }
      else { for (int q = 0; q < 4; ++q) { pr4[q] = 0.f; pk4[q] = 0.f; pv4[q] = 0.f; } }
      float kr[4], ss = 0.f, a4[4], w4[4];
#pragma unroll
      for (int q = 0; q < 4; ++q) {
        const float cr = bf2f(R.r[q]), ck = bf2f(R.k[q]), cv = bf2f(R.v[q]);
        r4[q] = cr + (pr4[q] - cr) * mr[q]; k4[q] = ck + (pk4[q] - ck) * mk[q]; v4[q] = cv + (pv4[q] - cv) * mv[q];
        kr[q] = k4[q] * kkc[q]; ss += kr[q] * kr[q];
        a4[q] = bf2f(R.a[q]); w4[q] = __expf(-bf2f(R.e[q]));
      }
      ss = sum16(ss);
      const float rn = rsqrtf(ss + 1e-6f);
      float* dst = buf + ((c & 1) * 16 + tt) * 384 + jg;
      float4 o;
      o = make_float4(w4[0], w4[1], w4[2], w4[3]); *reinterpret_cast<float4*>(dst) = o;
      o = make_float4(-kr[0] * rn, -kr[1] * rn, -kr[2] * rn, -kr[3] * rn); *reinterpret_cast<float4*>(dst + 64) = o;
      o = make_float4(kr[0] * rn * a4[0], kr[1] * rn * a4[1], kr[2] * rn * a4[2], kr[3] * rn * a4[3]); *reinterpret_cast<float4*>(dst + 128) = o;
      o = make_float4(k4[0] * (1.f + (a4[0] - 1.f) * kac[0]), k4[1] * (1.f + (a4[1] - 1.f) * kac[1]), k4[2] * (1.f + (a4[2] - 1.f) * kac[2]), k4[3] * (1.f + (a4[3] - 1.f) * kac[3]));
      *reinterpret_cast<float4*>(dst + 192) = o;
      o = make_float4(r4[0], r4[1], r4[2], r4[3]); *reinterpret_cast<float4*>(dst + 256) = o;
      o = make_float4(v4[0], v4[1], v4[2], v4[3]); *reinterpret_cast<float4*>(dst + 320) = o;
    }
  };
  RwRaw R; load_raw(0, R);
  for (int c = 0; c < nchunks; ++c) {
    prep_write(c, R);
    const u16x4 gcur = R.g;
    if (c + 1 < nchunks) load_raw(c + 1, R);
    __syncthreads();
    const int nsteps = min(16, T - c * 16);
    const float* cb = buf + (c & 1) * 16 * 384;
#pragma unroll 2
    for (int s = 0; s < nsteps; ++s) {
      const float* sb = cb + s * 384 + part * 16;
      float w[16], a[16], bb[16], kk[16], rr[16];
#pragma unroll
      for (int q = 0; q < 4; ++q) {
        const float4 x0 = *reinterpret_cast<const float4*>(sb + q * 4); w[q * 4] = x0.x; w[q * 4 + 1] = x0.y; w[q * 4 + 2] = x0.z; w[q * 4 + 3] = x0.w;
        const float4 x1 = *reinterpret_cast<const float4*>(sb + 64 + q * 4); a[q * 4] = x1.x; a[q * 4 + 1] = x1.y; a[q * 4 + 2] = x1.z; a[q * 4 + 3] = x1.w;
        const float4 x2 = *reinterpret_cast<const float4*>(sb + 128 + q * 4); bb[q * 4] = x2.x; bb[q * 4 + 1] = x2.y; bb[q * 4 + 2] = x2.z; bb[q * 4 + 3] = x2.w;
        const float4 x3 = *reinterpret_cast<const float4*>(sb + 192 + q * 4); kk[q * 4] = x3.x; kk[q * 4 + 1] = x3.y; kk[q * 4 + 2] = x3.z; kk[q * 4 + 3] = x3.w;
        const float4 x4 = *reinterpret_cast<const float4*>(sb + 256 + q * 4); rr[q * 4] = x4.x; rr[q * 4 + 1] = x4.y; rr[q * 4 + 2] = x4.z; rr[q * 4 + 3] = x4.w;
      }
      const float vv = cb[s * 384 + 320 + vrow];
      float s0 = 0.f, s1 = 0.f, s2 = 0.f, s3 = 0.f;
#pragma unroll
      for (int q = 0; q < 4; ++q) { s0 += S[q * 4] * a[q * 4]; s1 += S[q * 4 + 1] * a[q * 4 + 1]; s2 += S[q * 4 + 2] * a[q * 4 + 2]; s3 += S[q * 4 + 3] * a[q * 4 + 3]; }
      const float sa = quad_sum((s0 + s1) + (s2 + s3));
      float y0 = 0.f, y1 = 0.f, y2 = 0.f, y3 = 0.f;
#pragma unroll
      for (int q = 0; q < 16; ++q) S[q] = fmaf(sa, bb[q], fmaf(S[q], w[q], vv * kk[q]));
#pragma unroll
      for (int q = 0; q < 4; ++q) { y0 += S[q * 4] * rr[q * 4]; y1 += S[q * 4 + 1] * rr[q * 4 + 1]; y2 += S[q * 4 + 2] * rr[q * 4 + 2]; y3 += S[q * 4 + 3] * rr[q * 4 + 3]; }
      const float y = quad_sum((y0 + y1) + (y2 + y3));
      if (part == 0) ybuf[s * 64 + vrow] = y;
    }
    __syncthreads();
    {
      const int t = c * 16 + tt;
      if (t < T) {
        const float4 y4 = *reinterpret_cast<const float4*>(ybuf + tt * 64 + jg);
        const float* tb = cb + tt * 384 + jg;
        const float4 kq = *reinterpret_cast<const float4*>(tb + 192), rq = *reinterpret_cast<const float4*>(tb + 256), vq = *reinterpret_cast<const float4*>(tb + 320);
        const float mean = sum16(y4.x + y4.y + y4.z + y4.w) * (1.f / 64.f);
        const float d0 = y4.x - mean, d1 = y4.y - mean, d2 = y4.z - mean, d3 = y4.w - mean;
        const float var = sum16(d0 * d0 + d1 * d1 + d2 * d2 + d3 * d3) * (1.f / 64.f);
        const float rstd = rsqrtf(var + GN_EPS);
        const float dot = sum16(rq.x * kq.x * crk.x + rq.y * kq.y * crk.y + rq.z * kq.z * crk.z + rq.w * kq.w * crk.w);
        u16x4 o;
        o[0] = f2bf((d0 * rstd * lnw.x + lnb.x + dot * vq.x) * bf2f(gcur[0]));
        o[1] = f2bf((d1 * rstd * lnw.y + lnb.y + dot * vq.y) * bf2f(gcur[1]));
        o[2] = f2bf((d2 * rstd * lnw.z + lnb.z + dot * vq.z) * bf2f(gcur[2]));
        o[3] = f2bf((d3 * rstd * lnw.w + lnb.w + dot * vq.w) * bf2f(gcur[3]));
        *reinterpret_cast<u16x4*>(DA + (size_t)(rowb + t) * 512 + ch) = o;
      }
    }
  }
  {
    float* so = p.out + (samp ? OUT_WKV_S + ((size_t)(seq - 8) * 8 + h) * 4096 : OUT_WKV_P + ((size_t)seq * 8 + h) * 4096) + vrow * 64 + part * 16;
#pragma unroll
    for (int q = 0; q < 4; ++q) *reinterpret_cast<float4*>(so + q * 4) = make_float4(S[q * 4], S[q * 4 + 1], S[q * 4 + 2], S[q * 4 + 3]);
  }
  __syncthreads();
}

struct RW2 { bf16x8 cr, ck, pr, pk, a8; u16 r[9], k[9], v[9], e[8], a[8]; };
__device__ __forceinline__ void rwkv_chunked(const Params& p, int b, int h) {
  const int tid = threadIdx.x, lane = tid & 63, w = tid >> 6, fr = lane & 15, fq = lane >> 4;
#define RWC_CARVE(L) \
  u16* At = (u16*)(L);\
  u16* Rt = (u16*)(L + 4608);\
  u16* Bt = (u16*)(L + 9216);\
  u16* Kt = (u16*)(L + 13824);\
  u16* Aak = (u16*)(L + 9216);\
  u16* Ark = (u16*)(L + 11776); \
  u16* Arb = (u16*)(L + 14336); \
  u16* VT = (u16*)(L + 18432);\
  u16* KHT = (u16*)(L + 23552);\
  u16* BHT = (u16*)(L + 28672);\
  float* Af = (float*)(L + 33792);\
  float* AV = (float*)(L + 41984);\
  float* Ls = (float*)(L + 50176);\
  u16* St = (u16*)(L + 54272);\
  u16* Dt = (u16*)(L + 63488);\
  float* rn = (float*)(L + 68608); float* dots = rn + 32; float* gtot = dots + 32; float* pcs = gtot + 256; float* stat = pcs + 64;\
  float* cst = stat + 64;
  const int rowb = b * SEQ, ch = h * 64 + lane;
  const u16* PJ = (const u16*)(p.ws + OFF_PROJ); u16* DA = (u16*)(p.ws + OFF_DA);
  const u16* DE = (const u16*)(p.ws + OFF_DE); const u16* DG = (const u16*)(p.ws + OFF_DG);
  { unsigned char* L = smem; RWC_CARVE(L) (void)At; (void)Rt; (void)Bt; (void)Kt; (void)Aak; (void)Ark; (void)Arb; (void)VT; (void)KHT; (void)BHT; (void)Af; (void)AV; (void)Ls; (void)Dt; (void)rn; (void)dots; (void)gtot; (void)pcs; (void)stat;
  if (tid < 64) { cst[tid] = p.in[10][ch]; cst[64 + tid] = p.in[10][512 + ch]; cst[128 + tid] = p.in[16][ch]; cst[192 + tid] = p.in[17][ch]; cst[256 + tid] = p.in[18][ch]; }
  for (int i = tid; i < 64 * 72 / 2; i += 256) ((unsigned*)St)[i] = 0u; }
  const float mur = p.in[10][ch], muk = p.in[10][512 + ch], muv = p.in[10][1024 + ch];
  const float kkc = p.in[16][ch], kac = p.in[17][ch], lnw = p.in[19][ch], lnb = p.in[20][ch];
  const int i2 = tid >> 3, c0 = (tid & 7) * 8;
  const int mi = w >> 1, nt0 = (w & 1) * 2;
  f32x4 Sacc[4];
#pragma unroll
  for (int nt = 0; nt < 4; ++nt) Sacc[nt] = f32x4{0.f, 0.f, 0.f, 0.f};
  auto load2a = [&](int n_, RW2& R) {
    int nl = n_; asm volatile("" : "+s"(nl));
    int tz = threadIdx.x; asm volatile("" : "+v"(tz)); const int i2 = tz >> 3, c0 = (tz & 7) * 8;
    const int t0 = nl * 32;
    { const int t = t0 + i2; const size_t ro = (size_t)(rowb + t) * PCOLS + h * 64 + c0;
      R.cr = *reinterpret_cast<const bf16x8*>(PJ + ro); R.ck = *reinterpret_cast<const bf16x8*>(PJ + ro + 512);
      if (t > 0) { R.pr = *reinterpret_cast<const bf16x8*>(PJ + ro - PCOLS); R.pk = *reinterpret_cast<const bf16x8*>(PJ + ro - PCOLS + 512); }
      else { R.pr = bf16x8{0, 0, 0, 0, 0, 0, 0, 0}; R.pk = R.pr; }
      R.a8 = *reinterpret_cast<const bf16x8*>(DA + (size_t)(rowb + t) * 512 + h * 64 + c0); }
  };
  auto load2b = [&](int n_, RW2& R) {
    int nl = n_; asm volatile("" : "+s"(nl));
    int tz = threadIdx.x; asm volatile("" : "+v"(tz)); const int w = tz >> 6, ch = h * 64 + (tz & 63);
    const int t0 = nl * 32;
    { const int tb = t0 + w * 8;
#pragma unroll
      for (int q = 0; q < 9; ++q) { const int t = tb - 1 + q;
        if (t >= 0) { const size_t ro = (size_t)(rowb + t) * PCOLS + ch; R.r[q] = PJ[ro]; R.k[q] = PJ[ro + 512]; R.v[q] = PJ[ro + 1024]; }
        else { R.r[q] = 0; R.k[q] = 0; R.v[q] = 0; } }
#pragma unroll
      for (int q = 0; q < 8; ++q) { const size_t lo = (size_t)(rowb + tb + q) * 512 + ch; R.e[q] = DE[lo]; R.a[q] = DA[lo]; } }
  };
  RW2 R; load2a(0, R); load2b(0, R);
  __syncthreads();
  for (int n = 0; n < SEQ / 32; ++n) {
    int nq = n; asm volatile("" : "+s"(nq));
    int tl = threadIdx.x; asm volatile("" : "+v"(tl));
    const int tid = tl, lane = tid & 63, w = tid >> 6, fr = lane & 15, fq = lane >> 4;
    const int i2 = tid >> 3, c0 = (tid & 7) * 8, mi = w >> 1, nt0 = (w & 1) * 2;
    unsigned char* L = smem; RWC_CARVE(L)
    {
      float ss = 0.f, dt = 0.f;
#pragma unroll
      for (int q = 0; q < 8; ++q) {
        const float cr = bf2f((u16)R.cr[q]), ck = bf2f((u16)R.ck[q]);
        const float r = cr + (bf2f((u16)R.pr[q]) - cr) * cst[c0 + q], k = ck + (bf2f((u16)R.pk[q]) - ck) * cst[64 + c0 + q];
        const float a = bf2f((u16)R.a8[q]); const float kr = k * cst[128 + c0 + q];
        ss += kr * kr; dt += r * k * (1.f + (a - 1.f) * cst[192 + c0 + q]) * cst[256 + c0 + q];
      }
      ss += __shfl_xor(ss, 1); dt += __shfl_xor(dt, 1); ss += __shfl_xor(ss, 2); dt += __shfl_xor(dt, 2); ss += __shfl_xor(ss, 4); dt += __shfl_xor(dt, 4);
      if ((tid & 7) == 0) { rn[i2] = rsqrtf(ss + 1e-6f); dots[i2] = dt; }
    }
    float lsum = 0.f;
#pragma unroll
    for (int q = 0; q < 8; ++q) lsum -= bf2f(R.e[q]);
    gtot[w * 64 + lane] = lsum;
    __syncthreads();
    float vq[8]; u16 gq[8];
    {
      const float g0 = gtot[lane], g1 = gtot[64 + lane], g2 = gtot[128 + lane], g3 = gtot[192 + lane];
      const float Ltot = (g0 + g1) + (g2 + g3);
      const float off = (w > 0 ? g0 : 0.f) + (w > 1 ? g1 : 0.f) + (w > 2 ? g2 : 0.f);
      if (w == 0) pcs[lane] = __expf(Ltot);
      float run = 0.f; bf16x8 vp, khp, bhp;
#pragma unroll
      for (int q = 0; q < 8; ++q) {
        const int i = w * 8 + q;
        const float cr = bf2f(R.r[q + 1]), ck = bf2f(R.k[q + 1]), cv = bf2f(R.v[q + 1]);
        const float r = cr + (bf2f(R.r[q]) - cr) * mur, k = ck + (bf2f(R.k[q]) - ck) * muk, v = cv + (bf2f(R.v[q]) - cv) * muv;
        const float e = bf2f(R.e[q]), a = bf2f(R.a[q]);
        run -= e; const float Lc = off + run, Lp = Lc + e;
        const float kk = k * kkc * rn[i]; const float ain = -kk, bin = kk * a, kp = k * (1.f + (a - 1.f) * kac);
        const float eP = __expf(Lp), eC = __expf(Lc), eN = __expf(-Lc), eT = __expf(Ltot - Lc);
        const float at = ain * eP;
        At[i * 72 + lane] = f2bf(at); Af[i * 64 + lane] = at; Rt[i * 72 + lane] = f2bf(r * eC);
        Bt[i * 72 + lane] = f2bf(bin * eN); Kt[i * 72 + lane] = f2bf(kp * eN);
        vp[q] = (short)f2bf(v); khp[q] = (short)f2bf(kp * eT); bhp[q] = (short)f2bf(bin * eT);
        vq[q] = v; gq[q] = DG[(size_t)(rowb + nq * 32 + i) * 512 + ch];
      }
      *reinterpret_cast<bf16x8*>((char*)VT + lane * 80 + w * 16) = vp;
      *reinterpret_cast<bf16x8*>((char*)KHT + lane * 80 + w * 16) = khp;
      *reinterpret_cast<bf16x8*>((char*)BHT + lane * 80 + w * 16) = bhp;
    }
    if (n + 1 < SEQ / 32) load2b(n + 1, R);
    __syncthreads();
    f32x4 Yacc[2], SVacc[4];
    {
      f32x4 cab = {0.f, 0.f, 0.f, 0.f}, cak = cab, crb = cab, crk = cab;
#pragma unroll
      for (int ks = 0; ks < 2; ++ks) {
        const bf16x8 fa = *reinterpret_cast<const bf16x8*>((char*)At + (mi * 16 + fr) * 144 + ks * 64 + fq * 16);
        const bf16x8 fr_ = *reinterpret_cast<const bf16x8*>((char*)Rt + (mi * 16 + fr) * 144 + ks * 64 + fq * 16);
        const bf16x8 fb = *reinterpret_cast<const bf16x8*>((char*)Bt + ((w & 1) * 16 + fr) * 144 + ks * 64 + fq * 16);
        const bf16x8 fk = *reinterpret_cast<const bf16x8*>((char*)Kt + ((w & 1) * 16 + fr) * 144 + ks * 64 + fq * 16);
        cab = __builtin_amdgcn_mfma_f32_16x16x32_bf16(fa, fb, cab, 0, 0, 0);
        cak = __builtin_amdgcn_mfma_f32_16x16x32_bf16(fa, fk, cak, 0, 0, 0);
        crb = __builtin_amdgcn_mfma_f32_16x16x32_bf16(fr_, fb, crb, 0, 0, 0);
        crk = __builtin_amdgcn_mfma_f32_16x16x32_bf16(fr_, fk, crk, 0, 0, 0);
      }
      __syncthreads();
#pragma unroll
      for (int jj = 0; jj < 4; ++jj) {
        const int i = mi * 16 + fq * 4 + jj, s = (w & 1) * 16 + fr;
        Ls[i * 32 + s] = (s < i) ? cab[jj] : 0.f;
        Aak[i * 40 + s] = f2bf((s < i) ? cak[jj] : 0.f);
        Arb[i * 40 + s] = f2bf((s <= i) ? crb[jj] : 0.f);
        Ark[i * 40 + s] = f2bf((s <= i) ? crk[jj] : 0.f);
      }
    }
    __syncthreads();
    {
      const bf16x8 faak = *reinterpret_cast<const bf16x8*>((char*)Aak + (mi * 16 + fr) * 80 + fq * 16);
      const bf16x8 fark = *reinterpret_cast<const bf16x8*>((char*)Ark + (mi * 16 + fr) * 80 + fq * 16);
      const bf16x8 fkh = *reinterpret_cast<const bf16x8*>((char*)KHT + (w * 16 + fr) * 80 + fq * 16);
      const f32x4 z4 = {0.f, 0.f, 0.f, 0.f};
#pragma unroll
      for (int nt = 0; nt < 4; ++nt) {
        const bf16x8 vb = *reinterpret_cast<const bf16x8*>((char*)VT + (nt * 16 + fr) * 80 + fq * 16);
        SVacc[nt] = __builtin_amdgcn_mfma_f32_16x16x32_bf16(fkh, vb, z4, 0, 0, 0);
        if (nt == nt0 || nt == nt0 + 1) {
          const f32x4 av = __builtin_amdgcn_mfma_f32_16x16x32_bf16(faak, vb, z4, 0, 0, 0);
          Yacc[nt - nt0] = __builtin_amdgcn_mfma_f32_16x16x32_bf16(fark, vb, z4, 0, 0, 0);
#pragma unroll
          for (int jj = 0; jj < 4; ++jj) AV[(mi * 16 + fq * 4 + jj) * 64 + nt * 16 + fr] = av[jj];
        }
      }
    }
    __syncthreads();
    if (tid < 128) {
      float* src = tid < 64 ? (Af + tid) : (AV + (tid - 64));
      float X[32];
#pragma unroll
      for (int i = 0; i < 32; ++i) X[i] = src[i * 64];
#pragma unroll
      for (int i = 1; i < 32; ++i) {
        float s = X[i];
#pragma unroll
        for (int s4 = 0; s4 < (i + 3) / 4; ++s4) {
          const float4 l = *reinterpret_cast<const float4*>(Ls + i * 32 + s4 * 4);
          s += l.x * X[4 * s4]; s += l.y * X[4 * s4 + 1]; s += l.z * X[4 * s4 + 2]; s += l.w * X[4 * s4 + 3];
        }
        X[i] = s;
      }
      if (tid < 64) {
#pragma unroll
        for (int i = 0; i < 32; ++i) At[i * 72 + tid] = f2bf(X[i]);
      } else {
#pragma unroll
        for (int i = 0; i < 32; ++i) src[i * 64] = X[i];
      }
    }
    if (n + 1 < SEQ / 32) load2a(n + 1, R);
    __syncthreads();
    {
      f32x4 Dacc[2];
#pragma unroll
      for (int q2 = 0; q2 < 2; ++q2)
#pragma unroll
        for (int jj = 0; jj < 4; ++jj) Dacc[q2][jj] = AV[(mi * 16 + fq * 4 + jj) * 64 + (nt0 + q2) * 16 + fr];
#pragma unroll
      for (int ks = 0; ks < 2; ++ks) {
        const bf16x8 fwa = *reinterpret_cast<const bf16x8*>((char*)At + (mi * 16 + fr) * 144 + ks * 64 + fq * 16);
        const bf16x8 frr = *reinterpret_cast<const bf16x8*>((char*)Rt + (mi * 16 + fr) * 144 + ks * 64 + fq * 16);
#pragma unroll
        for (int q2 = 0; q2 < 2; ++q2) {
          const bf16x8 sb = *reinterpret_cast<const bf16x8*>((char*)St + ((nt0 + q2) * 16 + fr) * 144 + ks * 64 + fq * 16);
          Dacc[q2] = __builtin_amdgcn_mfma_f32_16x16x32_bf16(fwa, sb, Dacc[q2], 0, 0, 0);
          Yacc[q2] = __builtin_amdgcn_mfma_f32_16x16x32_bf16(frr, sb, Yacc[q2], 0, 0, 0);
        }
      }
#pragma unroll
      for (int q2 = 0; q2 < 2; ++q2) {
        u16x4 o; o[0] = f2bf(Dacc[q2][0]); o[1] = f2bf(Dacc[q2][1]); o[2] = f2bf(Dacc[q2][2]); o[3] = f2bf(Dacc[q2][3]);
        *reinterpret_cast<u16x4*>((char*)Dt + ((nt0 + q2) * 16 + fr) * 80 + (mi * 16 + fq * 4) * 2) = o;
      }
      __syncthreads();
      const bf16x8 farb = *reinterpret_cast<const bf16x8*>((char*)Arb + (mi * 16 + fr) * 80 + fq * 16);
      const bf16x8 fbh = *reinterpret_cast<const bf16x8*>((char*)BHT + (w * 16 + fr) * 80 + fq * 16);
      float pc[4];
#pragma unroll
      for (int jj = 0; jj < 4; ++jj) pc[jj] = pcs[w * 16 + fq * 4 + jj];
#pragma unroll
      for (int nt = 0; nt < 4; ++nt) {
        const bf16x8 db = *reinterpret_cast<const bf16x8*>((char*)Dt + (nt * 16 + fr) * 80 + fq * 16);
        if (nt == nt0 || nt == nt0 + 1) Yacc[nt - nt0] = __builtin_amdgcn_mfma_f32_16x16x32_bf16(farb, db, Yacc[nt - nt0], 0, 0, 0);
#pragma unroll
        for (int jj = 0; jj < 4; ++jj) Sacc[nt][jj] = Sacc[nt][jj] * pc[jj] + SVacc[nt][jj];
        Sacc[nt] = __builtin_amdgcn_mfma_f32_16x16x32_bf16(fbh, db, Sacc[nt], 0, 0, 0);
        u16x4 o; o[0] = f2bf(Sacc[nt][0]); o[1] = f2bf(Sacc[nt][1]); o[2] = f2bf(Sacc[nt][2]); o[3] = f2bf(Sacc[nt][3]);
        *reinterpret_cast<u16x4*>((char*)St + (nt * 16 + fr) * 144 + (w * 16 + fq * 4) * 2) = o;
      }
#pragma unroll
      for (int q2 = 0; q2 < 2; ++q2)
#pragma unroll
        for (int jj = 0; jj < 4; ++jj) Af[(mi * 16 + fq * 4 + jj) * 64 + (nt0 + q2) * 16 + fr] = Yacc[q2][jj];
    }
    __syncthreads();
    {
      const float4 y0 = *reinterpret_cast<const float4*>(Af + i2 * 64 + c0), y1 = *reinterpret_cast<const float4*>(Af + i2 * 64 + c0 + 4);
      float sm = (y0.x + y0.y + y0.z + y0.w) + (y1.x + y1.y + y1.z + y1.w);
      sm += __shfl_xor(sm, 1); sm += __shfl_xor(sm, 2); sm += __shfl_xor(sm, 4);
      const float mean = sm * (1.f / 64.f);
      float d, vs = 0.f;
      d = y0.x - mean; vs += d * d; d = y0.y - mean; vs += d * d; d = y0.z - mean; vs += d * d; d = y0.w - mean; vs += d * d;
      d = y1.x - mean; vs += d * d; d = y1.y - mean; vs += d * d; d = y1.z - mean; vs += d * d; d = y1.w - mean; vs += d * d;
      vs += __shfl_xor(vs, 1); vs += __shfl_xor(vs, 2); vs += __shfl_xor(vs, 4);
      if ((tid & 7) == 0) { stat[i2 * 2] = mean; stat[i2 * 2 + 1] = rsqrtf(vs * (1.f / 64.f) + GN_EPS); }
    }
    __syncthreads();
#pragma unroll
    for (int q = 0; q < 8; ++q) {
      const int i = w * 8 + q;
      const float yn = (Af[i * 64 + lane] - stat[i * 2]) * stat[i * 2 + 1];
      DA[(size_t)(rowb + nq * 32 + i) * 512 + ch] = f2bf((yn * lnw + lnb + dots[i] * vq[q]) * bf2f(gq[q]));
    }
    __syncthreads();
  }
  float* so = p.out + OUT_WKV_P + ((size_t)b * 8 + h) * 4096;
#pragma unroll
  for (int nt = 0; nt < 4; ++nt)
#pragma unroll
    for (int jj = 0; jj < 4; ++jj) so[(nt * 16 + fr) * 64 + w * 16 + fq * 4 + jj] = Sacc[nt][jj];
}

__device__ __forceinline__ void gdn_scan_chain(const Params& p, int b, int h) {
  const int tid = threadIdx.x, lane = tid & 63, w = tid >> 6, fr = lane & 15, fq = lane >> 4;
  unsigned char* St = smem;
  unsigned char* Vt = smem + 128 * 272;
  u16* PJ = (u16*)(p.ws + OFF_PROJ);
  const float* gnorm = p.in[24];
  f32x4 Sacc[2][8];
#pragma unroll
  for (int m = 0; m < 2; ++m)
#pragma unroll
    for (int nt = 0; nt < 8; ++nt) Sacc[m][nt] = f32x4{0.f, 0.f, 0.f, 0.f};
  for (int i = tid; i < 128 * 272 / 16; i += 256) *reinterpret_cast<f32x4*>(St + i * 16) = f32x4{0.f, 0.f, 0.f, 0.f};
  __syncthreads();
  float gn[8];
#pragma unroll
  for (int nt = 0; nt < 8; ++nt) gn[nt] = gnorm[nt * 16 + fr];
  for (int n = 0; n < 32; ++n) {
    const int item = (b * 4 + h) * 32 + n; const size_t eb = (size_t)item * 8192;
    const u16* EUT = (const u16*)((const unsigned char*)p.out + EO_UT) + eb; const u16* EWN = (const u16*)((const unsigned char*)p.out + EO_WN) + eb;
    const u16* EQG = (const u16*)((const unsigned char*)p.out + EO_QG) + eb; const u16* EKD = (const u16*)((const unsigned char*)p.out + EO_KDT) + eb;
    const u16* QK = (const u16*)(p.ws + OFF_QK) + (size_t)item * 4096;
    const float gl = ((const float*)(p.ws + OFF_GL))[item];
    bf16x8 wn[4], qg[4], qk[2], kd[2][2];
#pragma unroll
    for (int kk = 0; kk < 4; ++kk) { wn[kk] = *reinterpret_cast<const bf16x8*>(EWN + (w * 16 + fr) * 128 + kk * 32 + fq * 8); qg[kk] = *reinterpret_cast<const bf16x8*>(EQG + (w * 16 + fr) * 128 + kk * 32 + fq * 8); }
#pragma unroll
    for (int k2 = 0; k2 < 2; ++k2) { qk[k2] = *reinterpret_cast<const bf16x8*>(QK + (w * 16 + fr) * 64 + k2 * 32 + fq * 8);
#pragma unroll
      for (int m = 0; m < 2; ++m) kd[m][k2] = *reinterpret_cast<const bf16x8*>(EKD + (w * 32 + m * 16 + fr) * 64 + k2 * 32 + fq * 8); }
    f32x4 Vacc[8], Oacc[8];
#pragma unroll
    for (int nt = 0; nt < 8; ++nt) {
      const u16x4 u4 = *reinterpret_cast<const u16x4*>(EUT + (nt * 16 + fr) * 64 + w * 16 + fq * 4);
      Vacc[nt] = f32x4{bf2f(u4[0]), bf2f(u4[1]), bf2f(u4[2]), bf2f(u4[3])}; Oacc[nt] = f32x4{0.f, 0.f, 0.f, 0.f};
    }
#pragma unroll
    for (int nt = 0; nt < 8; ++nt)
#pragma unroll
      for (int kk = 0; kk < 4; ++kk) {
        const bf16x8 sb = *reinterpret_cast<const bf16x8*>(St + (nt * 16 + fr) * 272 + kk * 64 + fq * 16);
        Vacc[nt] = __builtin_amdgcn_mfma_f32_16x16x32_bf16(wn[kk], sb, Vacc[nt], 0, 0, 0);
        Oacc[nt] = __builtin_amdgcn_mfma_f32_16x16x32_bf16(qg[kk], sb, Oacc[nt], 0, 0, 0);
      }
#pragma unroll
    for (int nt = 0; nt < 8; ++nt) {
      u16x4 o; o[0] = f2bf(Vacc[nt][0]); o[1] = f2bf(Vacc[nt][1]); o[2] = f2bf(Vacc[nt][2]); o[3] = f2bf(Vacc[nt][3]);
      *reinterpret_cast<u16x4*>(Vt + (nt * 16 + fr) * 144 + (w * 16 + fq * 4) * 2) = o;
    }
    __syncthreads();
#pragma unroll
    for (int m = 0; m < 2; ++m)
#pragma unroll
      for (int nt = 0; nt < 8; ++nt) Sacc[m][nt] *= gl;
#pragma unroll
    for (int nt = 0; nt < 8; ++nt)
#pragma unroll
      for (int k2 = 0; k2 < 2; ++k2) {
        const bf16x8 vb = *reinterpret_cast<const bf16x8*>(Vt + (nt * 16 + fr) * 144 + k2 * 64 + fq * 16);
        Oacc[nt] = __builtin_amdgcn_mfma_f32_16x16x32_bf16(qk[k2], vb, Oacc[nt], 0, 0, 0);
        Sacc[0][nt] = __builtin_amdgcn_mfma_f32_16x16x32_bf16(kd[0][k2], vb, Sacc[0][nt], 0, 0, 0);
        Sacc[1][nt] = __builtin_amdgcn_mfma_f32_16x16x32_bf16(kd[1][k2], vb, Sacc[1][nt], 0, 0, 0);
      }
#pragma unroll
    for (int m = 0; m < 2; ++m)
#pragma unroll
      for (int nt = 0; nt < 8; ++nt) {
        u16x4 o; o[0] = f2bf(Sacc[m][nt][0]); o[1] = f2bf(Sacc[m][nt][1]); o[2] = f2bf(Sacc[m][nt][2]); o[3] = f2bf(Sacc[m][nt][3]);
        *reinterpret_cast<u16x4*>(St + (nt * 16 + fr) * 272 + (w * 32 + m * 16 + fq * 4) * 2) = o;
      }
    {
      float ss[4] = {0.f, 0.f, 0.f, 0.f};
#pragma unroll
      for (int nt = 0; nt < 8; ++nt)
#pragma unroll
        for (int j = 0; j < 4; ++j) ss[j] += Oacc[nt][j] * Oacc[nt][j];
#pragma unroll
      for (int j = 0; j < 4; ++j) {
        const float rs = rsqrtf(sum16(ss[j]) * (1.f / 128.f) + NORM_EPS);
        const int row = b * SEQ + n * 64 + w * 16 + fq * 4 + j;
        u16* zp = PJ + (size_t)row * PCOLS + 3328 + h * 128;
#pragma unroll
        for (int nt = 0; nt < 8; ++nt) { const int v = nt * 16 + fr; const float z = bf2f(zp[v]); zp[v] = f2bf(Oacc[nt][j] * rs * gn[nt] * siluf_(z)); }
      }
    }
    __syncthreads();
  }
  float* so = p.out + OUT_GDN_P + ((size_t)b * 4 + h) * 16384;
#pragma unroll
  for (int m = 0; m < 2; ++m)
#pragma unroll
    for (int nt = 0; nt < 8; ++nt)
#pragma unroll
      for (int j = 0; j < 4; ++j) so[(w * 32 + m * 16 + fq * 4 + j) * 128 + nt * 16 + fr] = Sacc[m][nt][j];
}

__device__ __forceinline__ void gdn_sample_item(const Params& p, int b, int h) {
  const int tid = threadIdx.x, lane = tid & 63;
  float* cs = (float*)smem;
  float* red = cs + 384;
  float* sc = red + 512;
  const int row = NP + b;
  const u16* PJ = (const u16*)(p.ws + OFF_PROJ);
  const float* st = p.in[6] + (size_t)b * 4608; const float* cw = p.in[21];
  for (int i = tid; i < 384; i += 256) {
    const int which = i >> 7, c = i & 127, ch = which * 512 + h * 128 + c;
    float acc = st[ch] * cw[ch] + st[1536 + ch] * cw[1536 + ch] + st[3072 + ch] * cw[3072 + ch] + bf2f(PJ[(size_t)row * PCOLS + A_COLS + ch]) * cw[4608 + ch];
    cs[i] = siluf_(acc);
  }
  __syncthreads();
  if (tid < 128) {
    const int which = tid >> 6;
    const float x0 = cs[which * 128 + lane], x1 = cs[which * 128 + 64 + lane];
    const float ss = sum64(x0 * x0 + x1 * x1);
    const float s = rsqrtf(ss + 1e-6f) * (which == 0 ? 0.08838834764831845f : 1.f);
    cs[which * 128 + lane] = x0 * s; cs[which * 128 + 64 + lane] = x1 * s;
  }
  if (tid == 128) {
    const float* AB = (const float*)(p.ws + OFF_AB) + (size_t)row * 8;
    sc[0] = sigmoidf_(AB[h]); sc[1] = __expf(-__expf(p.in[22][h]) * softplusf_(AB[4 + h] + p.in[23][h]));
  }
  __syncthreads();
  if (tid < 64) { const float d = sum64(cs[lane] * cs[128 + lane] + cs[64 + lane] * cs[192 + lane]); if (lane == 0) sc[2] = d; }
  const int v = tid & 127, kh = tid >> 7;
  const float* S0 = p.in[7] + ((size_t)b * 4 + h) * 16384;
  float S[64]; float ks = 0.f, qs = 0.f;
#pragma unroll
  for (int k = 0; k < 64; ++k) { S[k] = S0[(kh * 64 + k) * 128 + v]; ks += cs[128 + kh * 64 + k] * S[k]; qs += cs[kh * 64 + k] * S[k]; }
  red[kh * 128 + v] = ks; red[256 + kh * 128 + v] = qs;
  __syncthreads();
  const float beta = sc[0], eg = sc[1], qk = sc[2];
  const float kS = red[v] + red[128 + v], qS = red[256 + v] + red[384 + v];
  const float vnew = beta * (cs[256 + v] - eg * kS);
  const float o = eg * qS + qk * vnew;
  float* so = p.out + OUT_GDN_S + ((size_t)b * 4 + h) * 16384;
#pragma unroll
  for (int k = 0; k < 64; ++k) so[(kh * 64 + k) * 128 + v] = S[k] * eg + cs[128 + kh * 64 + k] * vnew;
  __syncthreads();
  if (tid < 128) red[tid] = o * o;
  __syncthreads();
  if (tid < 64) { const float s = sum64(red[lane] + red[64 + lane]); if (lane == 0) sc[3] = s; }
  __syncthreads();
  if (tid < 128) {
    const float rs = rsqrtf(sc[3] * (1.f / 128.f) + NORM_EPS);
    u16* zp = (u16*)(p.ws + OFF_PROJ) + (size_t)row * PCOLS + 3328 + h * 128 + v;
    const float z = bf2f(*zp);
    *zp = f2bf(o * rs * p.in[24][v] * siluf_(z));
  }
  __syncthreads();
}

__device__ __forceinline__ void phase_branches(const Params& p) {
  constexpr int NRT = MR / 128;
  u16* PA = (u16*)(p.ws + OFF_DE); u16* PB = (u16*)p.out;
  for (int t = blockIdx.x; t < 2 * 8 * NRT; t += gridDim.x) {
    const int which = t / (8 * NRT), r2 = t - which * 8 * NRT; const int ct = r2 & 7, rt = r2 >> 3;
    const int row0 = rt * 128, col0 = ct * 128;
    f32x4 acc[4][4];
    if (which == 0) gemm_mainloop((const u16*)(p.ws + OFF_DA) + (size_t)row0 * 512, 512, (const u16*)(p.ws + OFF_WAT) + (size_t)col0 * 512, 512, 512, acc);
    else gemm_mainloop((const u16*)(p.ws + OFF_PROJ) + (size_t)row0 * PCOLS + 3328, PCOLS, (const u16*)(p.ws + OFF_WBT) + (size_t)col0 * 512, 512, 512, acc);
    u16* O = which == 0 ? PA : PB;
    EPI_COORDS
#pragma unroll
    for (int m = 0; m < 4; ++m)
#pragma unroll
      for (int j = 0; j < 4; ++j) {
        const int row = row0 + wr_ * 64 + m * 16 + fq_ * 4 + j;
#pragma unroll
        for (int n = 0; n < 4; ++n) O[(size_t)row * 1024 + col0 + wc_ * 64 + n * 16 + fr_] = f2bf(acc[m][n][j]);
      }
  }
  u16* PE = (u16*)(p.ws + OFF_LIN);
  const int gt = blockIdx.x * 256 + threadIdx.x, nt = gridDim.x * 256;
  for (int i = gt; i < MR * 64; i += nt) {
    const int row = i >> 6, c4 = (i & 63) * 4;
    const float* src = row < NP ? p.in[2] + (size_t)row * 256 : p.in[3] + (size_t)(row - NP) * 256;
    const float4 v = *reinterpret_cast<const float4*>(src + c4);
    u16x4 o; o[0] = f2bf(v.x); o[1] = f2bf(v.y); o[2] = f2bf(v.z); o[3] = f2bf(v.w);
    *reinterpret_cast<u16x4*>(PE + (size_t)row * 256 + c4) = o;
  }
}
__device__ __forceinline__ void phase_gates(const Params& p) {
  constexpr int NRT = MR / 128;
  u16* PA = (u16*)(p.ws + OFF_DE); const u16* PB = (const u16*)p.out;
  for (int t = blockIdx.x; t < 16 * NRT; t += gridDim.x) {
    const int ct = t & 15, rt = t >> 4; const int row0 = rt * 128, col0 = ct * 128;
    f32x4 acc[4][4];
    gemm_mainloop((const u16*)(p.ws + OFF_U) + (size_t)row0 * 1024, 1024, (const u16*)(p.ws + OFF_WGI) + (size_t)col0 * 1024, 1024, 1024, acc);
    EPI_COORDS
#pragma unroll
    for (int m = 0; m < 4; ++m)
#pragma unroll
      for (int j = 0; j < 4; ++j) {
        const int row = row0 + wr_ * 64 + m * 16 + fq_ * 4 + j;
#pragma unroll
        for (int q = 0; q < 2; ++q) {
          const int col = (col0 + wc_ * 64) / 2 + q * 16 + fr_;
          const size_t o = (size_t)row * 1024 + col;
          PA[o] = f2bf(sigmoidf_(acc[m][2 * q][j]) * bf2f(PA[o]) + sigmoidf_(acc[m][2 * q + 1][j]) * bf2f(PB[o]));
        }
      }
  }
}
__device__ __forceinline__ void phase_wout(const Params& p) {
  constexpr int NRT = MR / 128;
  u16* HG = (u16*)(p.ws + OFF_U); float* rss = (float*)(p.ws + OFF_RSS); const float* gain = p.in[28];
  for (int t = blockIdx.x; t < 8 * NRT; t += gridDim.x) {
    const int ct = t & 7, rt = t >> 3; const int row0 = rt * 128, col0 = ct * 128;
    f32x4 acc[4][4];
    gemm_mainloop((const u16*)(p.ws + OFF_DE) + (size_t)row0 * 1024, 1024, (const u16*)(p.ws + OFF_WOT) + (size_t)col0 * 1024, 1024, 1024, acc);
    EPI_COORDS
#pragma unroll
    for (int m = 0; m < 4; ++m)
#pragma unroll
      for (int j = 0; j < 4; ++j) {
        const int row = row0 + wr_ * 64 + m * 16 + fq_ * 4 + j; const float* xr = xrow(p, row); float ss = 0.f;
#pragma unroll
        for (int n = 0; n < 4; ++n) {
          const int col = col0 + wc_ * 64 + n * 16 + fr_;
          const float hv = xr[col] + acc[m][n][j];
          p.out[(size_t)row * 1024 + col] = hv; HG[(size_t)row * 1024 + col] = f2bf(hv * gain[col]); ss += hv * hv;
        }
        ss = sum16(ss);
        if (fr_ == 0) atomicAdd(rss + row, ss);
      }
  }
}
__device__ __forceinline__ void phase_ffn_up(const Params& p) {
  constexpr int NRT = MR / 128;
  u16* ACT = (u16*)(p.ws + OFF_ACT); const float* rss = (const float*)(p.ws + OFF_RSS);
  for (int t = blockIdx.x; t < 44 * NRT; t += gridDim.x) {
    const int ct = t % 44, rt = t / 44; const int row0 = rt * 128, col0 = ct * 128;
    f32x4 acc[4][4];
    gemm_mainloop((const u16*)(p.ws + OFF_U) + (size_t)row0 * 1024, 1024, (const u16*)(p.ws + OFF_WGU) + (size_t)col0 * 1024, 1024, 1024, acc);
    EPI_COORDS
#pragma unroll
    for (int m = 0; m < 4; ++m)
#pragma unroll
      for (int j = 0; j < 4; ++j) {
        const int row = row0 + wr_ * 64 + m * 16 + fq_ * 4 + j;
        const float rs = rsqrtf(rss[row] * (1.f / 1024.f) + NORM_EPS);
#pragma unroll
        for (int q = 0; q < 2; ++q) {
          const int col = (col0 + wc_ * 64) / 2 + q * 16 + fr_;
          ACT[(size_t)row * DFF + col] = f2bf(siluf_(rs * acc[m][2 * q][j]) * (rs * acc[m][2 * q + 1][j]));
        }
      }
  }
}
__device__ __forceinline__ void phase_ffn_down(const Params& p) {
  constexpr int NRT = MR / 128;
  u16* HG = (u16*)(p.ws + OFF_U); float* rss = (float*)(p.ws + OFF_RSS) + MR; const float* gain = p.in[32];
  u16* PP = (u16*)(p.ws + OFF_PP);
  for (int t = blockIdx.x; t < 16 * NRT; t += gridDim.x) {
    const int which = t / (8 * NRT), r2 = t - which * 8 * NRT; const int ct = r2 & 7, rt = r2 >> 3; const int row0 = rt * 128, col0 = ct * 128;
    f32x4 acc[4][4];
    if (which == 0) {
      gemm_mainloop((const u16*)(p.ws + OFF_ACT) + (size_t)row0 * DFF, DFF, (const u16*)(p.ws + OFF_WDT) + (size_t)col0 * DFF, DFF, DFF, acc);
      EPI_COORDS
#pragma unroll
      for (int m = 0; m < 4; ++m)
#pragma unroll
        for (int j = 0; j < 4; ++j) {
          const int row = row0 + wr_ * 64 + m * 16 + fq_ * 4 + j; float ss = 0.f;
#pragma unroll
          for (int n = 0; n < 4; ++n) {
            const int col = col0 + wc_ * 64 + n * 16 + fr_; const size_t o = (size_t)row * 1024 + col;
            const float hv = p.out[o] + acc[m][n][j];
            p.out[o] = hv; HG[o] = f2bf(hv * gain[col]); ss += hv * hv;
          }
          ss = sum16(ss);
          if (fr_ == 0) atomicAdd(rss + row, ss);
        }
    } else {
      gemm_mainloop((const u16*)(p.ws + OFF_LIN) + (size_t)row0 * 256, 256, (const u16*)(p.ws + OFF_WPP) + (size_t)col0 * 256, 256, 256, acc);
      EPI_COORDS
#pragma unroll
      for (int m = 0; m < 4; ++m)
#pragma unroll
        for (int j = 0; j < 4; ++j) {
          const int row = row0 + wr_ * 64 + m * 16 + fq_ * 4 + j;
#pragma unroll
          for (int n = 0; n < 4; ++n) PP[(size_t)row * 1024 + col0 + wc_ * 64 + n * 16 + fr_] = f2bf(acc[m][n][j]);
        }
    }
  }
}
__device__ __forceinline__ void phase_ple(const Params& p) {
  constexpr int NRT = MR / 128;
  const float* rss2 = (const float*)(p.ws + OFF_RSS) + MR; float* rss3 = (float*)(p.ws + OFF_RSS) + 2 * MR;
  const u16* PP = (const u16*)(p.ws + OFF_PP);
  for (int t = blockIdx.x; t < 8 * NRT; t += gridDim.x) {
    const int ct = t & 7, rt = t >> 3; const int row0 = rt * 128, col0 = ct * 128;
    f32x4 acc[4][4];
    gemm_mainloop((const u16*)(p.ws + OFF_U) + (size_t)row0 * 1024, 1024, (const u16*)(p.ws + OFF_WPG) + (size_t)col0 * 1024, 1024, 1024, acc);
    EPI_COORDS
#pragma unroll
    for (int m = 0; m < 4; ++m)
#pragma unroll
      for (int j = 0; j < 4; ++j) {
        const int row = row0 + wr_ * 64 + m * 16 + fq_ * 4 + j; float ss = 0.f;
        const float rs = rsqrtf(rss2[row] * (1.f / 1024.f) + NORM_EPS);
#pragma unroll
        for (int n = 0; n < 4; ++n) {
          const int col = col0 + wc_ * 64 + n * 16 + fr_; const size_t o = (size_t)row * 1024 + col;
          const float hv = p.out[o] + sigmoidf_(rs * acc[m][n][j]) * bf2f(PP[o]);
          p.out[o] = hv; ss += hv * hv;
        }
        ss = sum16(ss);
        if (fr_ == 0) atomicAdd(rss3 + row, ss);
      }
  }
}
__device__ __forceinline__ void phase_final(const Params& p) {
  const float* rss3 = (const float*)(p.ws + OFF_RSS) + 2 * MR; const float* gain = p.in[35];
  const int gt = blockIdx.x * 256 + threadIdx.x, nt = gridDim.x * 256;
  for (int i = gt; i < MR * 256; i += nt) {
    const int row = i >> 8, c4 = (i & 255) * 4;
    const float rs = rsqrtf(rss3[row] * (1.f / 1024.f) + NORM_EPS);
    float4 v = *reinterpret_cast<float4*>(p.out + (size_t)row * 1024 + c4);
    const float4 g = *reinterpret_cast<const float4*>(gain + c4);
    v.x *= rs * g.x; v.y *= rs * g.y; v.z *= rs * g.z; v.w *= rs * g.w;
    *reinterpret_cast<float4*>(p.out + (size_t)row * 1024 + c4) = v;
  }
}


#define XB_TMO      128
#define XB_XCNT(j)  (256  + 64 * (j))
#define XB_XSUB(j)  (1280 + 64 * (j))
#define XB_XGEN(j)  (2304 + 64 * (j))
#define XB_TOP      3328
#define XB_TOPGEN   3392
#define XCD_BAR_WORDS 3456
#define XB_SPIN_CAP (1u << 22)
#define LAS __attribute__((address_space(3)))
__device__ __forceinline__ unsigned xb_ld(unsigned* p) { return __hip_atomic_load(p, __ATOMIC_RELAXED, __HIP_MEMORY_SCOPE_AGENT); }
__device__ __forceinline__ unsigned xb_add(unsigned* p, unsigned v) { return __hip_atomic_fetch_add(p, v, __ATOMIC_RELAXED, __HIP_MEMORY_SCOPE_AGENT); }
__device__ __forceinline__ unsigned xb_xcc_id() { return (unsigned)__builtin_amdgcn_s_getreg((3 << 11) | 20) & 0xFu; }
#define XB_SPIN(cond, bar) do { unsigned _sp = 0; while (cond) { __builtin_amdgcn_s_sleep(1); \
    if ((++_sp & 255u) == 0u) { if (xb_ld(&(bar)[XB_TMO])) break; if (_sp > XB_SPIN_CAP) { atomicAdd(&(bar)[XB_TMO], 1u); break; } } } } while (0)
struct XcdBarrier { unsigned* bar; unsigned x; volatile LAS unsigned* st; };
__device__ __forceinline__ XcdBarrier xcd_barrier_post(unsigned* bar, volatile LAS unsigned* st) {
  XcdBarrier b; b.bar = bar; b.x = xb_xcc_id(); b.st = st;
  if (threadIdx.x == 0) (void)xb_add(&bar[XB_XCNT(b.x)], 1u);
  return b;
}
__device__ __forceinline__ void xcd_barrier_complete(unsigned* bar, unsigned x, unsigned& nloc, unsigned& nx) {
  const unsigned G = gridDim.x * gridDim.y * gridDim.z;
  unsigned sum, cnt, mine, sp = 0u;
  for (;;) {
    sum = 0u; cnt = 0u; mine = 0u;
#pragma unroll
    for (unsigned j = 0; j < 16; ++j) { const unsigned c = xb_ld(&bar[XB_XCNT(j)]); sum += c; cnt += (c > 0u) ? 1u : 0u; mine = (j == x) ? c : mine; }
    if (sum == G) break;
    __builtin_amdgcn_s_sleep(1);
    if ((++sp & 255u) == 0u) { if (xb_ld(&bar[XB_TMO])) break; if (sp > XB_SPIN_CAP) { atomicAdd(&bar[XB_TMO], 1u); break; } }
  }
  nloc = mine > 0u ? mine : 1u; nx = cnt > 0u ? cnt : 1u;
}
__device__ __forceinline__ void xcd_barrier(const XcdBarrier& b) {
  asm volatile("s_waitcnt vmcnt(0)" ::: "memory");
  __syncthreads();
  if (threadIdx.x == 0) {
    unsigned* bar = b.bar;
    __builtin_amdgcn_s_waitcnt(0);
    unsigned nloc = b.st[0], nx = b.st[1];
    if (nloc == 0u) { xcd_barrier_complete(bar, b.x, nloc, nx); b.st[0] = nloc; b.st[1] = nx; }
    const unsigned old = xb_add(&bar[XB_XSUB(b.x)], 1u);
    const unsigned gen = old / nloc;
    if (old + 1u == (gen + 1u) * nloc) {
      __builtin_amdgcn_fence(__ATOMIC_RELEASE, "agent");
      asm volatile("s_waitcnt vmcnt(0)" ::: "memory");
      const unsigned og = xb_add(&bar[XB_TOP], 1u);
      const unsigned tg = og / nx;
      if (og + 1u == (tg + 1u) * nx) xb_add(&bar[XB_TOPGEN], 1u);
      else XB_SPIN(xb_ld(&bar[XB_TOPGEN]) == tg, bar);
      __builtin_amdgcn_fence(__ATOMIC_ACQUIRE, "agent");
      xb_add(&bar[XB_XGEN(b.x)], 1u);
      asm volatile("s_waitcnt vmcnt(0)" ::: "memory");
    } else {
      XB_SPIN(xb_ld(&bar[XB_XGEN(b.x)]) == gen, bar);
      __builtin_amdgcn_fence(__ATOMIC_ACQUIRE, "agent");
      asm volatile("s_waitcnt vmcnt(0)" ::: "memory");
    }
  }
  __syncthreads();
}

__global__ void __launch_bounds__(256, 2) hybrid_fwd(Params p) {
  cg::grid_group grid = cg::this_grid();
  volatile LAS unsigned* xst = (volatile LAS unsigned*)(smem + LDS_BYTES - 16);
  if (threadIdx.x == 0) { xst[0] = 0u; xst[1] = 0u; }
  __syncthreads();
  const XcdBarrier xb = xcd_barrier_post((unsigned*)(p.ws + OFF_BAR), xst);
  phase_prep(p);
  grid.sync();
  phase_proj(p);
  xcd_barrier(xb);
  phase_lora_in(p);
  for (int it = blockIdx.x; it < 1024; it += gridDim.x) gdn_prep_item(p, it);
  xcd_barrier(xb);
  phase_lora(p);
  xcd_barrier(xb);
  {
    const int G = gridDim.x, bid = blockIdx.x;
    if (bid < 64) rwkv_chunked(p, bid >> 3, bid & 7);
    else if (bid < 96) gdn_scan_chain(p, (bid - 64) >> 2, (bid - 64) & 3);
    else {
      for (int it = bid - 96; it < 1024; it += G - 96) rwkv_chain<true>(p, 8 + (it >> 3), it & 7);
      for (int it = (G - 1 - bid); it < 512; it += G - 96) gdn_sample_item(p, it >> 2, it & 3);
    }
  }
  xcd_barrier(xb);
  phase_branches(p);
  xcd_barrier(xb);
  phase_gates(p);
  xcd_barrier(xb);
  phase_wout(p);
  xcd_barrier(xb);
  phase_ffn_up(p);
  xcd_barrier(xb);
  phase_ffn_down(p);
  xcd_barrier(xb);
  phase_ple(p);
  xcd_barrier(xb);
  phase_final(p);
}

extern "C" void kernel_launch(void* const* d_in, const int* in_sizes, int n_in, void* d_out, int out_size, void* d_ws, size_t ws_size,
                              hipStream_t stream) {
  static int grid_blocks = 0;
  if (!grid_blocks) {
    int dev = 0, cus = 0, per_cu = 0;
    hipGetDevice(&dev);
    hipDeviceGetAttribute(&cus, hipDeviceAttributeMultiprocessorCount, dev);
    hipFuncSetAttribute((const void*)hybrid_fwd, hipFuncAttributeMaxDynamicSharedMemorySize, LDS_BYTES);
    hipOccupancyMaxActiveBlocksPerMultiprocessor(&per_cu, (const void*)hybrid_fwd, 256, LDS_BYTES);
    if (per_cu > 2) per_cu = 2;
    if (per_cu < 1) per_cu = 1;
    grid_blocks = cus * per_cu;
  }
  Params p{};
  for (int i = 0; i < 36; ++i) p.in[i] = (const float*)d_in[i];
  p.out = (float*)d_out; p.ws = (unsigned char*)d_ws;
  (void)hipMemsetAsync((unsigned char*)d_ws + OFF_BAR, 0, 16384, stream);
  void* args[] = {&p};
  hipError_t e = hipLaunchCooperativeKernel((const void*)hybrid_fwd, dim3(grid_blocks), dim3(256), args, LDS_BYTES, stream);
  if (e != hipSuccess) fprintf(stderr, "cooperative launch failed: %s (grid %d)\n", hipGetErrorString(e), grid_blocks);
}
```

```cpp
#include <hip/hip_runtime.h>
#include <hip/hip_bf16.h>
#include <hip/hip_cooperative_groups.h>
#include <cstdio>
namespace cg = cooperative_groups;

typedef unsigned short u16;
using bf16x8 = __attribute__((ext_vector_type(8))) short;
using u16x4 = __attribute__((ext_vector_type(4))) unsigned short;
using f32x4 = __attribute__((ext_vector_type(4))) float;

constexpr int D = 1024, NP = 16384, NS = 128, MR = NP + NS;
constexpr int SEQ = 2048;
constexpr int A_COLS = 1792, PCOLS = 3848;
constexpr int IN_COLS = 5896, DFF = 2816;
constexpr float NORM_EPS = 1e-6f, GN_EPS = 64e-5f;

constexpr long OUT_Y = 0;
constexpr long OUT_SHIFT_P = (long)MR * D;
constexpr long OUT_WKV_P = OUT_SHIFT_P + 8 * 1792;
constexpr long OUT_CONV_P = OUT_WKV_P + 8L * 8 * 64 * 64;
constexpr long OUT_GDN_P = OUT_CONV_P + 8 * 3 * 1536;
constexpr long OUT_SHIFT_S = OUT_GDN_P + 8L * 4 * 128 * 128;
constexpr long OUT_WKV_S = OUT_SHIFT_S + 128 * 1792;
constexpr long OUT_CONV_S = OUT_WKV_S + 128L * 8 * 64 * 64;
constexpr long OUT_GDN_S = OUT_CONV_S + 128 * 3 * 1536;

constexpr size_t OFF_WINT = 0;
constexpr size_t OFF_WGI = OFF_WINT + (size_t)PCOLS * 1024 * 2;
constexpr size_t OFF_W2T = OFF_WGI + (size_t)2048 * 1024 * 2;
constexpr size_t OFF_A2T = OFF_W2T + 512 * 64 * 2;
constexpr size_t OFF_G2T = OFF_A2T + 512 * 64 * 2;
constexpr size_t OFF_WAT = OFF_G2T + 512 * 128 * 2;
constexpr size_t OFF_WBT = OFF_WAT + 1024 * 512 * 2;
constexpr size_t OFF_WOT = OFF_WBT + 1024 * 512 * 2;
constexpr size_t OFF_WGU = OFF_WOT + 1024 * 1024 * 2;
constexpr size_t OFF_WDT = OFF_WGU + (size_t)5632 * 1024 * 2;
constexpr size_t OFF_WPG = OFF_WDT + (size_t)1024 * 2816 * 2;
constexpr size_t OFF_WPP = OFF_WPG + 1024 * 1024 * 2;
constexpr size_t OFF_U = OFF_WPP + 1024 * 256 * 2;
constexpr size_t OFF_PROJ = OFF_U + (size_t)MR * 1024 * 2;
constexpr size_t OFF_DA = OFF_PROJ + (size_t)MR * PCOLS * 2;
constexpr size_t OFF_DE = OFF_DA + (size_t)MR * 512 * 2;
constexpr size_t OFF_DG = OFF_DE + (size_t)MR * 512 * 2;
constexpr size_t OFF_QK = OFF_DG + (size_t)MR * 512 * 2;
constexpr size_t OFF_LIN = OFF_QK + (size_t)1024 * 64 * 64 * 2;
constexpr size_t OFF_RSS = OFF_LIN + (size_t)MR * 256 * 2;
constexpr size_t OFF_AB = OFF_RSS + (size_t)3 * MR * 4;
constexpr size_t OFF_GL = OFF_AB + (size_t)MR * 8 * 4;
constexpr size_t OFF_BAR = OFF_GL + 4096;
constexpr size_t OFF_END = OFF_BAR + 16384;
constexpr size_t OFF_ACT = OFF_PROJ;
constexpr size_t OFF_PP = OFF_PROJ + (size_t)MR * DFF * 2;
static_assert(OFF_PP + (size_t)MR * 1024 * 2 <= OFF_DA, "pp overflow");
static_assert(OFF_END <= 268435456ull, "ws overflow");
constexpr size_t EO_UT = 37748736, EO_WN = EO_UT + 4194304, EO_QG = EO_WN + 4194304, EO_KDT = EO_QG + 4194304;

struct Params { const float* in[36]; float* out; unsigned char* ws; };
typedef const __attribute__((address_space(4))) Params* KP;

extern __shared__ __attribute__((aligned(16))) unsigned char smem[];
constexpr int LDS_BYTES = 72192;

__device__ __forceinline__ int ltid() { int t = threadIdx.x; asm volatile("" : "+v"(t)); return t; }
__device__ __forceinline__ u16 f2bf(float f) { unsigned u = __float_as_uint(f); u += 0x7fffu + ((u >> 16) & 1u); return (u16)(u >> 16); }
__device__ __forceinline__ float bf2f(u16 h) { return __uint_as_float(((unsigned)h) << 16); }
__device__ __forceinline__ float sigmoidf_(float x) { return 1.f / (1.f + __expf(-x)); }
__device__ __forceinline__ float siluf_(float x) { return x / (1.f + __expf(-x)); }
__device__ __forceinline__ float softplusf_(float x) { return fmaxf(x, 0.f) + log1pf(__expf(-fabsf(x))); }
__device__ __forceinline__ float quad_sum(float x) {
  x += __int_as_float(__builtin_amdgcn_update_dpp(0, __float_as_int(x), 0xB1, 0xF, 0xF, true));
  x += __int_as_float(__builtin_amdgcn_update_dpp(0, __float_as_int(x), 0x4E, 0xF, 0xF, true));
  return x;
}
__device__ __forceinline__ float sum16(float x) {
  x += __shfl_xor(x, 1); x += __shfl_xor(x, 2); x += __shfl_xor(x, 4); x += __shfl_xor(x, 8); return x;
}
__device__ __forceinline__ float sum64(float x) { x = sum16(x); x += __shfl_xor(x, 16); x += __shfl_xor(x, 32); return x; }
__device__ __forceinline__ const float* xrow(KP p, int row) {
  return row < NP ? p->in[0] + (size_t)row * D : p->in[1] + (size_t)(row - NP) * D;
}

__device__ __forceinline__ void gemm_mainloop(const u16* __restrict__ A, long lda, const u16* __restrict__ Bt, long ldb, int K,
                                              f32x4 (&acc)[4][4]) {
  const int tid = threadIdx.x, lane = tid & 63, wid = tid >> 6, wr = wid >> 1, wc = wid & 1, fr = lane & 15, fq = lane >> 4;
  unsigned char* SA = smem; unsigned char* SB = smem + 16384;
#pragma unroll
  for (int m = 0; m < 4; ++m)
#pragma unroll
    for (int n = 0; n < 4; ++n) acc[m][n] = f32x4{0.f, 0.f, 0.f, 0.f};
  const int nk = K >> 6;
  for (int kt = 0; kt < nk; ++kt) {
#pragma unroll
    for (int i = 0; i < 4; ++i) {
      const int b = tid * 16 + i * 4096, r = b >> 7, c = (((b & 127) >> 4) ^ (r & 7)) * 8;
      __builtin_amdgcn_global_load_lds((const unsigned*)(A + (long)r * lda + kt * 64 + c), (unsigned*)(SA + b), 16, 0, 0);
      __builtin_amdgcn_global_load_lds((const unsigned*)(Bt + (long)r * ldb + kt * 64 + c), (unsigned*)(SB + b), 16, 0, 0);
    }
    asm volatile("s_waitcnt vmcnt(0)" ::: "memory");
    __syncthreads();
#pragma unroll
    for (int kk = 0; kk < 2; ++kk) {
      bf16x8 a[4], b[4];
#pragma unroll
      for (int m = 0; m < 4; ++m) { const int r = wr * 64 + m * 16 + fr; a[m] = *reinterpret_cast<const bf16x8*>(SA + r * 128 + (((kk * 4 + fq) ^ (r & 7)) << 4)); }
#pragma unroll
      for (int n = 0; n < 4; ++n) { const int r = wc * 64 + n * 16 + fr; b[n] = *reinterpret_cast<const bf16x8*>(SB + r * 128 + (((kk * 4 + fq) ^ (r & 7)) << 4)); }
#pragma unroll
      for (int m = 0; m < 4; ++m)
#pragma unroll
        for (int n = 0; n < 4; ++n) acc[m][n] = __builtin_amdgcn_mfma_f32_16x16x32_bf16(a[m], b[n], acc[m][n], 0, 0, 0);
    }
    __syncthreads();
  }
}

struct XTiles { int x, lb, nb, nr, nct, W, ng, total; };
__device__ __forceinline__ XTiles xt_make(int nrt, int nct, int W) {
  XTiles t; t.x = blockIdx.x & 7; t.lb = blockIdx.x >> 3; t.nb = gridDim.x >> 3;
  t.nr = (nrt - t.x + 7) >> 3; t.nct = nct; t.W = W; t.ng = (nct + W - 1) / W; t.total = t.nr * nct; return t;
}
__device__ __forceinline__ void xt_get(const XTiles& t, int u, int& rt, int& ct) {
  int g = u / (t.W * t.nr); if (g > t.ng - 1) g = t.ng - 1;
  const int rem = u - g * t.W * t.nr; const int wg = (g == t.ng - 1) ? t.nct - g * t.W : t.W;
  const int rl = rem / wg, cl = rem - rl * wg; rt = t.x + 8 * rl; ct = g * t.W + cl;
}
#define EPI_COORDS const int tid_ = threadIdx.x, lane_ = tid_ & 63, wid_ = tid_ >> 6, wr_ = wid_ >> 1, wc_ = wid_ & 1, fr_ = lane_ & 15, fq_ = lane_ >> 4; (void)wc_; (void)wr_; (void)fr_; (void)fq_;

template <int NC>
__device__ __forceinline__ void tile_flush_bf16(u16* __restrict__ dst, long ld, int row0, int col0, int col_limit) {
  __syncthreads();
  const u16* T = (const u16*)smem;
  constexpr int CPR = NC / 8;
#pragma unroll
  for (int i = 0; i < (128 * CPR) / 256; ++i) {
    const int c = threadIdx.x + i * 256, r = c / CPR, chk = c % CPR;
    const bf16x8 v = *reinterpret_cast<const bf16x8*>(T + r * (NC + 8) + chk * 8);
    if (col0 + chk * 8 < col_limit) *reinterpret_cast<bf16x8*>(dst + (long)(row0 + r) * ld + col0 + chk * 8) = v;
  }
  __syncthreads();
}

struct TJob { const float* src; int ld_src; int K; int N; u16* dst; int ld_dst; int ilv; };
__device__ __forceinline__ TJob get_job(KP p, int j) {
  unsigned char* ws = p->ws; TJob t;
  switch (j) {
    case 0: t = TJob{p->in[9], IN_COLS, 1024, PCOLS, (u16*)(ws + OFF_WINT), 1024, 0}; break;
    case 1: t = TJob{p->in[9] + PCOLS, IN_COLS, 1024, 1024, (u16*)(ws + OFF_WGI), 1024, 1}; break;
    case 2: t = TJob{p->in[9] + PCOLS + 1024, IN_COLS, 1024, 1024, (u16*)(ws + OFF_WGI), 1024, 2}; break;
    case 3: t = TJob{p->in[12], 512, 64, 512, (u16*)(ws + OFF_W2T), 64, 0}; break;
    case 4: t = TJob{p->in[14], 512, 64, 512, (u16*)(ws + OFF_A2T), 64, 0}; break;
    case 5: t = TJob{p->in[15], 512, 128, 512, (u16*)(ws + OFF_G2T), 128, 0}; break;
    case 6: t = TJob{p->in[25], 1024, 512, 1024, (u16*)(ws + OFF_WAT), 512, 0}; break;
    case 7: t = TJob{p->in[26], 1024, 512, 1024, (u16*)(ws + OFF_WBT), 512, 0}; break;
    case 8: t = TJob{p->in[27], 1024, 1024, 1024, (u16*)(ws + OFF_WOT), 1024, 0}; break;
    case 9: t = TJob{p->in[29], DFF, 1024, DFF, (u16*)(ws + OFF_WGU), 1024, 1}; break;
    case 10: t = TJob{p->in[30], DFF, 1024, DFF, (u16*)(ws + OFF_WGU), 1024, 2}; break;
    case 11: t = TJob{p->in[31], 1024, DFF, 1024, (u16*)(ws + OFF_WDT), DFF, 0}; break;
    case 12: t = TJob{p->in[33], 1024, 1024, 1024, (u16*)(ws + OFF_WPG), 1024, 0}; break;
    default: t = TJob{p->in[34], 1024, 256, 1024, (u16*)(ws + OFF_WPP), 256, 0}; break;
  }
  return t;
}
__device__ __forceinline__ int job_tiles(const TJob& t) { return (t.K >> 6) * ((t.N + 63) >> 6); }

__device__ __forceinline__ void phase_prep(KP p) {
  const int tid = threadIdx.x;
  float* T = (float*)smem;
  int total = 0;
  for (int j = 0; j < 14; ++j) { TJob t = get_job(p, j); total += job_tiles(t); }
  for (int g = blockIdx.x; g < total; g += gridDim.x) {
    int j = 0, rem = g; TJob t = get_job(p, 0);
    for (;;) { int nt_ = job_tiles(t); if (rem < nt_) break; rem -= nt_; ++j; t = get_job(p, j); }
    const int nkt = t.K >> 6; const int kt = rem % nkt, nt = rem / nkt;
#pragma unroll
    for (int i = 0; i < 4; ++i) {
      const int k = (tid >> 4) + 16 * i, n4 = (tid & 15) * 4, n = nt * 64 + n4;
      float4 v = *reinterpret_cast<const float4*>(t.src + (long)(kt * 64 + k) * t.ld_src + (n < t.N ? n : 0));
      if (n >= t.N) v = make_float4(0.f, 0.f, 0.f, 0.f);
      T[k * 65 + n4 + 0] = v.x; T[k * 65 + n4 + 1] = v.y; T[k * 65 + n4 + 2] = v.z; T[k * 65 + n4 + 3] = v.w;
    }
    __syncthreads();
    {
      const int nl = tid >> 2, kq = (tid & 3) * 16, n = nt * 64 + nl;
      if (n < t.N) {
        const int drow = t.ilv ? ((((n >> 4) * 2 + (t.ilv - 1)) << 4) + (n & 15)) : n;
        bf16x8 o0, o1;
#pragma unroll
        for (int q = 0; q < 8; ++q) { o0[q] = (short)f2bf(T[(kq + q) * 65 + nl]); o1[q] = (short)f2bf(T[(kq + 8 + q) * 65 + nl]); }
        u16* d = t.dst + (long)drow * t.ld_dst + kt * 64 + kq;
        *reinterpret_cast<bf16x8*>(d) = o0; *reinterpret_cast<bf16x8*>(d + 8) = o1;
      }
    }
    __syncthreads();
  }
  {
    const int lane = tid & 63, gw = blockIdx.x * 4 + (tid >> 6), nw = gridDim.x * 4;
    u16* U = (u16*)(p->ws + OFF_U);
    const float* gain = p->in[8];
    for (int row = gw; row < MR; row += nw) {
      const float* x = xrow(p, row);
      float4 v[4]; float ss = 0.f;
#pragma unroll
      for (int i = 0; i < 4; ++i) { v[i] = *reinterpret_cast<const float4*>(x + i * 256 + lane * 4); ss += v[i].x * v[i].x + v[i].y * v[i].y + v[i].z * v[i].z + v[i].w * v[i].w; }
      ss = sum64(ss);
      const float rs = rsqrtf(ss * (1.f / 1024.f) + NORM_EPS);
#pragma unroll
      for (int i = 0; i < 4; ++i) {
        const float4 g4 = *reinterpret_cast<const float4*>(gain + i * 256 + lane * 4);
        u16x4 o; o[0] = f2bf(v[i].x * rs * g4.x); o[1] = f2bf(v[i].y * rs * g4.y); o[2] = f2bf(v[i].z * rs * g4.z); o[3] = f2bf(v[i].w * rs * g4.w);
        *reinterpret_cast<u16x4*>(U + (size_t)row * 1024 + i * 256 + lane * 4) = o;
      }
    }
  }
  {
    float* rss = (float*)(p->ws + OFF_RSS);
    const int gt = blockIdx.x * 256 + tid, nt = gridDim.x * 256;
    for (int i = gt; i < 3 * MR; i += nt) rss[i] = 0.f;
    const float* sc = p->in[6];
    for (int i = gt; i < 128 * 2 * 1536; i += nt) {
      const int b = i / 3072, r = i - b * 3072;
      p->out[OUT_CONV_S + (long)b * 4608 + r] = sc[(long)b * 4608 + 1536 + r];
    }
  }
}

__device__ __forceinline__ void phase_proj(KP p) {
  const u16* U = (const u16*)(p->ws + OFF_U); const u16* W = (const u16*)(p->ws + OFF_WINT);
  u16* PJ = (u16*)(p->ws + OFF_PROJ); float* AB = (float*)(p->ws + OFF_AB);
  constexpr int NCT = 31, NRT = MR / 128;
  const XTiles XT = xt_make(NRT, NCT, 6);
  for (int t = XT.lb; t < XT.total; t += XT.nb) {
    int ct, rt; xt_get(XT, t, rt, ct); const int row0 = rt * 128, col0 = ct * 128;
    f32x4 acc[4][4];
    gemm_mainloop(U + (size_t)row0 * 1024, 1024, W + (size_t)col0 * 1024, 1024, 1024, acc);
    EPI_COORDS
    {
      u16* T = (u16*)smem;
#pragma unroll
      for (int m = 0; m < 4; ++m)
#pragma unroll
        for (int j = 0; j < 4; ++j)
#pragma unroll
          for (int n = 0; n < 4; ++n) T[(wr_ * 64 + m * 16 + fq_ * 4 + j) * 136 + wc_ * 64 + n * 16 + fr_] = f2bf(acc[m][n][j]);
    }
    const bool special = (rt & 15) == 15 || rt == NRT - 1 || ct == NCT - 1;
    if (special) {
#pragma unroll
    for (int m = 0; m < 4; ++m)
#pragma unroll
      for (int j = 0; j < 4; ++j) {
        const int row = row0 + wr_ * 64 + m * 16 + fq_ * 4 + j;
        int shift_b = -1; long shift_off = 0; int conv_j = -1; long conv_off = 0;
        if (row < NP) { const int tt = row & (SEQ - 1), b = row >> 11; if (tt == SEQ - 1) { shift_b = b; shift_off = OUT_SHIFT_P + (long)b * 1792; }
                        if (tt >= SEQ - 3) { conv_j = tt - (SEQ - 3); conv_off = OUT_CONV_P + ((long)b * 3 + conv_j) * 1536; } }
        else { const int b = row - NP; shift_b = b; shift_off = OUT_SHIFT_S + (long)b * 1792; conv_j = 2; conv_off = OUT_CONV_S + ((long)b * 3 + 2) * 1536; }
#pragma unroll
        for (int n = 0; n < 4; ++n) {
          const int col = col0 + wc_ * 64 + n * 16 + fr_;
          const float v = acc[m][n][j];
          if (col < PCOLS) {
            if (col >= 3840) AB[(size_t)row * 8 + (col - 3840)] = v;
            if (shift_b >= 0 && col < A_COLS) p->out[shift_off + col] = v;
            if (conv_j >= 0 && col >= A_COLS && col < A_COLS + 1536) p->out[conv_off + (col - A_COLS)] = v;
          }
        }
      }
    }
    tile_flush_bf16<128>(PJ, PCOLS, row0, col0, PCOLS);
  }
}

__device__ __forceinline__ void phase_lora_in(KP p) {
  const u16* PJ = (const u16*)(p->ws + OFF_PROJ); u16* LIN = (u16*)(p->ws + OFF_LIN);
  const float* mu = p->in[10]; const float* sh = p->in[4];
  const int gt = blockIdx.x * 256 + threadIdx.x, nt = gridDim.x * 256;
  for (int i = gt; i < MR * 64; i += nt) {
    const int row = i >> 6, c4 = (i & 63) * 4, col = 1536 + c4;
    const u16x4 cur = *reinterpret_cast<const u16x4*>(PJ + (size_t)row * PCOLS + col);
    float pv[4];
    {
      const bool hasprev = row < NP && (row & (SEQ - 1)) > 0;
      const u16x4 pr = *reinterpret_cast<const u16x4*>(PJ + (size_t)(hasprev ? row - 1 : row) * PCOLS + col);
      const float4 s4 = *reinterpret_cast<const float4*>(sh + (size_t)(row >= NP ? row - NP : 0) * 1792 + col);
      const float sv[4] = {s4.x, s4.y, s4.z, s4.w};
      for (int q = 0; q < 4; ++q) pv[q] = row >= NP ? sv[q] : (hasprev ? bf2f(pr[q]) : 0.f);
    }
    const float4 m4 = *reinterpret_cast<const float4*>(mu + col);
    const float mm[4] = {m4.x, m4.y, m4.z, m4.w};
    u16x4 o;
#pragma unroll
    for (int q = 0; q < 4; ++q) {
      const float c = bf2f(cur[q]); float x = c + (pv[q] - c) * mm[q];
      if (c4 < 64) x = tanhf(x); else if (c4 >= 128) x = sigmoidf_(x);
      o[q] = f2bf(x);
    }
    *reinterpret_cast<u16x4*>(LIN + (size_t)row * 256 + c4) = o;
  }
}

__device__ __forceinline__ void gdn_prep_item(KP p, int item) {
  const int tid = ltid(), lane = tid & 63, wid = tid >> 6, fr = lane & 15, fq = lane >> 4;
  const int n = item & 31, h = (item >> 5) & 3, b = item >> 7;
  const int rowb = b * SEQ + n * 64;
  const u16* PJ = (const u16*)(p->ws + OFF_PROJ);
  u16* qs = (u16*)smem; u16* ks = qs + 64 * 136; u16* vs = ks + 64 * 136;
  float* Ls = (float*)(smem + 3 * 64 * 136 * 2);
  float* gcs = Ls + 64 * 64; float* betas = gcs + 64; float* egcs = betas + 64;
  const float* cw = p->in[21];
  for (int it = tid; it < 64 * 48; it += 256) {
    const int t = it / 48, cg8 = it - t * 48; const int which = cg8 >> 4, cc = (cg8 & 15) * 8;
    const int ch = which * 512 + h * 128 + cc;
    float acc8[8];
#pragma unroll
    for (int q = 0; q < 8; ++q) acc8[q] = 0.f;
#pragma unroll
    for (int j = 0; j < 4; ++j) {
      const int tt = n * 64 + t - 3 + j; const float mk = tt >= 0 ? 1.f : 0.f;
      {
        const bf16x8 xv = *reinterpret_cast<const bf16x8*>(PJ + (size_t)(b * SEQ + (tt >= 0 ? tt : 0)) * PCOLS + A_COLS + ch);
        const float4 w0 = *reinterpret_cast<const float4*>(cw + j * 1536 + ch), w1 = *reinterpret_cast<const float4*>(cw + j * 1536 + ch + 4);
        const float wv[8] = {w0.x, w0.y, w0.z, w0.w, w1.x, w1.y, w1.z, w1.w};
#pragma unroll
        for (int q = 0; q < 8; ++q) acc8[q] += bf2f((u16)xv[q]) * (wv[q] * mk);
      }
    }
    bf16x8 o;
#pragma unroll
    for (int q = 0; q < 8; ++q) o[q] = (short)f2bf(siluf_(acc8[q]));
    u16* dst = (which == 0 ? qs : (which == 1 ? ks : vs)) + t * 136 + cc;
    *reinterpret_cast<bf16x8*>(dst) = o;
  }
  if (wid == 0) {
    const float* AB = (const float*)(p->ws + OFF_AB) + (size_t)(rowb + lane) * 8;
    const float braw = AB[h], araw = AB[4 + h];
    const float g = -__expf(p->in[22][h]) * softplusf_(araw + p->in[23][h]);
    float c = g;
#pragma unroll
    for (int o = 1; o < 64; o <<= 1) { const float up = __shfl_up(c, o); if (lane >= o) c += up; }
    gcs[lane] = c; betas[lane] = sigmoidf_(braw); egcs[lane] = __expf(c);
  }
  __syncthreads();
  {
    const int r = tid >> 2, part = tid & 3;
#pragma unroll
    for (int w2 = 0; w2 < 2; ++w2) {
      u16* base = (w2 == 0 ? qs : ks) + r * 136 + part * 32;
      float v[32]; float ss = 0.f;
#pragma unroll
      for (int q8 = 0; q8 < 4; ++q8) { const bf16x8 x = *reinterpret_cast<const bf16x8*>(base + q8 * 8);
#pragma unroll
        for (int q = 0; q < 8; ++q) { v[q8 * 8 + q] = bf2f((u16)x[q]); ss += v[q8 * 8 + q] * v[q8 * 8 + q]; } }
      ss = quad_sum(ss);
      const float sc = rsqrtf(ss + 1e-6f) * (w2 == 0 ? 0.08838834764831845f : 1.f);
#pragma unroll
      for (int q8 = 0; q8 < 4; ++q8) { bf16x8 o;
#pragma unroll
        for (int q = 0; q < 8; ++q) o[q] = (short)f2bf(v[q8 * 8 + q] * sc);
        *reinterpret_cast<bf16x8*>(base + q8 * 8) = o; }
    }
  }
  __syncthreads();
  {
    f32x4 aL[4], aQ[4];
#pragma unroll
    for (int nt = 0; nt < 4; ++nt) { aL[nt] = f32x4{0.f, 0.f, 0.f, 0.f}; aQ[nt] = f32x4{0.f, 0.f, 0.f, 0.f}; }
#pragma unroll
    for (int kk = 0; kk < 4; ++kk) {
      const bf16x8 ak = *reinterpret_cast<const bf16x8*>((char*)ks + (wid * 16 + fr) * 272 + kk * 64 + fq * 16);
      const bf16x8 aq = *reinterpret_cast<const bf16x8*>((char*)qs + (wid * 16 + fr) * 272 + kk * 64 + fq * 16);
#pragma unroll
      for (int nt = 0; nt < 4; ++nt) {
        const bf16x8 bk = *reinterpret_cast<const bf16x8*>((char*)ks + (nt * 16 + fr) * 272 + kk * 64 + fq * 16);
        aL[nt] = __builtin_amdgcn_mfma_f32_16x16x32_bf16(ak, bk, aL[nt], 0, 0, 0);
        aQ[nt] = __builtin_amdgcn_mfma_f32_16x16x32_bf16(aq, bk, aQ[nt], 0, 0, 0);
      }
    }
    u16* QK = (u16*)(p->ws + OFF_QK) + (size_t)item * 4096;
#pragma unroll
    for (int nt = 0; nt < 4; ++nt)
#pragma unroll
      for (int j = 0; j < 4; ++j) {
        const int i = wid * 16 + fq * 4 + j, jc = nt * 16 + fr;
        const float dec = (i >= jc) ? __expf(gcs[i] - gcs[jc]) : 0.f;
        Ls[i * 64 + jc] = (i > jc) ? betas[i] * aL[nt][j] * dec : 0.f;
        QK[i * 64 + jc] = f2bf(aQ[nt][j] * dec);
      }
  }
  __syncthreads();
  const size_t ebase = (size_t)((item >> 5) * 8 + (n & 7)) * 8192;
  u16* EUT = (u16*)((unsigned char*)p->out + EO_UT) + ebase; u16* EWN = (u16*)((unsigned char*)p->out + EO_WN) + ebase;
  u16* EQG = (u16*)((unsigned char*)p->out + EO_QG) + ebase; u16* EKD = (u16*)((unsigned char*)p->out + EO_KDT) + ebase;
  {
    float X[64];
    const bool isv = tid < 128; const u16* src = isv ? (vs + tid) : (ks + (tid - 128));
#pragma unroll
    for (int i = 0; i < 64; ++i) { float r = bf2f(src[i * 136]) * betas[i]; if (!isv) r *= egcs[i]; X[i] = r; }
#pragma unroll
    for (int i = 1; i < 64; ++i) {
      float s = X[i];
#pragma unroll
      for (int j4 = 0; j4 < (i + 3) / 4; ++j4) {
        const float4 l = *reinterpret_cast<const float4*>(Ls + i * 64 + j4 * 4);
        s -= l.x * X[4 * j4]; s -= l.y * X[4 * j4 + 1]; s -= l.z * X[4 * j4 + 2]; s -= l.w * X[4 * j4 + 3];
      }
      X[i] = s;
    }
    if (isv) {
#pragma unroll
      for (int q8 = 0; q8 < 8; ++q8) { bf16x8 o;
#pragma unroll
        for (int q = 0; q < 8; ++q) o[q] = (short)f2bf(X[q8 * 8 + q]);
        *reinterpret_cast<bf16x8*>(EUT + tid * 64 + q8 * 8) = o; }
    } else {
#pragma unroll
      for (int i = 0; i < 64; ++i) EWN[i * 128 + (tid - 128)] = f2bf(-X[i]);
    }
  }
  {
    const int i = tid >> 2, k0 = (tid & 3) * 32; const float eg = egcs[i];
#pragma unroll
    for (int q8 = 0; q8 < 4; ++q8) { const bf16x8 x = *reinterpret_cast<const bf16x8*>(qs + i * 136 + k0 + q8 * 8); bf16x8 o;
#pragma unroll
      for (int q = 0; q < 8; ++q) o[q] = (short)f2bf(bf2f((u16)x[q]) * eg);
      *reinterpret_cast<bf16x8*>(EQG + i * 128 + k0 + q8 * 8) = o; }
    const int k = tid >> 1, i0 = (tid & 1) * 32; const float gl = gcs[63];
#pragma unroll
    for (int q8 = 0; q8 < 4; ++q8) { bf16x8 o;
#pragma unroll
      for (int q = 0; q < 8; ++q) { const int ii = i0 + q8 * 8 + q; o[q] = (short)f2bf(bf2f(ks[ii * 136 + k]) * __expf(gl - gcs[ii])); }
      *reinterpret_cast<bf16x8*>(EKD + k * 64 + i0 + q8 * 8) = o; }
    if (tid == 0) ((float*)(p->ws + OFF_GL))[item] = __expf(gl);
  }
  __syncthreads();
}

__device__ __forceinline__ void phase_lora(KP p) {
  const u16* LIN = (const u16*)(p->ws + OFF_LIN);
  constexpr int NRT = MR / 128;
  for (int t = blockIdx.x; t < 3 * 4 * NRT; t += gridDim.x) {
    const int which = t / (4 * NRT), r2 = t - which * 4 * NRT; const int ct = r2 & 3, rt = r2 >> 2;
    const int row0 = rt * 128, col0 = ct * 128;
    f32x4 acc[4][4];
    const u16* A; const u16* Bt; int K; u16* O; const float* bias;
    if (which == 0) { A = LIN; Bt = (const u16*)(p->ws + OFF_W2T); K = 64; O = (u16*)(p->ws + OFF_DE); bias = p->in[11]; }
    else if (which == 1) { A = LIN + 64; Bt = (const u16*)(p->ws + OFF_A2T); K = 64; O = (u16*)(p->ws + OFF_DA); bias = p->in[13]; }
    else { A = LIN + 128; Bt = (const u16*)(p->ws + OFF_G2T); K = 128; O = (u16*)(p->ws + OFF_DG); bias = p->in[13]; }
    gemm_mainloop(A + (size_t)row0 * 256, 256, Bt + (size_t)col0 * K, K, K, acc);
    EPI_COORDS
#pragma unroll
    for (int n = 0; n < 4; ++n) {
      const int col = col0 + wc_ * 64 + n * 16 + fr_; const float bs = bias[col];
#pragma unroll
      for (int m = 0; m < 4; ++m)
#pragma unroll
        for (int j = 0; j < 4; ++j) {
          const int row = row0 + wr_ * 64 + m * 16 + fq_ * 4 + j; float v = acc[m][n][j];
          if (which == 0) { const float z = bs + v; v = __expf(-softplusf_(-z) - 0.5f); }
          else if (which == 1) v = sigmoidf_(bs + v);
          O[(size_t)row * 512 + col] = f2bf(v);
        }
    }
  }
}

struct RwRaw { u16x4 r, k, v, pr, pk, pv, e, a, g; float4 sr, sk, sv; };
template <bool samp>
__device__ __forceinline__ void rwkv_chain(KP p, int seq, int h, bool dry) {
  const int tid = ltid();
  constexpr int T = samp ? 1 : SEQ; const int rowb = samp ? NP + (seq - 8) : seq * SEQ;
  const u16* PJ = (const u16*)(p->ws + OFF_PROJ); u16* DA = (u16*)(p->ws + OFF_DA);
  const u16* DE = (const u16*)(p->ws + OFF_DE); const u16* DG = (const u16*)(p->ws + OFF_DG);
  float* buf = (float*)smem;
  float* ybuf = buf + 2 * 16 * 384;
  const int vrow = tid >> 2, part = tid & 3;
  const int tt = tid >> 4, jg = (tid & 15) * 4, ch = h * 64 + jg;
  float S[16];
  if (samp) { const float* s0 = p->in[5] + ((size_t)(seq - 8) * 8 + h) * 4096 + vrow * 64 + part * 16;
#pragma unroll
    for (int q = 0; q < 4; ++q) { const float4 x = *reinterpret_cast<const float4*>(s0 + q * 4); S[q * 4] = x.x; S[q * 4 + 1] = x.y; S[q * 4 + 2] = x.z; S[q * 4 + 3] = x.w; } }
  else {
#pragma unroll
    for (int q = 0; q < 16; ++q) S[q] = 0.f; }
  const float4 mur = *reinterpret_cast<const float4*>(p->in[10] + ch), muk = *reinterpret_cast<const float4*>(p->in[10] + 512 + ch), muv = *reinterpret_cast<const float4*>(p->in[10] + 1024 + ch);
  const float4 ckk = *reinterpret_cast<const float4*>(p->in[16] + ch), cka = *reinterpret_cast<const float4*>(p->in[17] + ch), crk = *reinterpret_cast<const float4*>(p->in[18] + ch);
  const float4 lnw = *reinterpret_cast<const float4*>(p->in[19] + ch), lnb = *reinterpret_cast<const float4*>(p->in[20] + ch);
  constexpr int nchunks = (T + 15) >> 4;
  auto load_raw = [&](int c, RwRaw& R) {
    const int t = c * 16 + tt;
    if (t < T) {
      const size_t ro = (size_t)(rowb + t) * PCOLS;
      R.r = *reinterpret_cast<const u16x4*>(PJ + ro + ch); R.k = *reinterpret_cast<const u16x4*>(PJ + ro + 512 + ch); R.v = *reinterpret_cast<const u16x4*>(PJ + ro + 1024 + ch);
      if (t > 0) { const size_t po = ro - PCOLS; R.pr = *reinterpret_cast<const u16x4*>(PJ + po + ch); R.pk = *reinterpret_cast<const u16x4*>(PJ + po + 512 + ch); R.pv = *reinterpret_cast<const u16x4*>(PJ + po + 1024 + ch); }
      else if (samp) { const float* sh = p->in[4] + (size_t)(seq - 8) * 1792; R.sr = *reinterpret_cast<const float4*>(sh + ch); R.sk = *reinterpret_cast<const float4*>(sh + 512 + ch); R.sv = *reinterpret_cast<const float4*>(sh + 1024 + ch); }
      const size_t lo = (size_t)(rowb + t) * 512 + ch;
      R.e = *reinterpret_cast<const u16x4*>(DE + lo); R.a = *reinterpret_cast<const u16x4*>(DA + lo); R.g = *reinterpret_cast<const u16x4*>(DG + lo);
    }
  };
  auto prep_write = [&](int c, const RwRaw& R) {
    const int t = c * 16 + tt;
    if (t < T) {
      float r4[4], k4[4], v4[4], pr4[4], pk4[4], pv4[4];
      const float mr[4] = {mur.x, mur.y, mur.z, mur.w}, mk[4] = {muk.x, muk.y, muk.z, muk.w}, mv[4] = {muv.x, muv.y, muv.z, muv.w};
      const float kkc[4] = {ckk.x, ckk.y, ckk.z, ckk.w}, kac[4] = {cka.x, cka.y, cka.z, cka.w};
      if (t > 0) { for (int q = 0; q < 4; ++q) { pr4[q] = bf2f(R.pr[q]); pk4[q] = bf2f(R.pk[q]); pv4[q] = bf2f(R.pv[q]); } }
      else if (samp) { pr4[0] = R.sr.x; pr4[1] = R.sr.y; pr4[2] = R.sr.z; pr4[3] = R.sr.w; pk4[0] = R.sk.x; pk4[1] = R.sk.y; pk4[2] = R.sk.z; pk4[3] = R.sk.w; pv4[0] = R.sv.x; pv4[1] = R.sv.y; pv4[2] = R.sv.z; pv4[3] = R.sv.w; }
      else { for (int q = 0; q < 4; ++q) { pr4[q] = 0.f; pk4[q] = 0.f; pv4[q] = 0.f; } }
      float kr[4], ss = 0.f, a4[4], w4[4];
#pragma unroll
      for (int q = 0; q < 4; ++q) {
        const float cr = bf2f(R.r[q]), ck = bf2f(R.k[q]), cv = bf2f(R.v[q]);
        r4[q] = cr + (pr4[q] - cr) * mr[q]; k4[q] = ck + (pk4[q] - ck) * mk[q]; v4[q] = cv + (pv4[q] - cv) * mv[q];
        kr[q] = k4[q] * kkc[q]; ss += kr[q] * kr[q];
        a4[q] = bf2f(R.a[q]); w4[q] = __expf(-bf2f(R.e[q]));
      }
      ss = sum16(ss);
      const float rn = rsqrtf(ss + 1e-6f);
      float* dst = buf + ((c & 1) * 16 + tt) * 384 + jg;
      float4 o;
      o = make_float4(w4[0], w4[1], w4[2], w4[3]); *reinterpret_cast<float4*>(dst) = o;
      o = make_float4(-kr[0] * rn, -kr[1] * rn, -kr[2] * rn, -kr[3] * rn); *reinterpret_cast<float4*>(dst + 64) = o;
      o = make_float4(kr[0] * rn * a4[0], kr[1] * rn * a4[1], kr[2] * rn * a4[2], kr[3] * rn * a4[3]); *reinterpret_cast<float4*>(dst + 128) = o;
      o = make_float4(k4[0] * (1.f + (a4[0] - 1.f) * kac[0]), k4[1] * (1.f + (a4[1] - 1.f) * kac[1]), k4[2] * (1.f + (a4[2] - 1.f) * kac[2]), k4[3] * (1.f + (a4[3] - 1.f) * kac[3]));
      *reinterpret_cast<float4*>(dst + 192) = o;
      o = make_float4(r4[0], r4[1], r4[2], r4[3]); *reinterpret_cast<float4*>(dst + 256) = o;
      o = make_float4(v4[0], v4[1], v4[2], v4[3]); *reinterpret_cast<float4*>(dst + 320) = o;
    }
  };
  RwRaw R; load_raw(0, R);
  for (int c = 0; c < nchunks; ++c) {
    prep_write(c, R);
    const u16x4 gcur = R.g;
    if (c + 1 < nchunks) load_raw(c + 1, R);
    __syncthreads();
    const int nsteps = min(16, T - c * 16);
    const float* cb = buf + (c & 1) * 16 * 384;
#pragma unroll 2
    for (int s = 0; s < nsteps; ++s) {
      const float* sb = cb + s * 384 + part * 16;
      float w[16], a[16], bb[16], kk[16], rr[16];
#pragma unroll
      for (int q = 0; q < 4; ++q) {
        const float4 x0 = *reinterpret_cast<const float4*>(sb + q * 4); w[q * 4] = x0.x; w[q * 4 + 1] = x0.y; w[q * 4 + 2] = x0.z; w[q * 4 + 3] = x0.w;
        const float4 x1 = *reinterpret_cast<const float4*>(sb + 64 + q * 4); a[q * 4] = x1.x; a[q * 4 + 1] = x1.y; a[q * 4 + 2] = x1.z; a[q * 4 + 3] = x1.w;
        const float4 x2 = *reinterpret_cast<const float4*>(sb + 128 + q * 4); bb[q * 4] = x2.x; bb[q * 4 + 1] = x2.y; bb[q * 4 + 2] = x2.z; bb[q * 4 + 3] = x2.w;
        const float4 x3 = *reinterpret_cast<const float4*>(sb + 192 + q * 4); kk[q * 4] = x3.x; kk[q * 4 + 1] = x3.y; kk[q * 4 + 2] = x3.z; kk[q * 4 + 3] = x3.w;
        const float4 x4 = *reinterpret_cast<const float4*>(sb + 256 + q * 4); rr[q * 4] = x4.x; rr[q * 4 + 1] = x4.y; rr[q * 4 + 2] = x4.z; rr[q * 4 + 3] = x4.w;
      }
      const float vv = cb[s * 384 + 320 + vrow];
      float s0 = 0.f, s1 = 0.f, s2 = 0.f, s3 = 0.f;
#pragma unroll
      for (int q = 0; q < 4; ++q) { s0 += S[q * 4] * a[q * 4]; s1 += S[q * 4 + 1] * a[q * 4 + 1]; s2 += S[q * 4 + 2] * a[q * 4 + 2]; s3 += S[q * 4 + 3] * a[q * 4 + 3]; }
      const float sa = quad_sum((s0 + s1) + (s2 + s3));
      float y0 = 0.f, y1 = 0.f, y2 = 0.f, y3 = 0.f;
#pragma unroll
      for (int q = 0; q < 16; ++q) S[q] = fmaf(sa, bb[q], fmaf(S[q], w[q], vv * kk[q]));
#pragma unroll
      for (int q = 0; q < 4; ++q) { y0 += S[q * 4] * rr[q * 4]; y1 += S[q * 4 + 1] * rr[q * 4 + 1]; y2 += S[q * 4 + 2] * rr[q * 4 + 2]; y3 += S[q * 4 + 3] * rr[q * 4 + 3]; }
      const float y = quad_sum((y0 + y1) + (y2 + y3));
      if (part == 0) ybuf[s * 64 + vrow] = y;
    }
    __syncthreads();
    {
      const int t = c * 16 + tt;
      if (t < T) {
        const float4 y4 = *reinterpret_cast<const float4*>(ybuf + tt * 64 + jg);
        const float* tb = cb + tt * 384 + jg;
        const float4 kq = *reinterpret_cast<const float4*>(tb + 192), rq = *reinterpret_cast<const float4*>(tb + 256), vq = *reinterpret_cast<const float4*>(tb + 320);
        const float mean = sum16(y4.x + y4.y + y4.z + y4.w) * (1.f / 64.f);
        const float d0 = y4.x - mean, d1 = y4.y - mean, d2 = y4.z - mean, d3 = y4.w - mean;
        const float var = sum16(d0 * d0 + d1 * d1 + d2 * d2 + d3 * d3) * (1.f / 64.f);
        const float rstd = rsqrtf(var + GN_EPS);
        const float dot = sum16(rq.x * kq.x * crk.x + rq.y * kq.y * crk.y + rq.z * kq.z * crk.z + rq.w * kq.w * crk.w);
        u16x4 o;
        o[0] = f2bf((d0 * rstd * lnw.x + lnb.x + dot * vq.x) * bf2f(gcur[0]));
        o[1] = f2bf((d1 * rstd * lnw.y + lnb.y + dot * vq.y) * bf2f(gcur[1]));
        o[2] = f2bf((d2 * rstd * lnw.z + lnb.z + dot * vq.z) * bf2f(gcur[2]));
        o[3] = f2bf((d3 * rstd * lnw.w + lnb.w + dot * vq.w) * bf2f(gcur[3]));
        *reinterpret_cast<u16x4*>((dry ? (u16*)(p->ws + OFF_LIN) : DA) + (size_t)((rowb + t) & (dry ? 8191 : 0xffffff)) * 512 + ch) = o;
      }
    }
  }
  {
    float* so = p->out + (samp ? OUT_WKV_S + ((size_t)(seq - 8) * 8 + h) * 4096 : OUT_WKV_P + ((size_t)seq * 8 + h) * 4096) + vrow * 64 + part * 16;
#pragma unroll
    for (int q = 0; q < 4; ++q) *reinterpret_cast<float4*>(so + q * 4) = make_float4(S[q * 4], S[q * 4 + 1], S[q * 4 + 2], S[q * 4 + 3]);
  }
  __syncthreads();
}

constexpr int RW_REC = 35328;
constexpr int RO_WA = 0, RO_RT = 4096, RO_UVT = 8192, RO_YVT = 12288, RO_BHT = 16384, RO_VT = 20480, RO_SV = 24576, RO_ARB = 32768, RO_PC = 34816, RO_DOT = 35072;
#define RWC_CARVE(L) \
  u16* At = (u16*)(L);\
  u16* Rt = (u16*)(L + 4608);\
  u16* Bt = (u16*)(L + 9216);\
  u16* Kt = (u16*)(L + 13824);\
  u16* Aak = (u16*)(L + 9216);\
  u16* Ark = (u16*)(L + 11776); \
  u16* Arb = (u16*)(L + 14336); \
  u16* VT = (u16*)(L + 18432);\
  u16* KHT = (u16*)(L + 23552);\
  float* Af = (float*)(L + 33792);\
  float* AV = (float*)(L + 41984);\
  float* Ls = (float*)(L + 50176);\
  float* rn = (float*)(L + 68608); float* dots = rn + 32; float* gtot = dots + 32; float* cst = gtot + 256;

__device__ __forceinline__ void rwkv_prep_item(KP p, int chain, int n, unsigned char* rec) {
  int tl = threadIdx.x; asm volatile("" : "+v"(tl));
  const int tid = tl, lane = tid & 63, w = tid >> 6, fr = lane & 15, fq = lane >> 4;
  const int i2 = tid >> 3, c0 = (tid & 7) * 8, mi = w >> 1, nt0 = (w & 1) * 2;
  const int b = chain >> 3, h = chain & 7;
  unsigned char* L = smem; RWC_CARVE(L)
  const int rowb = b * SEQ + n * 32, ch = h * 64 + lane;
  const u16* PJ = (const u16*)(p->ws + OFF_PROJ); const u16* DA = (const u16*)(p->ws + OFF_DA); const u16* DE = (const u16*)(p->ws + OFF_DE);
  const float mur = p->in[10][ch], muk = p->in[10][512 + ch], muv = p->in[10][1024 + ch];
  const float kkc = p->in[16][ch], kac = p->in[17][ch];
  float c_mr[8], c_mk[8], c_kk[8], c_ka[8], c_rk[8];
  { const int cc = h * 64 + c0;
    const float4 a0 = *reinterpret_cast<const float4*>(p->in[10] + cc), a1 = *reinterpret_cast<const float4*>(p->in[10] + cc + 4);
    const float4 b0 = *reinterpret_cast<const float4*>(p->in[10] + 512 + cc), b1 = *reinterpret_cast<const float4*>(p->in[10] + 512 + cc + 4);
    const float4 d0 = *reinterpret_cast<const float4*>(p->in[16] + cc), d1 = *reinterpret_cast<const float4*>(p->in[16] + cc + 4);
    const float4 e0 = *reinterpret_cast<const float4*>(p->in[17] + cc), e1 = *reinterpret_cast<const float4*>(p->in[17] + cc + 4);
    const float4 f0 = *reinterpret_cast<const float4*>(p->in[18] + cc), f1 = *reinterpret_cast<const float4*>(p->in[18] + cc + 4);
    c_mr[0] = a0.x; c_mr[1] = a0.y; c_mr[2] = a0.z; c_mr[3] = a0.w; c_mr[4] = a1.x; c_mr[5] = a1.y; c_mr[6] = a1.z; c_mr[7] = a1.w;
    c_mk[0] = b0.x; c_mk[1] = b0.y; c_mk[2] = b0.z; c_mk[3] = b0.w; c_mk[4] = b1.x; c_mk[5] = b1.y; c_mk[6] = b1.z; c_mk[7] = b1.w;
    c_kk[0] = d0.x; c_kk[1] = d0.y; c_kk[2] = d0.z; c_kk[3] = d0.w; c_kk[4] = d1.x; c_kk[5] = d1.y; c_kk[6] = d1.z; c_kk[7] = d1.w;
    c_ka[0] = e0.x; c_ka[1] = e0.y; c_ka[2] = e0.z; c_ka[3] = e0.w; c_ka[4] = e1.x; c_ka[5] = e1.y; c_ka[6] = e1.z; c_ka[7] = e1.w;
    c_rk[0] = f0.x; c_rk[1] = f0.y; c_rk[2] = f0.z; c_rk[3] = f0.w; c_rk[4] = f1.x; c_rk[5] = f1.y; c_rk[6] = f1.z; c_rk[7] = f1.w; }
  bf16x8 cr8, ck8, pr8, pk8, a8; u16 rr[9], rk[9], rv[9], re[8], ra[8];
  { const int t = n * 32 + i2; const size_t ro = (size_t)(rowb + i2) * PCOLS + h * 64 + c0;
    cr8 = *reinterpret_cast<const bf16x8*>(PJ + ro); ck8 = *reinterpret_cast<const bf16x8*>(PJ + ro + 512);
    const size_t rop = t > 0 ? ro - PCOLS : ro;
    pr8 = *reinterpret_cast<const bf16x8*>(PJ + rop); pk8 = *reinterpret_cast<const bf16x8*>(PJ + rop + 512);
    if (t == 0) { pr8 = bf16x8{0, 0, 0, 0, 0, 0, 0, 0}; pk8 = pr8; }
    a8 = *reinterpret_cast<const bf16x8*>(DA + (size_t)(rowb + i2) * 512 + h * 64 + c0); }
#pragma unroll
  for (int q = 0; q < 9; ++q) { const int i = w * 8 - 1 + q; const bool ok = (n * 32 + i) >= 0;
    const size_t ro = (size_t)(rowb + (ok ? i : 0)) * PCOLS + ch; rr[q] = PJ[ro]; rk[q] = PJ[ro + 512]; rv[q] = PJ[ro + 1024];
    if (!ok) { rr[q] = 0; rk[q] = 0; rv[q] = 0; } }
#pragma unroll
  for (int q = 0; q < 8; ++q) { const size_t lo = (size_t)(rowb + w * 8 + q) * 512 + ch; re[q] = DE[lo]; ra[q] = DA[lo]; }
  __syncthreads();
  {
    float ss = 0.f, dt = 0.f;
#pragma unroll
    for (int q = 0; q < 8; ++q) {
      const float cr = bf2f((u16)cr8[q]), ck = bf2f((u16)ck8[q]);
      const float r = cr + (bf2f((u16)pr8[q]) - cr) * c_mr[q], k = ck + (bf2f((u16)pk8[q]) - ck) * c_mk[q];
      const float a = bf2f((u16)a8[q]); const float kr = k * c_kk[q];
      ss += kr * kr; dt += r * k * (1.f + (a - 1.f) * c_ka[q]) * c_rk[q];
    }
    ss += __shfl_xor(ss, 1); dt += __shfl_xor(dt, 1); ss += __shfl_xor(ss, 2); dt += __shfl_xor(dt, 2); ss += __shfl_xor(ss, 4); dt += __shfl_xor(dt, 4);
    if ((tid & 7) == 0) { rn[i2] = rsqrtf(ss + 1e-6f); dots[i2] = dt; ((float*)(rec + RO_DOT))[i2] = dt; }
  }
  float lsum = 0.f;
#pragma unroll
  for (int q = 0; q < 8; ++q) lsum -= bf2f(re[q]);
  gtot[w * 64 + lane] = lsum;
  __syncthreads();
  {
    const float g0 = gtot[lane], g1 = gtot[64 + lane], g2 = gtot[128 + lane], g3 = gtot[192 + lane];
    const float Ltot = (g0 + g1) + (g2 + g3);
    const float off = (w > 0 ? g0 : 0.f) + (w > 1 ? g1 : 0.f) + (w > 2 ? g2 : 0.f);
    if (w == 0) ((float*)(rec + RO_PC))[lane] = __expf(Ltot);
    float run = 0.f; bf16x8 vp, khp, bhp;
    u16* RTg = (u16*)(rec + RO_RT);
#pragma unroll
    for (int q = 0; q < 8; ++q) {
      const int i = w * 8 + q;
      const float cr = bf2f(rr[q + 1]), ck = bf2f(rk[q + 1]), cv = bf2f(rv[q + 1]);
      const float r = cr + (bf2f(rr[q]) - cr) * mur, k = ck + (bf2f(rk[q]) - ck) * muk, v = cv + (bf2f(rv[q]) - cv) * muv;
      const float e = bf2f(re[q]), a = bf2f(ra[q]);
      run -= e; const float Lc = off + run, Lp = Lc + e;
      const float kk = k * kkc * rn[i]; const float ain = -kk, bin = kk * a, kp = k * (1.f + (a - 1.f) * kac);
      const float eP = __expf(Lp), eC = __expf(Lc), eN = __expf(-Lc), eT = __expf(Ltot - Lc);
      const float at = ain * eP; const u16 rt = f2bf(r * eC);
      At[i * 72 + lane] = f2bf(at); Af[i * 64 + lane] = at; Rt[i * 72 + lane] = rt; RTg[i * 64 + lane] = rt;
      Bt[i * 72 + lane] = f2bf(bin * eN); Kt[i * 72 + lane] = f2bf(kp * eN);
      vp[q] = (short)f2bf(v); khp[q] = (short)f2bf(kp * eT); bhp[q] = (short)f2bf(bin * eT);
    }
    *reinterpret_cast<bf16x8*>((char*)VT + lane * 80 + w * 16) = vp;
    *reinterpret_cast<bf16x8*>((char*)KHT + lane * 80 + w * 16) = khp;
    *reinterpret_cast<bf16x8*>(rec + RO_VT + lane * 64 + w * 16) = vp;
    *reinterpret_cast<bf16x8*>(rec + RO_BHT + lane * 64 + w * 16) = bhp;
  }
  __syncthreads();
  {
    f32x4 cab = {0.f, 0.f, 0.f, 0.f}, cak = cab, crb = cab, crk = cab;
#pragma unroll
    for (int ks = 0; ks < 2; ++ks) {
      const bf16x8 fa = *reinterpret_cast<const bf16x8*>((char*)At + (mi * 16 + fr) * 144 + ks * 64 + fq * 16);
      const bf16x8 fr_ = *reinterpret_cast<const bf16x8*>((char*)Rt + (mi * 16 + fr) * 144 + ks * 64 + fq * 16);
      const bf16x8 fb = *reinterpret_cast<const bf16x8*>((char*)Bt + ((w & 1) * 16 + fr) * 144 + ks * 64 + fq * 16);
      const bf16x8 fk = *reinterpret_cast<const bf16x8*>((char*)Kt + ((w & 1) * 16 + fr) * 144 + ks * 64 + fq * 16);
      cab = __builtin_amdgcn_mfma_f32_16x16x32_bf16(fa, fb, cab, 0, 0, 0);
      cak = __builtin_amdgcn_mfma_f32_16x16x32_bf16(fa, fk, cak, 0, 0, 0);
      crb = __builtin_amdgcn_mfma_f32_16x16x32_bf16(fr_, fb, crb, 0, 0, 0);
      crk = __builtin_amdgcn_mfma_f32_16x16x32_bf16(fr_, fk, crk, 0, 0, 0);
    }
    __syncthreads();
    u16* ARBg = (u16*)(rec + RO_ARB);
#pragma unroll
    for (int jj = 0; jj < 4; ++jj) {
      const int i = mi * 16 + fq * 4 + jj, s = (w & 1) * 16 + fr;
      Ls[s * 32 + i] = (s < i) ? cab[jj] : 0.f;
      Aak[i * 40 + s] = f2bf((s < i) ? cak[jj] : 0.f);
      ARBg[i * 32 + s] = f2bf((s <= i) ? crb[jj] : 0.f);
      Ark[i * 40 + s] = f2bf((s <= i) ? crk[jj] : 0.f);
    }
  }
  __syncthreads();
  {
    const bf16x8 faak = *reinterpret_cast<const bf16x8*>((char*)Aak + (mi * 16 + fr) * 80 + fq * 16);
    const bf16x8 fark = *reinterpret_cast<const bf16x8*>((char*)Ark + (mi * 16 + fr) * 80 + fq * 16);
    const bf16x8 fkh = *reinterpret_cast<const bf16x8*>((char*)KHT + (w * 16 + fr) * 80 + fq * 16);
    const f32x4 z4 = {0.f, 0.f, 0.f, 0.f};
#pragma unroll
    for (int nt = 0; nt < 4; ++nt) {
      const bf16x8 vb = *reinterpret_cast<const bf16x8*>((char*)VT + (nt * 16 + fr) * 80 + fq * 16);
      const f32x4 sv = __builtin_amdgcn_mfma_f32_16x16x32_bf16(fkh, vb, z4, 0, 0, 0);
      { u16x4 o; o[0] = f2bf(sv[0]); o[1] = f2bf(sv[1]); o[2] = f2bf(sv[2]); o[3] = f2bf(sv[3]);
        *reinterpret_cast<u16x4*>(rec + RO_SV + (nt * 16 + fr) * 128 + (w * 16 + fq * 4) * 2) = o; }
      if (nt == nt0 || nt == nt0 + 1) {
        const f32x4 av = __builtin_amdgcn_mfma_f32_16x16x32_bf16(faak, vb, z4, 0, 0, 0);
        const f32x4 yv = __builtin_amdgcn_mfma_f32_16x16x32_bf16(fark, vb, z4, 0, 0, 0);
#pragma unroll
        for (int jj = 0; jj < 4; ++jj) AV[(mi * 16 + fq * 4 + jj) * 64 + nt * 16 + fr] = av[jj];
        u16x4 o; o[0] = f2bf(yv[0]); o[1] = f2bf(yv[1]); o[2] = f2bf(yv[2]); o[3] = f2bf(yv[3]);
        *reinterpret_cast<u16x4*>(rec + RO_YVT + (nt * 16 + fr) * 64 + (mi * 16 + fq * 4) * 2) = o;
      }
    }
  }
  __syncthreads();
  if (tid < 128) {
    float* xc = tid < 64 ? (Af + tid) : (AV + (tid - 64));
#pragma unroll 1
    for (int i0 = 0; i0 < 32; i0 += 8) {
      float acc[8];
#pragma unroll
      for (int r = 0; r < 8; ++r) acc[r] = xc[(i0 + r) * 64];
#pragma unroll 2
      for (int j = 0; j < i0; ++j) {
        const float xj = xc[j * 64];
        const float4 l0 = *reinterpret_cast<const float4*>(Ls + j * 32 + i0), l1 = *reinterpret_cast<const float4*>(Ls + j * 32 + i0 + 4);
        acc[0] += l0.x * xj; acc[1] += l0.y * xj; acc[2] += l0.z * xj; acc[3] += l0.w * xj;
        acc[4] += l1.x * xj; acc[5] += l1.y * xj; acc[6] += l1.z * xj; acc[7] += l1.w * xj;
      }
#pragma unroll
      for (int r2 = 0; r2 < 7; ++r2) {
        const float4 l0 = *reinterpret_cast<const float4*>(Ls + (i0 + r2) * 32 + i0), l1 = *reinterpret_cast<const float4*>(Ls + (i0 + r2) * 32 + i0 + 4);
        const float lv[8] = {l0.x, l0.y, l0.z, l0.w, l1.x, l1.y, l1.z, l1.w};
#pragma unroll
        for (int r = r2 + 1; r < 8; ++r) acc[r] += lv[r] * acc[r2];
      }
#pragma unroll
      for (int r = 0; r < 8; ++r) xc[(i0 + r) * 64] = acc[r];
    }
    if (tid < 64) {
      u16* WAg = (u16*)(rec + RO_WA);
#pragma unroll 4
      for (int i = 0; i < 32; ++i) WAg[i * 64 + tid] = f2bf(xc[i * 64]);
    } else {
#pragma unroll
      for (int q8 = 0; q8 < 4; ++q8) { bf16x8 o;
#pragma unroll
        for (int q = 0; q < 8; ++q) o[q] = (short)f2bf(xc[(q8 * 8 + q) * 64]);
        *reinterpret_cast<bf16x8*>(rec + RO_UVT + (tid - 64) * 64 + q8 * 16) = o; }
    }
  }
  __syncthreads();
}

struct RwRec { bf16x8 wa[2], rt[2], arb, bh, vt; u16x4 uv[2], yv[2], sv[4]; float4 pc; float4 d0, d1; u16 g[8]; };
__device__ __forceinline__ void rwkv_scan_seg(KP p, int chain, int seg, const unsigned char* recs, bool dry) {
  int tl = threadIdx.x; asm volatile("" : "+v"(tl));
  const int tid = tl, lane = tid & 63, w = tid >> 6, fr = lane & 15, fq = lane >> 4;
  const int i2 = tid >> 3, c0 = (tid & 7) * 8, mi = w >> 1, nt0 = (w & 1) * 2;
  const int b = chain >> 3, h = chain & 7, ch = h * 64 + lane;
  u16* St = (u16*)(smem);
  u16* Dt = (u16*)(smem + 9216);
  float* Ys = (float*)(smem + 14336);
  float* stat = (float*)(smem + 22528);
  u16* DA = (u16*)(p->ws + OFF_DA); const u16* DG = (const u16*)(p->ws + OFF_DG);
  const float lnw = p->in[19][ch], lnb = p->in[20][ch];
  float* so = p->out + OUT_WKV_P + (size_t)chain * 4096;
  f32x4 Sacc[4];
  const float keep = seg == 0 ? 0.f : 1.f;
#pragma unroll
  for (int nt = 0; nt < 4; ++nt) {
#pragma unroll
    for (int jj = 0; jj < 4; ++jj) Sacc[nt][jj] = fminf(fmaxf(so[(nt * 16 + fr) * 64 + w * 16 + fq * 4 + jj], -3e38f), 3e38f) * keep;
    u16x4 o; o[0] = f2bf(Sacc[nt][0]); o[1] = f2bf(Sacc[nt][1]); o[2] = f2bf(Sacc[nt][2]); o[3] = f2bf(Sacc[nt][3]);
    *reinterpret_cast<u16x4*>((char*)St + (nt * 16 + fr) * 144 + (w * 16 + fq * 4) * 2) = o;
  }
  auto load_rec = [&](int c, RwRec& R) {
    int cl = c; asm volatile("" : "+s"(cl));
    int ty = threadIdx.x; asm volatile("" : "+v"(ty));
    const int lane = ty & 63, w = ty >> 6, fr = lane & 15, fq = lane >> 4, mi = w >> 1, nt0 = (w & 1) * 2, ch = h * 64 + lane;
    const unsigned char* rec = recs + (size_t)(chain * 16 + cl) * RW_REC;
#pragma unroll
    for (int ks = 0; ks < 2; ++ks) {
      R.wa[ks] = *reinterpret_cast<const bf16x8*>(rec + RO_WA + (mi * 16 + fr) * 128 + ks * 64 + fq * 16);
      R.rt[ks] = *reinterpret_cast<const bf16x8*>(rec + RO_RT + (mi * 16 + fr) * 128 + ks * 64 + fq * 16);
    }
    R.arb = *reinterpret_cast<const bf16x8*>(rec + RO_ARB + (mi * 16 + fr) * 64 + fq * 16);
    R.bh = *reinterpret_cast<const bf16x8*>(rec + RO_BHT + (w * 16 + fr) * 64 + fq * 16);
    R.vt = *reinterpret_cast<const bf16x8*>(rec + RO_VT + lane * 64 + w * 16);
#pragma unroll
    for (int q2 = 0; q2 < 2; ++q2) {
      R.uv[q2] = *reinterpret_cast<const u16x4*>(rec + RO_UVT + ((nt0 + q2) * 16 + fr) * 64 + (mi * 16 + fq * 4) * 2);
      R.yv[q2] = *reinterpret_cast<const u16x4*>(rec + RO_YVT + ((nt0 + q2) * 16 + fr) * 64 + (mi * 16 + fq * 4) * 2);
    }
#pragma unroll
    for (int nt = 0; nt < 4; ++nt) R.sv[nt] = *reinterpret_cast<const u16x4*>(rec + RO_SV + (nt * 16 + fr) * 128 + (w * 16 + fq * 4) * 2);
    R.pc = *reinterpret_cast<const float4*>(rec + RO_PC + (w * 16 + fq * 4) * 4);
    R.d0 = *reinterpret_cast<const float4*>(rec + RO_DOT + w * 32); R.d1 = *reinterpret_cast<const float4*>(rec + RO_DOT + w * 32 + 16);
    const size_t rowg = (size_t)(b * SEQ + (seg * 16 + cl) * 32 + w * 8);
#pragma unroll
    for (int q = 0; q < 8; ++q) R.g[q] = DG[(rowg + q) * 512 + ch];
  };
  RwRec R; load_rec(0, R);
  __syncthreads();
  for (int c = 0; c < 16; ++c) {
    int cq = c; asm volatile("" : "+s"(cq));
    int tz = threadIdx.x; asm volatile("" : "+v"(tz));
    const int lane = tz & 63, w = tz >> 6, fr = lane & 15, fq = lane >> 4, i2 = tz >> 3, c0 = (tz & 7) * 8, mi = w >> 1, nt0 = (w & 1) * 2;
    f32x4 Dacc[2], Yacc[2];
#pragma unroll
    for (int q2 = 0; q2 < 2; ++q2) {
      Dacc[q2] = f32x4{bf2f(R.uv[q2][0]), bf2f(R.uv[q2][1]), bf2f(R.uv[q2][2]), bf2f(R.uv[q2][3])};
      Yacc[q2] = f32x4{bf2f(R.yv[q2][0]), bf2f(R.yv[q2][1]), bf2f(R.yv[q2][2]), bf2f(R.yv[q2][3])};
    }
#pragma unroll
    for (int ks = 0; ks < 2; ++ks)
#pragma unroll
      for (int q2 = 0; q2 < 2; ++q2) {
        const bf16x8 sb = *reinterpret_cast<const bf16x8*>((char*)St + ((nt0 + q2) * 16 + fr) * 144 + ks * 64 + fq * 16);
        Dacc[q2] = __builtin_amdgcn_mfma_f32_16x16x32_bf16(R.wa[ks], sb, Dacc[q2], 0, 0, 0);
        Yacc[q2] = __builtin_amdgcn_mfma_f32_16x16x32_bf16(R.rt[ks], sb, Yacc[q2], 0, 0, 0);
      }
#pragma unroll
    for (int q2 = 0; q2 < 2; ++q2) {
      u16x4 o; o[0] = f2bf(Dacc[q2][0]); o[1] = f2bf(Dacc[q2][1]); o[2] = f2bf(Dacc[q2][2]); o[3] = f2bf(Dacc[q2][3]);
      *reinterpret_cast<u16x4*>((char*)Dt + ((nt0 + q2) * 16 + fr) * 80 + (mi * 16 + fq * 4) * 2) = o;
    }
    __syncthreads();
    const float pc[4] = {R.pc.x, R.pc.y, R.pc.z, R.pc.w};
#pragma unroll
    for (int nt = 0; nt < 4; ++nt) {
      const bf16x8 db = *reinterpret_cast<const bf16x8*>((char*)Dt + (nt * 16 + fr) * 80 + fq * 16);
      if (nt == nt0 || nt == nt0 + 1) Yacc[nt - nt0] = __builtin_amdgcn_mfma_f32_16x16x32_bf16(R.arb, db, Yacc[nt - nt0], 0, 0, 0);
#pragma unroll
      for (int jj = 0; jj < 4; ++jj) Sacc[nt][jj] = Sacc[nt][jj] * pc[jj] + bf2f(R.sv[nt][jj]);
      Sacc[nt] = __builtin_amdgcn_mfma_f32_16x16x32_bf16(R.bh, db, Sacc[nt], 0, 0, 0);
      u16x4 o; o[0] = f2bf(Sacc[nt][0]); o[1] = f2bf(Sacc[nt][1]); o[2] = f2bf(Sacc[nt][2]); o[3] = f2bf(Sacc[nt][3]);
      *reinterpret_cast<u16x4*>((char*)St + (nt * 16 + fr) * 144 + (w * 16 + fq * 4) * 2) = o;
    }
#pragma unroll
    for (int q2 = 0; q2 < 2; ++q2)
#pragma unroll
      for (int jj = 0; jj < 4; ++jj) Ys[(mi * 16 + fq * 4 + jj) * 64 + (nt0 + q2) * 16 + fr] = Yacc[q2][jj];
    const bf16x8 vt = R.vt; const float dd[8] = {R.d0.x, R.d0.y, R.d0.z, R.d0.w, R.d1.x, R.d1.y, R.d1.z, R.d1.w};
    u16 gq[8];
#pragma unroll
    for (int q = 0; q < 8; ++q) gq[q] = R.g[q];
    if (c + 1 < 16) load_rec(c + 1, R);
    __syncthreads();
    {
      const float4 y0 = *reinterpret_cast<const float4*>(Ys + i2 * 64 + c0), y1 = *reinterpret_cast<const float4*>(Ys + i2 * 64 + c0 + 4);
      float sm = (y0.x + y0.y + y0.z + y0.w) + (y1.x + y1.y + y1.z + y1.w);
      sm += __shfl_xor(sm, 1); sm += __shfl_xor(sm, 2); sm += __shfl_xor(sm, 4);
      const float mean = sm * (1.f / 64.f);
      float d, vs = 0.f;
      d = y0.x - mean; vs += d * d; d = y0.y - mean; vs += d * d; d = y0.z - mean; vs += d * d; d = y0.w - mean; vs += d * d;
      d = y1.x - mean; vs += d * d; d = y1.y - mean; vs += d * d; d = y1.z - mean; vs += d * d; d = y1.w - mean; vs += d * d;
      vs += __shfl_xor(vs, 1); vs += __shfl_xor(vs, 2); vs += __shfl_xor(vs, 4);
      if ((tz & 7) == 0) { stat[i2 * 2] = mean; stat[i2 * 2 + 1] = rsqrtf(vs * (1.f / 64.f) + GN_EPS); }
    }
    __syncthreads();
    const size_t rowo = (size_t)(b * SEQ + (seg * 16 + cq) * 32 + w * 8);
#pragma unroll
    for (int q = 0; q < 8; ++q) {
      const int i = w * 8 + q;
      const float yn = (Ys[i * 64 + lane] - stat[i * 2]) * stat[i * 2 + 1];
      (dry ? (u16*)(p->ws + OFF_LIN) : DA)[((rowo + q) & (dry ? 8191 : 0xffffff)) * 512 + h * 64 + lane] = f2bf((yn * lnw + lnb + dd[q] * bf2f((u16)vt[q])) * bf2f(gq[q]));
    }
    __syncthreads();
  }
  if (!dry) {
#pragma unroll
  for (int nt = 0; nt < 4; ++nt)
#pragma unroll
    for (int jj = 0; jj < 4; ++jj) so[(nt * 16 + fr) * 64 + w * 16 + fq * 4 + jj] = Sacc[nt][jj];
  }
}

__device__ __forceinline__ void gdn_scan_chain(KP p, int b, int h, int seg, bool dry) {
  const int tid = ltid(), lane = tid & 63, w = tid >> 6, fr = lane & 15, fq = lane >> 4;
  unsigned char* St = smem;
  unsigned char* Vt = smem + 128 * 272;
  u16* ORAW = dry ? (u16*)(p->ws + OFF_LIN) : (u16*)(p->ws + OFF_DE);
  f32x4 Sacc[2][8];
  float* so = p->out + OUT_GDN_P + ((size_t)b * 4 + h) * 16384;
  const float keep = seg == 0 ? 0.f : 1.f;
#pragma unroll
  for (int m = 0; m < 2; ++m) {
    const float* sbm = so + (w * 32 + m * 16 + fq * 4) * 128 + fr;
#pragma unroll
    for (int nt = 0; nt < 8; ++nt) {
#pragma unroll
      for (int j = 0; j < 4; ++j) Sacc[m][nt][j] = fminf(fmaxf(sbm[j * 128 + nt * 16], -3e38f), 3e38f) * keep;
      u16x4 o; o[0] = f2bf(Sacc[m][nt][0]); o[1] = f2bf(Sacc[m][nt][1]); o[2] = f2bf(Sacc[m][nt][2]); o[3] = f2bf(Sacc[m][nt][3]);
      *reinterpret_cast<u16x4*>(St + (nt * 16 + fr) * 272 + (w * 32 + m * 16 + fq * 4) * 2) = o;
    }
  }
  bf16x8 wn[4], qg[4], qk[2], kd[2][2]; u16x4 un[8]; float gl;
  auto loadA = [&](int n_) {
    int n = n_; asm volatile("" : "+s"(n));
    const int t = ltid(), ln = t & 63, w_ = t >> 6, fr_ = ln & 15, fq_ = ln >> 4;
    const size_t eb = (size_t)((b * 4 + h) * 8 + (n & 7)) * 8192;
    const u16* EWN = (const u16*)((const unsigned char*)p->out + EO_WN) + eb;
    const u16* EQG = (const u16*)((const unsigned char*)p->out + EO_QG) + eb;
#pragma unroll
    for (int kk = 0; kk < 4; ++kk) { wn[kk] = *reinterpret_cast<const bf16x8*>(EWN + (w_ * 16 + fr_) * 128 + kk * 32 + fq_ * 8); qg[kk] = *reinterpret_cast<const bf16x8*>(EQG + (w_ * 16 + fr_) * 128 + kk * 32 + fq_ * 8); }
  };
  auto loadU = [&](int n_) {
    int n = n_; asm volatile("" : "+s"(n));
    const int t = ltid(), ln = t & 63, w_ = t >> 6, fr_ = ln & 15, fq_ = ln >> 4;
    const size_t eb = (size_t)((b * 4 + h) * 8 + (n & 7)) * 8192;
    const u16* EUT = (const u16*)((const unsigned char*)p->out + EO_UT) + eb;
#pragma unroll
    for (int nt = 0; nt < 8; ++nt) un[nt] = *reinterpret_cast<const u16x4*>(EUT + (nt * 16 + fr_) * 64 + w_ * 16 + fq_ * 4);
  };
  auto loadB = [&](int n_) {
    int n = n_; asm volatile("" : "+s"(n));
    const int t = ltid(), ln = t & 63, w_ = t >> 6, fr_ = ln & 15, fq_ = ln >> 4;
    const int item = (b * 4 + h) * 32 + n; const size_t eb = (size_t)((b * 4 + h) * 8 + (n & 7)) * 8192;
    const u16* EKD = (const u16*)((const unsigned char*)p->out + EO_KDT) + eb; const u16* QK = (const u16*)(p->ws + OFF_QK) + (size_t)item * 4096;
    gl = ((const float*)(p->ws + OFF_GL))[item];
#pragma unroll
    for (int k2 = 0; k2 < 2; ++k2) { qk[k2] = *reinterpret_cast<const bf16x8*>(QK + (w_ * 16 + fr_) * 64 + k2 * 32 + fq_ * 8);
#pragma unroll
      for (int m = 0; m < 2; ++m) kd[m][k2] = *reinterpret_cast<const bf16x8*>(EKD + (w_ * 32 + m * 16 + fr_) * 64 + k2 * 32 + fq_ * 8); }
  };
  loadA(seg * 8); loadU(seg * 8); loadB(seg * 8);
  __syncthreads();
  for (int n = seg * 8; n < seg * 8 + 8; ++n) {
    f32x4 Oacc[8];
#pragma unroll
    for (int nt = 0; nt < 8; ++nt) {
      f32x4 va = f32x4{bf2f(un[nt][0]), bf2f(un[nt][1]), bf2f(un[nt][2]), bf2f(un[nt][3])}; Oacc[nt] = f32x4{0.f, 0.f, 0.f, 0.f};
#pragma unroll
      for (int kk = 0; kk < 4; ++kk) {
        const bf16x8 sb = *reinterpret_cast<const bf16x8*>(St + (nt * 16 + fr) * 272 + kk * 64 + fq * 16);
        va = __builtin_amdgcn_mfma_f32_16x16x32_bf16(wn[kk], sb, va, 0, 0, 0);
        Oacc[nt] = __builtin_amdgcn_mfma_f32_16x16x32_bf16(qg[kk], sb, Oacc[nt], 0, 0, 0);
      }
      u16x4 o; o[0] = f2bf(va[0]); o[1] = f2bf(va[1]); o[2] = f2bf(va[2]); o[3] = f2bf(va[3]);
      *reinterpret_cast<u16x4*>(Vt + (nt * 16 + fr) * 144 + (w * 16 + fq * 4) * 2) = o;
    }
    if (n + 1 < seg * 8 + 8) loadA(n + 1);
    __syncthreads();
    if (n + 1 < seg * 8 + 8) loadU(n + 1);
#pragma unroll
    for (int m = 0; m < 2; ++m)
#pragma unroll
      for (int nt = 0; nt < 8; ++nt) Sacc[m][nt] *= gl;
#pragma unroll
    for (int nt = 0; nt < 8; ++nt)
#pragma unroll
      for (int k2 = 0; k2 < 2; ++k2) {
        const bf16x8 vb = *reinterpret_cast<const bf16x8*>(Vt + (nt * 16 + fr) * 144 + k2 * 64 + fq * 16);
        Oacc[nt] = __builtin_amdgcn_mfma_f32_16x16x32_bf16(qk[k2], vb, Oacc[nt], 0, 0, 0);
        Sacc[0][nt] = __builtin_amdgcn_mfma_f32_16x16x32_bf16(kd[0][k2], vb, Sacc[0][nt], 0, 0, 0);
        Sacc[1][nt] = __builtin_amdgcn_mfma_f32_16x16x32_bf16(kd[1][k2], vb, Sacc[1][nt], 0, 0, 0);
      }
    if (n + 1 < seg * 8 + 8) loadB(n + 1);
#pragma unroll
    for (int m = 0; m < 2; ++m)
#pragma unroll
      for (int nt = 0; nt < 8; ++nt) {
        u16x4 o; o[0] = f2bf(Sacc[m][nt][0]); o[1] = f2bf(Sacc[m][nt][1]); o[2] = f2bf(Sacc[m][nt][2]); o[3] = f2bf(Sacc[m][nt][3]);
        *reinterpret_cast<u16x4*>(St + (nt * 16 + fr) * 272 + (w * 32 + m * 16 + fq * 4) * 2) = o;
      }
    {
      int nq = n; asm volatile("" : "+s"(nq));
#pragma unroll
      for (int j = 0; j < 4; ++j) {
        const int row = b * SEQ + nq * 64 + w * 16 + fq * 4 + j;
        u16* op = ORAW + (size_t)(dry ? (row & 8191) : row) * 512 + h * 128 + fr;
#pragma unroll
        for (int nt = 0; nt < 8; ++nt) op[nt * 16] = f2bf(Oacc[nt][j]);
      }
    }
    __syncthreads();
  }
  if (!dry)
#pragma unroll
  for (int m = 0; m < 2; ++m)
#pragma unroll
    for (int nt = 0; nt < 8; ++nt)
#pragma unroll
      for (int j = 0; j < 4; ++j) so[(w * 32 + m * 16 + fq * 4 + j) * 128 + nt * 16 + fr] = Sacc[m][nt][j];
}

__device__ __forceinline__ void phase_gdn_out(KP p) {
  const int tid = threadIdx.x, lane = tid & 63, gw = blockIdx.x * 4 + (tid >> 6), nw = gridDim.x * 4;
  const u16* ORAW = (const u16*)(p->ws + OFF_DE); u16* PJ = (u16*)(p->ws + OFF_PROJ);
  const float* gnorm = p->in[24] + (lane & 15) * 8;
  const float4 g0 = *reinterpret_cast<const float4*>(gnorm), g1 = *reinterpret_cast<const float4*>(gnorm + 4);
  const float gg[8] = {g0.x, g0.y, g0.z, g0.w, g1.x, g1.y, g1.z, g1.w};
  for (int row = gw; row < NP; row += nw) {
    const bf16x8 o8 = *reinterpret_cast<const bf16x8*>(ORAW + (size_t)row * 512 + lane * 8);
    u16* zp = PJ + (size_t)row * PCOLS + 3328 + lane * 8;
    const bf16x8 z8 = *reinterpret_cast<const bf16x8*>(zp);
    float o[8], ss = 0.f;
#pragma unroll
    for (int q = 0; q < 8; ++q) { o[q] = bf2f((u16)o8[q]); ss += o[q] * o[q]; }
    const float rs = rsqrtf(sum16(ss) * (1.f / 128.f) + NORM_EPS);
    bf16x8 r8;
#pragma unroll
    for (int q = 0; q < 8; ++q) r8[q] = (short)f2bf(o[q] * rs * gg[q] * siluf_(bf2f((u16)z8[q])));
    *reinterpret_cast<bf16x8*>(zp) = r8;
  }
}

__device__ __forceinline__ void gdn_sample_item(KP p, int b, int h, bool dry) {
  const int tid = ltid(), lane = tid & 63;
  float* cs = (float*)smem;
  float* red = cs + 384;
  float* sc = red + 512;
  const int row = NP + b;
  const u16* PJ = (const u16*)(p->ws + OFF_PROJ);
  const float* st = p->in[6] + (size_t)b * 4608; const float* cw = p->in[21];
  for (int i = tid; i < 384; i += 256) {
    const int which = i >> 7, c = i & 127, ch = which * 512 + h * 128 + c;
    float acc = st[ch] * cw[ch] + st[1536 + ch] * cw[1536 + ch] + st[3072 + ch] * cw[3072 + ch] + bf2f(PJ[(size_t)row * PCOLS + A_COLS + ch]) * cw[4608 + ch];
    cs[i] = siluf_(acc);
  }
  __syncthreads();
  if (tid < 128) {
    const int which = tid >> 6;
    const float x0 = cs[which * 128 + lane], x1 = cs[which * 128 + 64 + lane];
    const float ss = sum64(x0 * x0 + x1 * x1);
    const float s = rsqrtf(ss + 1e-6f) * (which == 0 ? 0.08838834764831845f : 1.f);
    cs[which * 128 + lane] = x0 * s; cs[which * 128 + 64 + lane] = x1 * s;
  }
  if (tid == 128) {
    const float* AB = (const float*)(p->ws + OFF_AB) + (size_t)row * 8;
    sc[0] = sigmoidf_(AB[h]); sc[1] = __expf(-__expf(p->in[22][h]) * softplusf_(AB[4 + h] + p->in[23][h]));
  }
  __syncthreads();
  if (tid < 64) { const float d = sum64(cs[lane] * cs[128 + lane] + cs[64 + lane] * cs[192 + lane]); if (lane == 0) sc[2] = d; }
  const int v = tid & 127, kh = tid >> 7;
  const float* S0 = p->in[7] + ((size_t)b * 4 + h) * 16384;
  float S[64]; float ks = 0.f, qs = 0.f;
#pragma unroll
  for (int k = 0; k < 64; ++k) { S[k] = S0[(kh * 64 + k) * 128 + v]; ks += cs[128 + kh * 64 + k] * S[k]; qs += cs[kh * 64 + k] * S[k]; }
  red[kh * 128 + v] = ks; red[256 + kh * 128 + v] = qs;
  __syncthreads();
  const float beta = sc[0], eg = sc[1], qk = sc[2];
  const float kS = red[v] + red[128 + v], qS = red[256 + v] + red[384 + v];
  const float vnew = beta * (cs[256 + v] - eg * kS);
  const float o = eg * qS + qk * vnew;
  float* so = p->out + OUT_GDN_S + ((size_t)b * 4 + h) * 16384;
#pragma unroll
  for (int k = 0; k < 64; ++k) so[(kh * 64 + k) * 128 + v] = S[k] * eg + cs[128 + kh * 64 + k] * vnew;
  __syncthreads();
  if (tid < 128) red[tid] = o * o;
  __syncthreads();
  if (tid < 64) { const float s = sum64(red[lane] + red[64 + lane]); if (lane == 0) sc[3] = s; }
  __syncthreads();
  if (tid < 128) {
    const float rs = rsqrtf(sc[3] * (1.f / 128.f) + NORM_EPS);
    u16* zp = (u16*)(p->ws + OFF_PROJ) + (size_t)row * PCOLS + 3328 + h * 128 + v;
    const float z = bf2f(*zp);
    *(dry ? (u16*)(p->ws + OFF_LIN) + (size_t)(row & 8191) * 512 + h * 128 + v : zp) = f2bf(o * rs * p->in[24][v] * siluf_(z));
  }
  __syncthreads();
}

__device__ __forceinline__ void phase_branches(KP p) {
  constexpr int NRT = MR / 128;
  u16* PA = (u16*)(p->ws + OFF_DE); u16* PB = (u16*)p->out;
  const XTiles XT = xt_make(NRT, 16, 8);
  for (int t = XT.lb; t < XT.total; t += XT.nb) {
    int ct2, rt; xt_get(XT, t, rt, ct2); const int which = ct2 >> 3, ct = ct2 & 7;
    const int row0 = rt * 128, col0 = ct * 128;
    f32x4 acc[4][4];
    if (which == 0) gemm_mainloop((const u16*)(p->ws + OFF_DA) + (size_t)row0 * 512, 512, (const u16*)(p->ws + OFF_WAT) + (size_t)col0 * 512, 512, 512, acc);
    else gemm_mainloop((const u16*)(p->ws + OFF_PROJ) + (size_t)row0 * PCOLS + 3328, PCOLS, (const u16*)(p->ws + OFF_WBT) + (size_t)col0 * 512, 512, 512, acc);
    u16* O = which == 0 ? PA : PB;
    EPI_COORDS
#pragma unroll
    for (int m = 0; m < 4; ++m)
#pragma unroll
      for (int j = 0; j < 4; ++j)
#pragma unroll
        for (int n = 0; n < 4; ++n) ((u16*)smem)[(wr_ * 64 + m * 16 + fq_ * 4 + j) * 136 + wc_ * 64 + n * 16 + fr_] = f2bf(acc[m][n][j]);
    tile_flush_bf16<128>(O, 1024, row0, col0, 1024);
  }
  u16* PE = (u16*)(p->ws + OFF_LIN);
  const int gt = blockIdx.x * 256 + threadIdx.x, nt = gridDim.x * 256;
  for (int i = gt; i < MR * 64; i += nt) {
    const int row = i >> 6, c4 = (i & 63) * 4;
    const float* src = row < NP ? p->in[2] + (size_t)row * 256 : p->in[3] + (size_t)(row - NP) * 256;
    const float4 v = *reinterpret_cast<const float4*>(src + c4);
    u16x4 o; o[0] = f2bf(v.x); o[1] = f2bf(v.y); o[2] = f2bf(v.z); o[3] = f2bf(v.w);
    *reinterpret_cast<u16x4*>(PE + (size_t)row * 256 + c4) = o;
  }
}
__device__ __forceinline__ void phase_gates(KP p) {
  constexpr int NRT = MR / 128;
  u16* PA = (u16*)(p->ws + OFF_DE); const u16* PB = (const u16*)p->out;
  const XTiles XT = xt_make(NRT, 16, 8);
  for (int t = XT.lb; t < XT.total; t += XT.nb) {
    int ct, rt; xt_get(XT, t, rt, ct); const int row0 = rt * 128, col0 = ct * 128;
    f32x4 acc[4][4];
    gemm_mainloop((const u16*)(p->ws + OFF_U) + (size_t)row0 * 1024, 1024, (const u16*)(p->ws + OFF_WGI) + (size_t)col0 * 1024, 1024, 1024, acc);
    EPI_COORDS
#pragma unroll
    for (int m = 0; m < 4; ++m) {
      u16 pa[4][2], pb[4][2];
#pragma unroll
      for (int j = 0; j < 4; ++j) { const size_t ob = (size_t)(row0 + wr_ * 64 + m * 16 + fq_ * 4 + j) * 1024 + (col0 + wc_ * 64) / 2 + fr_;
#pragma unroll
        for (int q = 0; q < 2; ++q) { pa[j][q] = PA[ob + q * 16]; pb[j][q] = PB[ob + q * 16]; } }
#pragma unroll
      for (int j = 0; j < 4; ++j) { const size_t ob = (size_t)(row0 + wr_ * 64 + m * 16 + fq_ * 4 + j) * 1024 + (col0 + wc_ * 64) / 2 + fr_;
#pragma unroll
        for (int q = 0; q < 2; ++q)
          PA[ob + q * 16] = f2bf(sigmoidf_(acc[m][2 * q][j]) * bf2f(pa[j][q]) + sigmoidf_(acc[m][2 * q + 1][j]) * bf2f(pb[j][q]));
      }
    }
  }
}
__device__ __forceinline__ void phase_wout(KP p) {
  constexpr int NRT = MR / 128;
  u16* HG = (u16*)(p->ws + OFF_U); float* rss = (float*)(p->ws + OFF_RSS); const float* gain = p->in[28];
  const XTiles XT = xt_make(NRT, 8, 8);
  for (int t = XT.lb; t < XT.total; t += XT.nb) {
    int ct, rt; xt_get(XT, t, rt, ct); const int row0 = rt * 128, col0 = ct * 128;
    f32x4 acc[4][4];
    gemm_mainloop((const u16*)(p->ws + OFF_DE) + (size_t)row0 * 1024, 1024, (const u16*)(p->ws + OFF_WOT) + (size_t)col0 * 1024, 1024, 1024, acc);
    EPI_COORDS
    float* outp = p->out; float g4[4];
#pragma unroll
    for (int n = 0; n < 4; ++n) g4[n] = gain[col0 + wc_ * 64 + n * 16 + fr_];
#pragma unroll
    for (int m = 0; m < 4; ++m) {
      float res[4][4];
#pragma unroll
      for (int j = 0; j < 4; ++j) { const float* xr = xrow(p, row0 + wr_ * 64 + m * 16 + fq_ * 4 + j) + col0 + wc_ * 64 + fr_;
#pragma unroll
        for (int n = 0; n < 4; ++n) res[j][n] = xr[n * 16]; }
#pragma unroll
      for (int j = 0; j < 4; ++j) {
        const int row = row0 + wr_ * 64 + m * 16 + fq_ * 4 + j; float ss = 0.f;
        const size_t ob = (size_t)row * 1024 + col0 + wc_ * 64 + fr_;
#pragma unroll
        for (int n = 0; n < 4; ++n) {
          const float hv = res[j][n] + acc[m][n][j];
          outp[ob + n * 16] = hv; HG[ob + n * 16] = f2bf(hv * g4[n]); ss += hv * hv;
        }
        ss = sum16(ss);
        if (fr_ == 0) atomicAdd(rss + row, ss);
      }
    }
  }
}
__device__ __forceinline__ void phase_ffn_up(KP p) {
  constexpr int NRT = MR / 128;
  u16* ACT = (u16*)(p->ws + OFF_ACT); const float* rss = (const float*)(p->ws + OFF_RSS);
  const XTiles XT = xt_make(NRT, 44, 6);
  for (int t = XT.lb; t < XT.total; t += XT.nb) {
    int ct, rt; xt_get(XT, t, rt, ct); const int row0 = rt * 128, col0 = ct * 128;
    f32x4 acc[4][4];
    gemm_mainloop((const u16*)(p->ws + OFF_U) + (size_t)row0 * 1024, 1024, (const u16*)(p->ws + OFF_WGU) + (size_t)col0 * 1024, 1024, 1024, acc);
    EPI_COORDS
    float rsv[4][4];
#pragma unroll
    for (int m = 0; m < 4; ++m)
#pragma unroll
      for (int j = 0; j < 4; ++j) rsv[m][j] = rss[row0 + wr_ * 64 + m * 16 + fq_ * 4 + j];
#pragma unroll
    for (int m = 0; m < 4; ++m)
#pragma unroll
      for (int j = 0; j < 4; ++j) {
        const int row = row0 + wr_ * 64 + m * 16 + fq_ * 4 + j;
        const float rs = rsqrtf(rsv[m][j] * (1.f / 1024.f) + NORM_EPS);
#pragma unroll
        for (int q = 0; q < 2; ++q)
          ((u16*)smem)[(row - row0) * 72 + wc_ * 32 + q * 16 + fr_] = f2bf(siluf_(rs * acc[m][2 * q][j]) * (rs * acc[m][2 * q + 1][j]));
      }
    tile_flush_bf16<64>(ACT, DFF, row0, col0 / 2, DFF);
  }
}
__device__ __forceinline__ void phase_ffn_down(KP p) {
  constexpr int NRT = MR / 128;
  u16* HG = (u16*)(p->ws + OFF_U); float* rss = (float*)(p->ws + OFF_RSS) + MR; const float* gain = p->in[32];
  u16* PP = (u16*)(p->ws + OFF_PP);
  const XTiles XT = xt_make(NRT, 16, 8);
  for (int t = XT.lb; t < XT.total; t += XT.nb) {
    int ct2, rt; xt_get(XT, t, rt, ct2); const int which = ct2 >> 3, ct = ct2 & 7; const int row0 = rt * 128, col0 = ct * 128;
    f32x4 acc[4][4];
    if (which == 0) {
      gemm_mainloop((const u16*)(p->ws + OFF_ACT) + (size_t)row0 * DFF, DFF, (const u16*)(p->ws + OFF_WDT) + (size_t)col0 * DFF, DFF, DFF, acc);
      EPI_COORDS
      float* outp = p->out; float g4[4];
#pragma unroll
      for (int n = 0; n < 4; ++n) g4[n] = gain[col0 + wc_ * 64 + n * 16 + fr_];
#pragma unroll
      for (int m = 0; m < 4; ++m) {
        float res[4][4];
#pragma unroll
        for (int j = 0; j < 4; ++j) { const float* hr = outp + (size_t)(row0 + wr_ * 64 + m * 16 + fq_ * 4 + j) * 1024 + col0 + wc_ * 64 + fr_;
#pragma unroll
          for (int n = 0; n < 4; ++n) res[j][n] = hr[n * 16]; }
#pragma unroll
        for (int j = 0; j < 4; ++j) {
          const int row = row0 + wr_ * 64 + m * 16 + fq_ * 4 + j; float ss = 0.f;
          const size_t ob = (size_t)row * 1024 + col0 + wc_ * 64 + fr_;
#pragma unroll
          for (int n = 0; n < 4; ++n) {
            const float hv = res[j][n] + acc[m][n][j];
            outp[ob + n * 16] = hv; HG[ob + n * 16] = f2bf(hv * g4[n]); ss += hv * hv;
          }
          ss = sum16(ss);
          if (fr_ == 0) atomicAdd(rss + row, ss);
        }
      }
    } else {
      gemm_mainloop((const u16*)(p->ws + OFF_LIN) + (size_t)row0 * 256, 256, (const u16*)(p->ws + OFF_WPP) + (size_t)col0 * 256, 256, 256, acc);
      EPI_COORDS
#pragma unroll
      for (int m = 0; m < 4; ++m)
#pragma unroll
        for (int j = 0; j < 4; ++j) {
          const int row = row0 + wr_ * 64 + m * 16 + fq_ * 4 + j;
#pragma unroll
          for (int n = 0; n < 4; ++n) PP[(size_t)row * 1024 + col0 + wc_ * 64 + n * 16 + fr_] = f2bf(acc[m][n][j]);
        }
    }
  }
}
__device__ __forceinline__ void phase_ple(KP p) {
  constexpr int NRT = MR / 128;
  const float* rss2 = (const float*)(p->ws + OFF_RSS) + MR; float* rss3 = (float*)(p->ws + OFF_RSS) + 2 * MR;
  const u16* PP = (const u16*)(p->ws + OFF_PP);
  const XTiles XT = xt_make(NRT, 8, 8);
  for (int t = XT.lb; t < XT.total; t += XT.nb) {
    int ct, rt; xt_get(XT, t, rt, ct); const int row0 = rt * 128, col0 = ct * 128;
    f32x4 acc[4][4];
    gemm_mainloop((const u16*)(p->ws + OFF_U) + (size_t)row0 * 1024, 1024, (const u16*)(p->ws + OFF_WPG) + (size_t)col0 * 1024, 1024, 1024, acc);
    EPI_COORDS
    float* outp = p->out;
#pragma unroll
    for (int m = 0; m < 4; ++m) {
      float res[4][4]; u16 pp[4][4]; float rsv[4];
#pragma unroll
      for (int j = 0; j < 4; ++j) { const size_t ob = (size_t)(row0 + wr_ * 64 + m * 16 + fq_ * 4 + j) * 1024 + col0 + wc_ * 64 + fr_;
        rsv[j] = rss2[row0 + wr_ * 64 + m * 16 + fq_ * 4 + j];
#pragma unroll
        for (int n = 0; n < 4; ++n) { res[j][n] = outp[ob + n * 16]; pp[j][n] = PP[ob + n * 16]; } }
#pragma unroll
      for (int j = 0; j < 4; ++j) {
        const int row = row0 + wr_ * 64 + m * 16 + fq_ * 4 + j; float ss = 0.f;
        const float rs = rsqrtf(rsv[j] * (1.f / 1024.f) + NORM_EPS);
        const size_t ob = (size_t)row * 1024 + col0 + wc_ * 64 + fr_;
#pragma unroll
        for (int n = 0; n < 4; ++n) {
          const float hv = res[j][n] + sigmoidf_(rs * acc[m][n][j]) * bf2f(pp[j][n]);
          outp[ob + n * 16] = hv; ss += hv * hv;
        }
        ss = sum16(ss);
        if (fr_ == 0) atomicAdd(rss3 + row, ss);
      }
    }
  }
}
__device__ __forceinline__ void phase_final(KP p) {
  const float* rss3 = (const float*)(p->ws + OFF_RSS) + 2 * MR; const float* gain = p->in[35];
  const int gt = blockIdx.x * 256 + threadIdx.x, nt = gridDim.x * 256;
  for (int i = gt; i < MR * 256; i += nt) {
    const int row = i >> 8, c4 = (i & 255) * 4;
    const float rs = rsqrtf(rss3[row] * (1.f / 1024.f) + NORM_EPS);
    float4 v = *reinterpret_cast<float4*>(p->out + (size_t)row * 1024 + c4);
    const float4 g = *reinterpret_cast<const float4*>(gain + c4);
    v.x *= rs * g.x; v.y *= rs * g.y; v.z *= rs * g.z; v.w *= rs * g.w;
#ifdef PROBE_TS
    { const unsigned long long* ts = (const unsigned long long*)(p->ws + OFF_BAR + 14336);
      float d1 = 0.f, d2 = 0.f;
      PROBE_D1; PROBE_D2;
      if (row >= NP) { const float sc = 1.f + d1 * 1e-5f; v.x *= sc; v.y *= sc; v.z *= sc; v.w *= sc; }
      if (i == 0) v.x += d2 * 0.01f; }
#endif
    *reinterpret_cast<float4*>(p->out + (size_t)row * 1024 + c4) = v;
  }
}


#define XB_TMO      128
#define XB_XCNT(j)  (256  + 64 * (j))
#define XB_XSUB(j)  (1280 + 64 * (j))
#define XB_XGEN(j)  (2304 + 64 * (j))
#define XB_TOP      3328
#define XB_TOPGEN   3392
#define XCD_BAR_WORDS 3456
#define XB_SPIN_CAP (1u << 22)
#define LAS __attribute__((address_space(3)))
__device__ __forceinline__ unsigned xb_ld(unsigned* p) { return __hip_atomic_load(p, __ATOMIC_RELAXED, __HIP_MEMORY_SCOPE_AGENT); }
__device__ __forceinline__ unsigned xb_add(unsigned* p, unsigned v) { return __hip_atomic_fetch_add(p, v, __ATOMIC_RELAXED, __HIP_MEMORY_SCOPE_AGENT); }
__device__ __forceinline__ unsigned xb_xcc_id() { return (unsigned)__builtin_amdgcn_s_getreg((3 << 11) | 20) & 0xFu; }
#define XB_SPIN(cond, bar) do { unsigned _sp = 0; while (cond) { __builtin_amdgcn_s_sleep(1); \
    if ((++_sp & 255u) == 0u) { if (xb_ld(&(bar)[XB_TMO])) break; if (_sp > XB_SPIN_CAP) { atomicAdd(&(bar)[XB_TMO], 1u); break; } } } } while (0)
struct XcdBarrier { unsigned* bar; unsigned x; volatile LAS unsigned* st; };
__device__ __forceinline__ XcdBarrier xcd_barrier_post(unsigned* bar, volatile LAS unsigned* st) {
  XcdBarrier b; b.bar = bar; b.x = xb_xcc_id(); b.st = st;
  if (threadIdx.x == 0) (void)xb_add(&bar[XB_XCNT(b.x)], 1u);
  return b;
}
__device__ __forceinline__ void xcd_barrier_complete(unsigned* bar, unsigned x, unsigned& nloc, unsigned& nx) {
  const unsigned G = gridDim.x * gridDim.y * gridDim.z;
  unsigned sum, cnt, mine, sp = 0u;
  for (;;) {
    sum = 0u; cnt = 0u; mine = 0u;
#pragma unroll
    for (unsigned j = 0; j < 16; ++j) { const unsigned c = xb_ld(&bar[XB_XCNT(j)]); sum += c; cnt += (c > 0u) ? 1u : 0u; mine = (j == x) ? c : mine; }
    if (sum == G) break;
    __builtin_amdgcn_s_sleep(1);
    if ((++sp & 255u) == 0u) { if (xb_ld(&bar[XB_TMO])) break; if (sp > XB_SPIN_CAP) { atomicAdd(&bar[XB_TMO], 1u); break; } }
  }
  nloc = mine > 0u ? mine : 1u; nx = cnt > 0u ? cnt : 1u;
}
__device__ __forceinline__ void xcd_barrier(const XcdBarrier& b) {
  asm volatile("s_waitcnt vmcnt(0)" ::: "memory");
  __syncthreads();
  if (threadIdx.x == 0) {
    unsigned* bar = b.bar;
    __builtin_amdgcn_s_waitcnt(0);
    unsigned nloc = b.st[0], nx = b.st[1];
    if (nloc == 0u) { xcd_barrier_complete(bar, b.x, nloc, nx); b.st[0] = nloc; b.st[1] = nx; }
    const unsigned old = xb_add(&bar[XB_XSUB(b.x)], 1u);
    const unsigned gen = old / nloc;
    if (old + 1u == (gen + 1u) * nloc) {
      __builtin_amdgcn_fence(__ATOMIC_RELEASE, "agent");
      asm volatile("s_waitcnt vmcnt(0)" ::: "memory");
      const unsigned og = xb_add(&bar[XB_TOP], 1u);
      const unsigned tg = og / nx;
      if (og + 1u == (tg + 1u) * nx) xb_add(&bar[XB_TOPGEN], 1u);
      else XB_SPIN(xb_ld(&bar[XB_TOPGEN]) == tg, bar);
      __builtin_amdgcn_fence(__ATOMIC_ACQUIRE, "agent");
      xb_add(&bar[XB_XGEN(b.x)], 1u);
      asm volatile("s_waitcnt vmcnt(0)" ::: "memory");
    } else {
      XB_SPIN(xb_ld(&bar[XB_XGEN(b.x)]) == gen, bar);
      __builtin_amdgcn_fence(__ATOMIC_ACQUIRE, "agent");
      asm volatile("s_waitcnt vmcnt(0)" ::: "memory");
    }
  }
  __syncthreads();
}

#ifdef PROBE_TS
#define TS(k) do { if (blockIdx.x == 0 && threadIdx.x == 0) ((unsigned long long*)(p->ws + OFF_BAR + 14336))[k] = __builtin_amdgcn_s_memrealtime(); } while (0)
#else
#define TS(k) do { } while (0)
#endif
__global__ void __launch_bounds__(256, 2) hybrid_fwd(Params pv) {
  KP p = (KP)__builtin_amdgcn_kernarg_segment_ptr();
  cg::grid_group grid = cg::this_grid();
  volatile LAS unsigned* xst = (volatile LAS unsigned*)(smem + LDS_BYTES - 16);
  if (threadIdx.x == 0) { xst[0] = 0u; xst[1] = 0u; }
  __syncthreads();
  const XcdBarrier xb = xcd_barrier_post((unsigned*)(p->ws + OFF_BAR), xst);
  TS(0);
  phase_prep(p);
  if (p->ws == nullptr) grid.sync();
  xcd_barrier(xb); TS(1);
  phase_proj(p);
  xcd_barrier(xb); TS(2);
  phase_lora_in(p);
  xcd_barrier(xb); TS(3);
  phase_lora(p);
  xcd_barrier(xb); TS(4);
  {
    const int G = gridDim.x, bid = blockIdx.x;
    unsigned char* recs = (unsigned char*)p->out;
#pragma unroll 1
    for (int seg = 0; seg < 4; ++seg) {
      int sg = seg; asm volatile("" : "+s"(sg));
#ifndef PROBE_PREP_N
#define PROBE_PREP_N 1
#endif
#ifndef PROBE_SCAN_N
#define PROBE_SCAN_N 1
#endif
      int nprep = PROBE_PREP_N, nscan = PROBE_SCAN_N;
      if (PROBE_PREP_N > 1) asm volatile("" : "+s"(nprep));
      if (PROBE_SCAN_N > 1) asm volatile("" : "+s"(nscan));
      for (int rep = 0; rep < nprep; ++rep)
      for (int it = bid; it < 1024 + 256; it += G) {
        if (it < 1024) rwkv_prep_item(p, it >> 4, sg * 16 + (it & 15), recs + (size_t)it * RW_REC);
        else gdn_prep_item(p, ((it - 1024) >> 3) * 32 + sg * 8 + ((it - 1024) & 7));
      }
      xcd_barrier(xb); TS(5 + 2 * seg);
      for (int rep = 0; rep < nscan; ++rep) {
        const bool dry = rep + 1 < nscan;
#ifndef PROBE_SCAN_MASK
#define PROBE_SCAN_MASK 3
#endif
        if (bid < 64) { if (!dry || (PROBE_SCAN_MASK & 1)) rwkv_scan_seg(p, bid, sg, recs, dry); }
        else if (bid < 96) { if (!dry || (PROBE_SCAN_MASK & 2)) gdn_scan_chain(p, (bid - 64) >> 2, (bid - 64) & 3, sg, dry); }
        if (dry) xcd_barrier(xb);
      }
      if (bid < 96) { }
      else if (seg == 0) {
        for (int it = bid - 96; it < 1024; it += G - 96) rwkv_chain<true>(p, 8 + (it >> 3), it & 7, false);
        for (int it = (G - 1 - bid); it < 512; it += G - 96) gdn_sample_item(p, it >> 2, it & 3, false);
      }
      if (seg < 3) { xcd_barrier(xb); TS(6 + 2 * seg); }
    }
  }
  xcd_barrier(xb); TS(12);
  phase_gdn_out(p);
  xcd_barrier(xb);
  phase_branches(p);
  xcd_barrier(xb); TS(13);
  phase_gates(p);
  xcd_barrier(xb); TS(14);
  phase_wout(p);
  xcd_barrier(xb); TS(15);
  phase_ffn_up(p);
  xcd_barrier(xb); TS(16);
  phase_ffn_down(p);
  xcd_barrier(xb); TS(17);
  phase_ple(p);
  xcd_barrier(xb); TS(18);
  phase_final(p);
}

extern "C" void kernel_launch(void* const* d_in, const int* in_sizes, int n_in, void* d_out, int out_size, void* d_ws, size_t ws_size,
                              hipStream_t stream) {
  static int grid_blocks = 0;
  if (!grid_blocks) {
    int dev = 0, cus = 0, per_cu = 0;
    hipGetDevice(&dev);
    hipDeviceGetAttribute(&cus, hipDeviceAttributeMultiprocessorCount, dev);
    hipFuncSetAttribute((const void*)hybrid_fwd, hipFuncAttributeMaxDynamicSharedMemorySize, LDS_BYTES);
    hipOccupancyMaxActiveBlocksPerMultiprocessor(&per_cu, (const void*)hybrid_fwd, 256, LDS_BYTES);
    if (per_cu > 2) per_cu = 2;
    if (per_cu < 1) per_cu = 1;
    grid_blocks = cus * per_cu;
  }
  Params p{};
  for (int i = 0; i < 36; ++i) p.in[i] = (const float*)d_in[i];
  p.out = (float*)d_out; p.ws = (unsigned char*)d_ws;
  (void)hipMemsetAsync((unsigned char*)d_ws + OFF_BAR, 0, 16384, stream);
  void* args[] = {&p};
  hipError_t e = hipLaunchCooperativeKernel((const void*)hybrid_fwd, dim3(grid_blocks), dim3(256), args, LDS_BYTES, stream);
  if (e != hipSuccess) fprintf(stderr, "cooperative launch failed: %s (grid %d)\n", hipGetErrorString(e), grid_blocks);
}
```

```cpp
#include <hip/hip_runtime.h>
#include <hip/hip_bf16.h>
#include <hip/hip_cooperative_groups.h>
#include <cstdio>
namespace cg = cooperative_groups;

typedef unsigned short u16;
using bf16x8 = __attribute__((ext_vector_type(8))) short;
using u16x4 = __attribute__((ext_vector_type(4))) unsigned short;
using f32x4 = __attribute__((ext_vector_type(4))) float;

constexpr int D = 1024, NP = 16384, NS = 128, MR = NP + NS;
constexpr int SEQ = 2048;
constexpr int A_COLS = 1792, PCOLS = 3848;
constexpr int IN_COLS = 5896, DFF = 2816;
constexpr float NORM_EPS = 1e-6f, GN_EPS = 64e-5f;

constexpr long OUT_Y = 0;
constexpr long OUT_SHIFT_P = (long)MR * D;
constexpr long OUT_WKV_P = OUT_SHIFT_P + 8 * 1792;
constexpr long OUT_CONV_P = OUT_WKV_P + 8L * 8 * 64 * 64;
constexpr long OUT_GDN_P = OUT_CONV_P + 8 * 3 * 1536;
constexpr long OUT_SHIFT_S = OUT_GDN_P + 8L * 4 * 128 * 128;
constexpr long OUT_WKV_S = OUT_SHIFT_S + 128 * 1792;
constexpr long OUT_CONV_S = OUT_WKV_S + 128L * 8 * 64 * 64;
constexpr long OUT_GDN_S = OUT_CONV_S + 128 * 3 * 1536;

constexpr size_t OFF_WINT = 0;
constexpr size_t OFF_WGI = OFF_WINT + (size_t)PCOLS * 1024 * 2;
constexpr size_t OFF_W2T = OFF_WGI + (size_t)2048 * 1024 * 2;
constexpr size_t OFF_A2T = OFF_W2T + 512 * 64 * 2;
constexpr size_t OFF_G2T = OFF_A2T + 512 * 64 * 2;
constexpr size_t OFF_WAT = OFF_G2T + 512 * 128 * 2;
constexpr size_t OFF_WBT = OFF_WAT + 1024 * 512 * 2;
constexpr size_t OFF_WOT = OFF_WBT + 1024 * 512 * 2;
constexpr size_t OFF_WGU = OFF_WOT + 1024 * 1024 * 2;
constexpr size_t OFF_WDT = OFF_WGU + (size_t)5632 * 1024 * 2;
constexpr size_t OFF_WPG = OFF_WDT + (size_t)1024 * 2816 * 2;
constexpr size_t OFF_WPP = OFF_WPG + 1024 * 1024 * 2;
constexpr size_t OFF_U = OFF_WPP + 1024 * 256 * 2;
constexpr size_t OFF_PROJ = OFF_U + (size_t)MR * 1024 * 2;
constexpr size_t OFF_DA = OFF_PROJ + (size_t)MR * PCOLS * 2;
constexpr size_t OFF_DE = OFF_DA + (size_t)MR * 512 * 2;
constexpr size_t OFF_DG = OFF_DE + (size_t)MR * 512 * 2;
constexpr size_t OFF_QK = OFF_DG + (size_t)MR * 512 * 2;
constexpr size_t OFF_LIN = OFF_QK + (size_t)1024 * 64 * 64 * 2;
constexpr size_t OFF_RSS = OFF_LIN + (size_t)MR * 256 * 2;
constexpr size_t OFF_AB = OFF_RSS + (size_t)3 * MR * 4;
constexpr size_t OFF_GL = OFF_AB + (size_t)MR * 8 * 4;
constexpr size_t OFF_BAR = OFF_GL + 4096;
constexpr size_t OFF_END = OFF_BAR + 16384;
constexpr size_t OFF_ACT = OFF_PROJ;
constexpr size_t OFF_PP = OFF_PROJ + (size_t)MR * DFF * 2;
static_assert(OFF_PP + (size_t)MR * 1024 * 2 <= OFF_DA, "pp overflow");
static_assert(OFF_END <= 268435456ull, "ws overflow");
constexpr size_t EO_UT = 37748736, EO_WN = EO_UT + 4194304, EO_QG = EO_WN + 4194304, EO_KDT = EO_QG + 4194304;

struct Params { const float* in[36]; float* out; unsigned char* ws; };
typedef const __attribute__((address_space(4))) Params* KP;

extern __shared__ __attribute__((aligned(16))) unsigned char smem[];
constexpr int LDS_BYTES = 72192;

__device__ __forceinline__ int ltid() { int t = threadIdx.x; asm volatile("" : "+v"(t)); return t; }
__device__ __forceinline__ u16 f2bf(float f) { unsigned u = __float_as_uint(f); u += 0x7fffu + ((u >> 16) & 1u); return (u16)(u >> 16); }
__device__ __forceinline__ float bf2f(u16 h) { return __uint_as_float(((unsigned)h) << 16); }
__device__ __forceinline__ float sigmoidf_(float x) { return 1.f / (1.f + __expf(-x)); }
__device__ __forceinline__ float siluf_(float x) { return x / (1.f + __expf(-x)); }
__device__ __forceinline__ float softplusf_(float x) { return fmaxf(x, 0.f) + log1pf(__expf(-fabsf(x))); }
__device__ __forceinline__ float quad_sum(float x) {
  x += __int_as_float(__builtin_amdgcn_update_dpp(0, __float_as_int(x), 0xB1, 0xF, 0xF, true));
  x += __int_as_float(__builtin_amdgcn_update_dpp(0, __float_as_int(x), 0x4E, 0xF, 0xF, true));
  return x;
}
__device__ __forceinline__ float sum16(float x) {
  x += __shfl_xor(x, 1); x += __shfl_xor(x, 2); x += __shfl_xor(x, 4); x += __shfl_xor(x, 8); return x;
}
__device__ __forceinline__ float sum64(float x) { x = sum16(x); x += __shfl_xor(x, 16); x += __shfl_xor(x, 32); return x; }
__device__ __forceinline__ const float* xrow(KP p, int row) {
  return row < NP ? p->in[0] + (size_t)row * D : p->in[1] + (size_t)(row - NP) * D;
}

__device__ __forceinline__ void gemm_mainloop(const u16* __restrict__ A, long lda, const u16* __restrict__ Bt, long ldb, int K,
                                              f32x4 (&acc)[4][4]) {
  const int tid = threadIdx.x, lane = tid & 63, wid = tid >> 6, wr = wid >> 1, wc = wid & 1, fr = lane & 15, fq = lane >> 4;
  unsigned char* SA = smem; unsigned char* SB = smem + 16384;
#pragma unroll
  for (int m = 0; m < 4; ++m)
#pragma unroll
    for (int n = 0; n < 4; ++n) acc[m][n] = f32x4{0.f, 0.f, 0.f, 0.f};
  const int nk = K >> 6;
  for (int kt = 0; kt < nk; ++kt) {
#pragma unroll
    for (int i = 0; i < 4; ++i) {
      const int b = tid * 16 + i * 4096, r = b >> 7, c = (((b & 127) >> 4) ^ (r & 7)) * 8;
      __builtin_amdgcn_global_load_lds((const unsigned*)(A + (long)r * lda + kt * 64 + c), (unsigned*)(SA + b), 16, 0, 0);
      __builtin_amdgcn_global_load_lds((const unsigned*)(Bt + (long)r * ldb + kt * 64 + c), (unsigned*)(SB + b), 16, 0, 0);
    }
    asm volatile("s_waitcnt vmcnt(0)" ::: "memory");
    __syncthreads();
#pragma unroll
    for (int kk = 0; kk < 2; ++kk) {
      bf16x8 a[4], b[4];
#pragma unroll
      for (int m = 0; m < 4; ++m) { const int r = wr * 64 + m * 16 + fr; a[m] = *reinterpret_cast<const bf16x8*>(SA + r * 128 + (((kk * 4 + fq) ^ (r & 7)) << 4)); }
#pragma unroll
      for (int n = 0; n < 4; ++n) { const int r = wc * 64 + n * 16 + fr; b[n] = *reinterpret_cast<const bf16x8*>(SB + r * 128 + (((kk * 4 + fq) ^ (r & 7)) << 4)); }
#pragma unroll
      for (int m = 0; m < 4; ++m)
#pragma unroll
        for (int n = 0; n < 4; ++n) acc[m][n] = __builtin_amdgcn_mfma_f32_16x16x32_bf16(a[m], b[n], acc[m][n], 0, 0, 0);
    }
    __syncthreads();
  }
}

struct XTiles { int x, lb, nb, nr, nct, W, ng, total; };
__device__ __forceinline__ XTiles xt_make(int nrt, int nct, int W) {
  XTiles t; t.x = blockIdx.x & 7; t.lb = blockIdx.x >> 3; t.nb = gridDim.x >> 3;
  t.nr = (nrt - t.x + 7) >> 3; t.nct = nct; t.W = W; t.ng = (nct + W - 1) / W; t.total = t.nr * nct; return t;
}
__device__ __forceinline__ void xt_get(const XTiles& t, int u, int& rt, int& ct) {
  int g = u / (t.W * t.nr); if (g > t.ng - 1) g = t.ng - 1;
  const int rem = u - g * t.W * t.nr; const int wg = (g == t.ng - 1) ? t.nct - g * t.W : t.W;
  const int rl = rem / wg, cl = rem - rl * wg; rt = t.x + 8 * rl; ct = g * t.W + cl;
}
#define EPI_COORDS const int tid_ = threadIdx.x, lane_ = tid_ & 63, wid_ = tid_ >> 6, wr_ = wid_ >> 1, wc_ = wid_ & 1, fr_ = lane_ & 15, fq_ = lane_ >> 4; (void)wc_; (void)wr_; (void)fr_; (void)fq_;

template <int NC>
__device__ __forceinline__ void tile_flush_bf16(u16* __restrict__ dst, long ld, int row0, int col0, int col_limit) {
  __syncthreads();
  const u16* T = (const u16*)smem;
  constexpr int CPR = NC / 8;
#pragma unroll
  for (int i = 0; i < (128 * CPR) / 256; ++i) {
    const int c = threadIdx.x + i * 256, r = c / CPR, chk = c % CPR;
    const bf16x8 v = *reinterpret_cast<const bf16x8*>(T + r * (NC + 8) + chk * 8);
    if (col0 + chk * 8 < col_limit) *reinterpret_cast<bf16x8*>(dst + (long)(row0 + r) * ld + col0 + chk * 8) = v;
  }
  __syncthreads();
}

struct TJob { const float* src; int ld_src; int K; int N; u16* dst; int ld_dst; int ilv; };
__device__ __forceinline__ TJob get_job(KP p, int j) {
  unsigned char* ws = p->ws; TJob t;
  switch (j) {
    case 0: t = TJob{p->in[9], IN_COLS, 1024, PCOLS, (u16*)(ws + OFF_WINT), 1024, 0}; break;
    case 1: t = TJob{p->in[9] + PCOLS, IN_COLS, 1024, 1024, (u16*)(ws + OFF_WGI), 1024, 1}; break;
    case 2: t = TJob{p->in[9] + PCOLS + 1024, IN_COLS, 1024, 1024, (u16*)(ws + OFF_WGI), 1024, 2}; break;
    case 3: t = TJob{p->in[12], 512, 64, 512, (u16*)(ws + OFF_W2T), 64, 0}; break;
    case 4: t = TJob{p->in[14], 512, 64, 512, (u16*)(ws + OFF_A2T), 64, 0}; break;
    case 5: t = TJob{p->in[15], 512, 128, 512, (u16*)(ws + OFF_G2T), 128, 0}; break;
    case 6: t = TJob{p->in[25], 1024, 512, 1024, (u16*)(ws + OFF_WAT), 512, 0}; break;
    case 7: t = TJob{p->in[26], 1024, 512, 1024, (u16*)(ws + OFF_WBT), 512, 0}; break;
    case 8: t = TJob{p->in[27], 1024, 1024, 1024, (u16*)(ws + OFF_WOT), 1024, 0}; break;
    case 9: t = TJob{p->in[29], DFF, 1024, DFF, (u16*)(ws + OFF_WGU), 1024, 1}; break;
    case 10: t = TJob{p->in[30], DFF, 1024, DFF, (u16*)(ws + OFF_WGU), 1024, 2}; break;
    case 11: t = TJob{p->in[31], 1024, DFF, 1024, (u16*)(ws + OFF_WDT), DFF, 0}; break;
    case 12: t = TJob{p->in[33], 1024, 1024, 1024, (u16*)(ws + OFF_WPG), 1024, 0}; break;
    default: t = TJob{p->in[34], 1024, 256, 1024, (u16*)(ws + OFF_WPP), 256, 0}; break;
  }
  return t;
}
__device__ __forceinline__ int job_tiles(const TJob& t) { return (t.K >> 6) * ((t.N + 63) >> 6); }

__device__ __forceinline__ void phase_prep(KP p) {
  const int tid = threadIdx.x;
  float* T = (float*)smem;
  int total = 0;
  for (int j = 0; j < 14; ++j) { TJob t = get_job(p, j); total += job_tiles(t); }
  for (int g = blockIdx.x; g < total; g += gridDim.x) {
    int j = 0, rem = g; TJob t = get_job(p, 0);
    for (;;) { int nt_ = job_tiles(t); if (rem < nt_) break; rem -= nt_; ++j; t = get_job(p, j); }
    const int nkt = t.K >> 6; const int kt = rem % nkt, nt = rem / nkt;
#pragma unroll
    for (int i = 0; i < 4; ++i) {
      const int k = (tid >> 4) + 16 * i, n4 = (tid & 15) * 4, n = nt * 64 + n4;
      float4 v = *reinterpret_cast<const float4*>(t.src + (long)(kt * 64 + k) * t.ld_src + (n < t.N ? n : 0));
      if (n >= t.N) v = make_float4(0.f, 0.f, 0.f, 0.f);
      T[k * 65 + n4 + 0] = v.x; T[k * 65 + n4 + 1] = v.y; T[k * 65 + n4 + 2] = v.z; T[k * 65 + n4 + 3] = v.w;
    }
    __syncthreads();
    {
      const int nl = tid >> 2, kq = (tid & 3) * 16, n = nt * 64 + nl;
      if (n < t.N) {
        const int drow = t.ilv ? ((((n >> 4) * 2 + (t.ilv - 1)) << 4) + (n & 15)) : n;
        bf16x8 o0, o1;
#pragma unroll
        for (int q = 0; q < 8; ++q) { o0[q] = (short)f2bf(T[(kq + q) * 65 + nl]); o1[q] = (short)f2bf(T[(kq + 8 + q) * 65 + nl]); }
        u16* d = t.dst + (long)drow * t.ld_dst + kt * 64 + kq;
        *reinterpret_cast<bf16x8*>(d) = o0; *reinterpret_cast<bf16x8*>(d + 8) = o1;
      }
    }
    __syncthreads();
  }
  {
    const int lane = tid & 63, gw = blockIdx.x * 4 + (tid >> 6), nw = gridDim.x * 4;
    u16* U = (u16*)(p->ws + OFF_U);
    const float* gain = p->in[8];
    for (int row = gw; row < MR; row += nw) {
      const float* x = xrow(p, row);
      float4 v[4]; float ss = 0.f;
#pragma unroll
      for (int i = 0; i < 4; ++i) { v[i] = *reinterpret_cast<const float4*>(x + i * 256 + lane * 4); ss += v[i].x * v[i].x + v[i].y * v[i].y + v[i].z * v[i].z + v[i].w * v[i].w; }
      ss = sum64(ss);
      const float rs = rsqrtf(ss * (1.f / 1024.f) + NORM_EPS);
#pragma unroll
      for (int i = 0; i < 4; ++i) {
        const float4 g4 = *reinterpret_cast<const float4*>(gain + i * 256 + lane * 4);
        u16x4 o; o[0] = f2bf(v[i].x * rs * g4.x); o[1] = f2bf(v[i].y * rs * g4.y); o[2] = f2bf(v[i].z * rs * g4.z); o[3] = f2bf(v[i].w * rs * g4.w);
        *reinterpret_cast<u16x4*>(U + (size_t)row * 1024 + i * 256 + lane * 4) = o;
      }
    }
  }
  {
    float* rss = (float*)(p->ws + OFF_RSS);
    const int gt = blockIdx.x * 256 + tid, nt = gridDim.x * 256;
    for (int i = gt; i < 3 * MR; i += nt) rss[i] = 0.f;
    const float* sc = p->in[6];
    for (int i = gt; i < 128 * 2 * 1536; i += nt) {
      const int b = i / 3072, r = i - b * 3072;
      p->out[OUT_CONV_S + (long)b * 4608 + r] = sc[(long)b * 4608 + 1536 + r];
    }
  }
}

__device__ __forceinline__ void phase_proj(KP p) {
  const u16* U = (const u16*)(p->ws + OFF_U); const u16* W = (const u16*)(p->ws + OFF_WINT);
  u16* PJ = (u16*)(p->ws + OFF_PROJ); float* AB = (float*)(p->ws + OFF_AB);
  constexpr int NCT = 31, NRT = MR / 128;
  const XTiles XT = xt_make(NRT, NCT, 16);
  for (int t = XT.lb; t < XT.total; t += XT.nb) {
    int ct, rt; xt_get(XT, t, rt, ct); const int row0 = rt * 128, col0 = ct * 128;
    f32x4 acc[4][4];
    gemm_mainloop(U + (size_t)row0 * 1024, 1024, W + (size_t)col0 * 1024, 1024, 1024, acc);
    EPI_COORDS
    {
      u16* T = (u16*)smem;
#pragma unroll
      for (int m = 0; m < 4; ++m)
#pragma unroll
        for (int j = 0; j < 4; ++j)
#pragma unroll
          for (int n = 0; n < 4; ++n) T[(wr_ * 64 + m * 16 + fq_ * 4 + j) * 136 + wc_ * 64 + n * 16 + fr_] = f2bf(acc[m][n][j]);
    }
    const bool special = (rt & 15) == 15 || rt == NRT - 1 || ct == NCT - 1;
    if (special) {
#pragma unroll
    for (int m = 0; m < 4; ++m)
#pragma unroll
      for (int j = 0; j < 4; ++j) {
        const int row = row0 + wr_ * 64 + m * 16 + fq_ * 4 + j;
        int shift_b = -1; long shift_off = 0; int conv_j = -1; long conv_off = 0;
        if (row < NP) { const int tt = row & (SEQ - 1), b = row >> 11; if (tt == SEQ - 1) { shift_b = b; shift_off = OUT_SHIFT_P + (long)b * 1792; }
                        if (tt >= SEQ - 3) { conv_j = tt - (SEQ - 3); conv_off = OUT_CONV_P + ((long)b * 3 + conv_j) * 1536; } }
        else { const int b = row - NP; shift_b = b; shift_off = OUT_SHIFT_S + (long)b * 1792; conv_j = 2; conv_off = OUT_CONV_S + ((long)b * 3 + 2) * 1536; }
#pragma unroll
        for (int n = 0; n < 4; ++n) {
          const int col = col0 + wc_ * 64 + n * 16 + fr_;
          const float v = acc[m][n][j];
          if (col < PCOLS) {
            if (col >= 3840) AB[(size_t)row * 8 + (col - 3840)] = v;
            if (shift_b >= 0 && col < A_COLS) p->out[shift_off + col] = v;
            if (conv_j >= 0 && col >= A_COLS && col < A_COLS + 1536) p->out[conv_off + (col - A_COLS)] = v;
          }
        }
      }
    }
    tile_flush_bf16<128>(PJ, PCOLS, row0, col0, PCOLS);
  }
}

__device__ __forceinline__ void phase_lora_in(KP p) {
  const u16* PJ = (const u16*)(p->ws + OFF_PROJ); u16* LIN = (u16*)(p->ws + OFF_LIN);
  const float* mu = p->in[10]; const float* sh = p->in[4];
  const int gt = blockIdx.x * 256 + threadIdx.x, nt = gridDim.x * 256;
  for (int i = gt; i < MR * 64; i += nt) {
    const int row = i >> 6, c4 = (i & 63) * 4, col = 1536 + c4;
    const u16x4 cur = *reinterpret_cast<const u16x4*>(PJ + (size_t)row * PCOLS + col);
    float pv[4];
    {
      const bool hasprev = row < NP && (row & (SEQ - 1)) > 0;
      const u16x4 pr = *reinterpret_cast<const u16x4*>(PJ + (size_t)(hasprev ? row - 1 : row) * PCOLS + col);
      const float4 s4 = *reinterpret_cast<const float4*>(sh + (size_t)(row >= NP ? row - NP : 0) * 1792 + col);
      const float sv[4] = {s4.x, s4.y, s4.z, s4.w};
      for (int q = 0; q < 4; ++q) pv[q] = row >= NP ? sv[q] : (hasprev ? bf2f(pr[q]) : 0.f);
    }
    const float4 m4 = *reinterpret_cast<const float4*>(mu + col);
    const float mm[4] = {m4.x, m4.y, m4.z, m4.w};
    u16x4 o;
#pragma unroll
    for (int q = 0; q < 4; ++q) {
      const float c = bf2f(cur[q]); float x = c + (pv[q] - c) * mm[q];
      if (c4 < 64) x = tanhf(x); else if (c4 >= 128) x = sigmoidf_(x);
      o[q] = f2bf(x);
    }
    *reinterpret_cast<u16x4*>(LIN + (size_t)row * 256 + c4) = o;
  }
}

__device__ __forceinline__ void gdn_prep_item(KP p, int item) {
  const int tid = ltid(), lane = tid & 63, wid = tid >> 6, fr = lane & 15, fq = lane >> 4;
  const int n = item & 31, h = (item >> 5) & 3, b = item >> 7;
  const int rowb = b * SEQ + n * 64;
  const u16* PJ = (const u16*)(p->ws + OFF_PROJ);
  u16* qs = (u16*)smem; u16* ks = qs + 64 * 136; u16* vs = ks + 64 * 136;
  float* Ls = (float*)(smem + 3 * 64 * 136 * 2);
  float* gcs = Ls + 64 * 64; float* betas = gcs + 64; float* egcs = betas + 64;
  const float* cw = p->in[21];
  for (int it = tid; it < 64 * 48; it += 256) {
    const int t = it / 48, cg8 = it - t * 48; const int which = cg8 >> 4, cc = (cg8 & 15) * 8;
    const int ch = which * 512 + h * 128 + cc;
    float acc8[8];
#pragma unroll
    for (int q = 0; q < 8; ++q) acc8[q] = 0.f;
#pragma unroll
    for (int j = 0; j < 4; ++j) {
      const int tt = n * 64 + t - 3 + j; const float mk = tt >= 0 ? 1.f : 0.f;
      {
        const bf16x8 xv = *reinterpret_cast<const bf16x8*>(PJ + (size_t)(b * SEQ + (tt >= 0 ? tt : 0)) * PCOLS + A_COLS + ch);
        const float4 w0 = *reinterpret_cast<const float4*>(cw + j * 1536 + ch), w1 = *reinterpret_cast<const float4*>(cw + j * 1536 + ch + 4);
        const float wv[8] = {w0.x, w0.y, w0.z, w0.w, w1.x, w1.y, w1.z, w1.w};
#pragma unroll
        for (int q = 0; q < 8; ++q) acc8[q] += bf2f((u16)xv[q]) * (wv[q] * mk);
      }
    }
    bf16x8 o;
#pragma unroll
    for (int q = 0; q < 8; ++q) o[q] = (short)f2bf(siluf_(acc8[q]));
    u16* dst = (which == 0 ? qs : (which == 1 ? ks : vs)) + t * 136 + cc;
    *reinterpret_cast<bf16x8*>(dst) = o;
  }
  if (wid == 0) {
    const float* AB = (const float*)(p->ws + OFF_AB) + (size_t)(rowb + lane) * 8;
    const float braw = AB[h], araw = AB[4 + h];
    const float g = -__expf(p->in[22][h]) * softplusf_(araw + p->in[23][h]);
    float c = g;
#pragma unroll
    for (int o = 1; o < 64; o <<= 1) { const float up = __shfl_up(c, o); if (lane >= o) c += up; }
    gcs[lane] = c; betas[lane] = sigmoidf_(braw); egcs[lane] = __expf(c);
  }
  __syncthreads();
  {
    const int r = tid >> 2, part = tid & 3;
#pragma unroll
    for (int w2 = 0; w2 < 2; ++w2) {
      u16* base = (w2 == 0 ? qs : ks) + r * 136 + part * 32;
      float v[32]; float ss = 0.f;
#pragma unroll
      for (int q8 = 0; q8 < 4; ++q8) { const bf16x8 x = *reinterpret_cast<const bf16x8*>(base + q8 * 8);
#pragma unroll
        for (int q = 0; q < 8; ++q) { v[q8 * 8 + q] = bf2f((u16)x[q]); ss += v[q8 * 8 + q] * v[q8 * 8 + q]; } }
      ss = quad_sum(ss);
      const float sc = rsqrtf(ss + 1e-6f) * (w2 == 0 ? 0.08838834764831845f : 1.f);
#pragma unroll
      for (int q8 = 0; q8 < 4; ++q8) { bf16x8 o;
#pragma unroll
        for (int q = 0; q < 8; ++q) o[q] = (short)f2bf(v[q8 * 8 + q] * sc);
        *reinterpret_cast<bf16x8*>(base + q8 * 8) = o; }
    }
  }
  __syncthreads();
  {
    f32x4 aL[4], aQ[4];
#pragma unroll
    for (int nt = 0; nt < 4; ++nt) { aL[nt] = f32x4{0.f, 0.f, 0.f, 0.f}; aQ[nt] = f32x4{0.f, 0.f, 0.f, 0.f}; }
#pragma unroll
    for (int kk = 0; kk < 4; ++kk) {
      const bf16x8 ak = *reinterpret_cast<const bf16x8*>((char*)ks + (wid * 16 + fr) * 272 + kk * 64 + fq * 16);
      const bf16x8 aq = *reinterpret_cast<const bf16x8*>((char*)qs + (wid * 16 + fr) * 272 + kk * 64 + fq * 16);
#pragma unroll
      for (int nt = 0; nt < 4; ++nt) {
        const bf16x8 bk = *reinterpret_cast<const bf16x8*>((char*)ks + (nt * 16 + fr) * 272 + kk * 64 + fq * 16);
        aL[nt] = __builtin_amdgcn_mfma_f32_16x16x32_bf16(ak, bk, aL[nt], 0, 0, 0);
        aQ[nt] = __builtin_amdgcn_mfma_f32_16x16x32_bf16(aq, bk, aQ[nt], 0, 0, 0);
      }
    }
    u16* QK = (u16*)(p->ws + OFF_QK) + (size_t)item * 4096;
#pragma unroll
    for (int nt = 0; nt < 4; ++nt)
#pragma unroll
      for (int j = 0; j < 4; ++j) {
        const int i = wid * 16 + fq * 4 + j, jc = nt * 16 + fr;
        const float dec = (i >= jc) ? __expf(gcs[i] - gcs[jc]) : 0.f;
        Ls[i * 64 + jc] = (i > jc) ? betas[i] * aL[nt][j] * dec : 0.f;
        QK[i * 64 + jc] = f2bf(aQ[nt][j] * dec);
      }
  }
  __syncthreads();
  const size_t ebase = (size_t)((item >> 5) * 8 + (n & 7)) * 8192;
  u16* EUT = (u16*)((unsigned char*)p->out + EO_UT) + ebase; u16* EWN = (u16*)((unsigned char*)p->out + EO_WN) + ebase;
  u16* EQG = (u16*)((unsigned char*)p->out + EO_QG) + ebase; u16* EKD = (u16*)((unsigned char*)p->out + EO_KDT) + ebase;
  {
    float X[64];
    const bool isv = tid < 128; const u16* src = isv ? (vs + tid) : (ks + (tid - 128));
#pragma unroll
    for (int i = 0; i < 64; ++i) { float r = bf2f(src[i * 136]) * betas[i]; if (!isv) r *= egcs[i]; X[i] = r; }
#pragma unroll
    for (int i = 1; i < 64; ++i) {
      float s = X[i];
#pragma unroll
      for (int j4 = 0; j4 < (i + 3) / 4; ++j4) {
        const float4 l = *reinterpret_cast<const float4*>(Ls + i * 64 + j4 * 4);
        s -= l.x * X[4 * j4]; s -= l.y * X[4 * j4 + 1]; s -= l.z * X[4 * j4 + 2]; s -= l.w * X[4 * j4 + 3];
      }
      X[i] = s;
    }
    if (isv) {
#pragma unroll
      for (int q8 = 0; q8 < 8; ++q8) { bf16x8 o;
#pragma unroll
        for (int q = 0; q < 8; ++q) o[q] = (short)f2bf(X[q8 * 8 + q]);
        *reinterpret_cast<bf16x8*>(EUT + tid * 64 + q8 * 8) = o; }
    } else {
#pragma unroll
      for (int i = 0; i < 64; ++i) EWN[i * 128 + (tid - 128)] = f2bf(-X[i]);
    }
  }
  {
    const int i = tid >> 2, k0 = (tid & 3) * 32; const float eg = egcs[i];
#pragma unroll
    for (int q8 = 0; q8 < 4; ++q8) { const bf16x8 x = *reinterpret_cast<const bf16x8*>(qs + i * 136 + k0 + q8 * 8); bf16x8 o;
#pragma unroll
      for (int q = 0; q < 8; ++q) o[q] = (short)f2bf(bf2f((u16)x[q]) * eg);
      *reinterpret_cast<bf16x8*>(EQG + i * 128 + k0 + q8 * 8) = o; }
    const int k = tid >> 1, i0 = (tid & 1) * 32; const float gl = gcs[63];
#pragma unroll
    for (int q8 = 0; q8 < 4; ++q8) { bf16x8 o;
#pragma unroll
      for (int q = 0; q < 8; ++q) { const int ii = i0 + q8 * 8 + q; o[q] = (short)f2bf(bf2f(ks[ii * 136 + k]) * __expf(gl - gcs[ii])); }
      *reinterpret_cast<bf16x8*>(EKD + k * 64 + i0 + q8 * 8) = o; }
    if (tid == 0) ((float*)(p->ws + OFF_GL))[item] = __expf(gl);
  }
  __syncthreads();
}

__device__ __forceinline__ void phase_lora(KP p) {
  const u16* LIN = (const u16*)(p->ws + OFF_LIN);
  constexpr int NRT = MR / 128;
  for (int t = blockIdx.x; t < 3 * 4 * NRT; t += gridDim.x) {
    const int which = t / (4 * NRT), r2 = t - which * 4 * NRT; const int ct = r2 & 3, rt = r2 >> 2;
    const int row0 = rt * 128, col0 = ct * 128;
    f32x4 acc[4][4];
    const u16* A; const u16* Bt; int K; u16* O; const float* bias;
    if (which == 0) { A = LIN; Bt = (const u16*)(p->ws + OFF_W2T); K = 64; O = (u16*)(p->ws + OFF_DE); bias = p->in[11]; }
    else if (which == 1) { A = LIN + 64; Bt = (const u16*)(p->ws + OFF_A2T); K = 64; O = (u16*)(p->ws + OFF_DA); bias = p->in[13]; }
    else { A = LIN + 128; Bt = (const u16*)(p->ws + OFF_G2T); K = 128; O = (u16*)(p->ws + OFF_DG); bias = p->in[13]; }
    gemm_mainloop(A + (size_t)row0 * 256, 256, Bt + (size_t)col0 * K, K, K, acc);
    EPI_COORDS
#pragma unroll
    for (int n = 0; n < 4; ++n) {
      const int col = col0 + wc_ * 64 + n * 16 + fr_; const float bs = bias[col];
#pragma unroll
      for (int m = 0; m < 4; ++m)
#pragma unroll
        for (int j = 0; j < 4; ++j) {
          const int row = row0 + wr_ * 64 + m * 16 + fq_ * 4 + j; float v = acc[m][n][j];
          if (which == 0) { const float z = bs + v; v = __expf(-softplusf_(-z) - 0.5f); }
          else if (which == 1) v = sigmoidf_(bs + v);
          O[(size_t)row * 512 + col] = f2bf(v);
        }
    }
  }
}

struct RwRaw { u16x4 r, k, v, pr, pk, pv, e, a, g; float4 sr, sk, sv; };
template <bool samp>
__device__ __forceinline__ void rwkv_chain(KP p, int seq, int h, bool dry) {
  const int tid = ltid();
  constexpr int T = samp ? 1 : SEQ; const int rowb = samp ? NP + (seq - 8) : seq * SEQ;
  const u16* PJ = (const u16*)(p->ws + OFF_PROJ); u16* DA = (u16*)(p->ws + OFF_DA);
  const u16* DE = (const u16*)(p->ws + OFF_DE); const u16* DG = (const u16*)(p->ws + OFF_DG);
  float* buf = (float*)smem;
  float* ybuf = buf + 2 * 16 * 384;
  const int vrow = tid >> 2, part = tid & 3;
  const int tt = tid >> 4, jg = (tid & 15) * 4, ch = h * 64 + jg;
  float S[16];
  if (samp) { const float* s0 = p->in[5] + ((size_t)(seq - 8) * 8 + h) * 4096 + vrow * 64 + part * 16;
#pragma unroll
    for (int q = 0; q < 4; ++q) { const float4 x = *reinterpret_cast<const float4*>(s0 + q * 4); S[q * 4] = x.x; S[q * 4 + 1] = x.y; S[q * 4 + 2] = x.z; S[q * 4 + 3] = x.w; } }
  else {
#pragma unroll
    for (int q = 0; q < 16; ++q) S[q] = 0.f; }
  const float4 mur = *reinterpret_cast<const float4*>(p->in[10] + ch), muk = *reinterpret_cast<const float4*>(p->in[10] + 512 + ch), muv = *reinterpret_cast<const float4*>(p->in[10] + 1024 + ch);
  const float4 ckk = *reinterpret_cast<const float4*>(p->in[16] + ch), cka = *reinterpret_cast<const float4*>(p->in[17] + ch), crk = *reinterpret_cast<const float4*>(p->in[18] + ch);
  const float4 lnw = *reinterpret_cast<const float4*>(p->in[19] + ch), lnb = *reinterpret_cast<const float4*>(p->in[20] + ch);
  constexpr int nchunks = (T + 15) >> 4;
  auto load_raw = [&](int c, RwRaw& R) {
    const int t = c * 16 + tt;
    if (t < T) {
      const size_t ro = (size_t)(rowb + t) * PCOLS;
      R.r = *reinterpret_cast<const u16x4*>(PJ + ro + ch); R.k = *reinterpret_cast<const u16x4*>(PJ + ro + 512 + ch); R.v = *reinterpret_cast<const u16x4*>(PJ + ro + 1024 + ch);
      if (t > 0) { const size_t po = ro - PCOLS; R.pr = *reinterpret_cast<const u16x4*>(PJ + po + ch); R.pk = *reinterpret_cast<const u16x4*>(PJ + po + 512 + ch); R.pv = *reinterpret_cast<const u16x4*>(PJ + po + 1024 + ch); }
      else if (samp) { const float* sh = p->in[4] + (size_t)(seq - 8) * 1792; R.sr = *reinterpret_cast<const float4*>(sh + ch); R.sk = *reinterpret_cast<const float4*>(sh + 512 + ch); R.sv = *reinterpret_cast<const float4*>(sh + 1024 + ch); }
      const size_t lo = (size_t)(rowb + t) * 512 + ch;
      R.e = *reinterpret_cast<const u16x4*>(DE + lo); R.a = *reinterpret_cast<const u16x4*>(DA + lo); R.g = *reinterpret_cast<const u16x4*>(DG + lo);
    }
  };
  auto prep_write = [&](int c, const RwRaw& R) {
    const int t = c * 16 + tt;
    if (t < T) {
      float r4[4], k4[4], v4[4], pr4[4], pk4[4], pv4[4];
      const float mr[4] = {mur.x, mur.y, mur.z, mur.w}, mk[4] = {muk.x, muk.y, muk.z, muk.w}, mv[4] = {muv.x, muv.y, muv.z, muv.w};
      const float kkc[4] = {ckk.x, ckk.y, ckk.z, ckk.w}, kac[4] = {cka.x, cka.y, cka.z, cka.w};
      if (t > 0) { for (int q = 0; q < 4; ++q) { pr4[q] = bf2f(R.pr[q]); pk4[q] = bf2f(R.pk[q]); pv4[q] = bf2f(R.pv[q]); } }
      else if (samp) { pr4[0] = R.sr.x; pr4[1] = R.sr.y; pr4[2] = R.sr.z; pr4[3] = R.sr.w; pk4[0] = R.sk.x; pk4[1] = R.sk.y; pk4[2] = R.sk.z; pk4[3] = R.sk.w; pv4[0] = R.sv.x; pv4[1] = R.sv.y; pv4[2] = R.sv.z; pv4[3] = R.sv.w; }
      else { for (int q = 0; q < 4; ++q) { pr4[q] = 0.f; pk4[q] = 0.f; pv4[q] = 0.f; } }
      float kr[4], ss = 0.f, a4[4], w4[4];
#pragma unroll
      for (int q = 0; q < 4; ++q) {
        const float cr = bf2f(R.r[q]), ck = bf2f(R.k[q]), cv = bf2f(R.v[q]);
        r4[q] = cr + (pr4[q] - cr) * mr[q]; k4[q] = ck + (pk4[q] - ck) * mk[q]; v4[q] = cv + (pv4[q] - cv) * mv[q];
        kr[q] = k4[q] * kkc[q]; ss += kr[q] * kr[q];
        a4[q] = bf2f(R.a[q]); w4[q] = __expf(-bf2f(R.e[q]));
      }
      ss = sum16(ss);
      const float rn = rsqrtf(ss + 1e-6f);
      float* dst = buf + ((c & 1) * 16 + tt) * 384 + jg;
      float4 o;
      o = make_float4(w4[0], w4[1], w4[2], w4[3]); *reinterpret_cast<float4*>(dst) = o;
      o = make_float4(-kr[0] * rn, -kr[1] * rn, -kr[2] * rn, -kr[3] * rn); *reinterpret_cast<float4*>(dst + 64) = o;
      o = make_float4(kr[0] * rn * a4[0], kr[1] * rn * a4[1], kr[2] * rn * a4[2], kr[3] * rn * a4[3]); *reinterpret_cast<float4*>(dst + 128) = o;
      o = make_float4(k4[0] * (1.f + (a4[0] - 1.f) * kac[0]), k4[1] * (1.f + (a4[1] - 1.f) * kac[1]), k4[2] * (1.f + (a4[2] - 1.f) * kac[2]), k4[3] * (1.f + (a4[3] - 1.f) * kac[3]));
      *reinterpret_cast<float4*>(dst + 192) = o;
      o = make_float4(r4[0], r4[1], r4[2], r4[3]); *reinterpret_cast<float4*>(dst + 256) = o;
      o = make_float4(v4[0], v4[1], v4[2], v4[3]); *reinterpret_cast<float4*>(dst + 320) = o;
    }
  };
  RwRaw R; load_raw(0, R);
  for (int c = 0; c < nchunks; ++c) {
    prep_write(c, R);
    const u16x4 gcur = R.g;
    if (c + 1 < nchunks) load_raw(c + 1, R);
    __syncthreads();
    const int nsteps = min(16, T - c * 16);
    const float* cb = buf + (c & 1) * 16 * 384;
#pragma unroll 2
    for (int s = 0; s < nsteps; ++s) {
      const float* sb = cb + s * 384 + part * 16;
      float w[16], a[16], bb[16], kk[16], rr[16];
#pragma unroll
      for (int q = 0; q < 4; ++q) {
        const float4 x0 = *reinterpret_cast<const float4*>(sb + q * 4); w[q * 4] = x0.x; w[q * 4 + 1] = x0.y; w[q * 4 + 2] = x0.z; w[q * 4 + 3] = x0.w;
        const float4 x1 = *reinterpret_cast<const float4*>(sb + 64 + q * 4); a[q * 4] = x1.x; a[q * 4 + 1] = x1.y; a[q * 4 + 2] = x1.z; a[q * 4 + 3] = x1.w;
        const float4 x2 = *reinterpret_cast<const float4*>(sb + 128 + q * 4); bb[q * 4] = x2.x; bb[q * 4 + 1] = x2.y; bb[q * 4 + 2] = x2.z; bb[q * 4 + 3] = x2.w;
        const float4 x3 = *reinterpret_cast<const float4*>(sb + 192 + q * 4); kk[q * 4] = x3.x; kk[q * 4 + 1] = x3.y; kk[q * 4 + 2] = x3.z; kk[q * 4 + 3] = x3.w;
        const float4 x4 = *reinterpret_cast<const float4*>(sb + 256 + q * 4); rr[q * 4] = x4.x; rr[q * 4 + 1] = x4.y; rr[q * 4 + 2] = x4.z; rr[q * 4 + 3] = x4.w;
      }
      const float vv = cb[s * 384 + 320 + vrow];
      float s0 = 0.f, s1 = 0.f, s2 = 0.f, s3 = 0.f;
#pragma unroll
      for (int q = 0; q < 4; ++q) { s0 += S[q * 4] * a[q * 4]; s1 += S[q * 4 + 1] * a[q * 4 + 1]; s2 += S[q * 4 + 2] * a[q * 4 + 2]; s3 += S[q * 4 + 3] * a[q * 4 + 3]; }
      const float sa = quad_sum((s0 + s1) + (s2 + s3));
      float y0 = 0.f, y1 = 0.f, y2 = 0.f, y3 = 0.f;
#pragma unroll
      for (int q = 0; q < 16; ++q) S[q] = fmaf(sa, bb[q], fmaf(S[q], w[q], vv * kk[q]));
#pragma unroll
      for (int q = 0; q < 4; ++q) { y0 += S[q * 4] * rr[q * 4]; y1 += S[q * 4 + 1] * rr[q * 4 + 1]; y2 += S[q * 4 + 2] * rr[q * 4 + 2]; y3 += S[q * 4 + 3] * rr[q * 4 + 3]; }
      const float y = quad_sum((y0 + y1) + (y2 + y3));
      if (part == 0) ybuf[s * 64 + vrow] = y;
    }
    __syncthreads();
    {
      const int t = c * 16 + tt;
      if (t < T) {
        const float4 y4 = *reinterpret_cast<const float4*>(ybuf + tt * 64 + jg);
        const float* tb = cb + tt * 384 + jg;
        const float4 kq = *reinterpret_cast<const float4*>(tb + 192), rq = *reinterpret_cast<const float4*>(tb + 256), vq = *reinterpret_cast<const float4*>(tb + 320);
        const float mean = sum16(y4.x + y4.y + y4.z + y4.w) * (1.f / 64.f);
        const float d0 = y4.x - mean, d1 = y4.y - mean, d2 = y4.z - mean, d3 = y4.w - mean;
        const float var = sum16(d0 * d0 + d1 * d1 + d2 * d2 + d3 * d3) * (1.f / 64.f);
        const float rstd = rsqrtf(var + GN_EPS);
        const float dot = sum16(rq.x * kq.x * crk.x + rq.y * kq.y * crk.y + rq.z * kq.z * crk.z + rq.w * kq.w * crk.w);
        u16x4 o;
        o[0] = f2bf((d0 * rstd * lnw.x + lnb.x + dot * vq.x) * bf2f(gcur[0]));
        o[1] = f2bf((d1 * rstd * lnw.y + lnb.y + dot * vq.y) * bf2f(gcur[1]));
        o[2] = f2bf((d2 * rstd * lnw.z + lnb.z + dot * vq.z) * bf2f(gcur[2]));
        o[3] = f2bf((d3 * rstd * lnw.w + lnb.w + dot * vq.w) * bf2f(gcur[3]));
        *reinterpret_cast<u16x4*>((dry ? (u16*)(p->ws + OFF_LIN) : DA) + (size_t)((rowb + t) & (dry ? 8191 : 0xffffff)) * 512 + ch) = o;
      }
    }
  }
  {
    float* so = p->out + (samp ? OUT_WKV_S + ((size_t)(seq - 8) * 8 + h) * 4096 : OUT_WKV_P + ((size_t)seq * 8 + h) * 4096) + vrow * 64 + part * 16;
#pragma unroll
    for (int q = 0; q < 4; ++q) *reinterpret_cast<float4*>(so + q * 4) = make_float4(S[q * 4], S[q * 4 + 1], S[q * 4 + 2], S[q * 4 + 3]);
  }
  __syncthreads();
}

constexpr int RW_REC = 35328;
constexpr int RO_WA = 0, RO_RT = 4096, RO_UVT = 8192, RO_YVT = 12288, RO_BHT = 16384, RO_VT = 20480, RO_SV = 24576, RO_ARB = 32768, RO_PC = 34816, RO_DOT = 35072;
#define RWC_CARVE(L) \
  u16* At = (u16*)(L);\
  u16* Rt = (u16*)(L + 4608);\
  u16* Bt = (u16*)(L + 9216);\
  u16* Kt = (u16*)(L + 13824);\
  u16* Aak = (u16*)(L + 9216);\
  u16* Ark = (u16*)(L + 11776); \
  u16* Arb = (u16*)(L + 14336); \
  u16* VT = (u16*)(L + 18432);\
  u16* KHT = (u16*)(L + 23552);\
  float* Af = (float*)(L + 33792);\
  float* AV = (float*)(L + 41984);\
  float* Ls = (float*)(L + 50176);\
  float* rn = (float*)(L + 68608); float* dots = rn + 32; float* gtot = dots + 32; float* cst = gtot + 256;

__device__ __forceinline__ void rwkv_prep_item(KP p, int chain, int n, unsigned char* rec) {
  int tl = threadIdx.x; asm volatile("" : "+v"(tl));
  const int tid = tl, lane = tid & 63, w = tid >> 6, fr = lane & 15, fq = lane >> 4;
  const int i2 = tid >> 3, c0 = (tid & 7) * 8, mi = w >> 1, nt0 = (w & 1) * 2;
  const int b = chain >> 3, h = chain & 7;
  unsigned char* L = smem; RWC_CARVE(L)
  const int rowb = b * SEQ + n * 32, ch = h * 64 + lane;
  const u16* PJ = (const u16*)(p->ws + OFF_PROJ); const u16* DA = (const u16*)(p->ws + OFF_DA); const u16* DE = (const u16*)(p->ws + OFF_DE);
  const float mur = p->in[10][ch], muk = p->in[10][512 + ch], muv = p->in[10][1024 + ch];
  const float kkc = p->in[16][ch], kac = p->in[17][ch];
  float c_mr[8], c_mk[8], c_kk[8], c_ka[8], c_rk[8];
  { const int cc = h * 64 + c0;
    const float4 a0 = *reinterpret_cast<const float4*>(p->in[10] + cc), a1 = *reinterpret_cast<const float4*>(p->in[10] + cc + 4);
    const float4 b0 = *reinterpret_cast<const float4*>(p->in[10] + 512 + cc), b1 = *reinterpret_cast<const float4*>(p->in[10] + 512 + cc + 4);
    const float4 d0 = *reinterpret_cast<const float4*>(p->in[16] + cc), d1 = *reinterpret_cast<const float4*>(p->in[16] + cc + 4);
    const float4 e0 = *reinterpret_cast<const float4*>(p->in[17] + cc), e1 = *reinterpret_cast<const float4*>(p->in[17] + cc + 4);
    const float4 f0 = *reinterpret_cast<const float4*>(p->in[18] + cc), f1 = *reinterpret_cast<const float4*>(p->in[18] + cc + 4);
    c_mr[0] = a0.x; c_mr[1] = a0.y; c_mr[2] = a0.z; c_mr[3] = a0.w; c_mr[4] = a1.x; c_mr[5] = a1.y; c_mr[6] = a1.z; c_mr[7] = a1.w;
    c_mk[0] = b0.x; c_mk[1] = b0.y; c_mk[2] = b0.z; c_mk[3] = b0.w; c_mk[4] = b1.x; c_mk[5] = b1.y; c_mk[6] = b1.z; c_mk[7] = b1.w;
    c_kk[0] = d0.x; c_kk[1] = d0.y; c_kk[2] = d0.z; c_kk[3] = d0.w; c_kk[4] = d1.x; c_kk[5] = d1.y; c_kk[6] = d1.z; c_kk[7] = d1.w;
    c_ka[0] = e0.x; c_ka[1] = e0.y; c_ka[2] = e0.z; c_ka[3] = e0.w; c_ka[4] = e1.x; c_ka[5] = e1.y; c_ka[6] = e1.z; c_ka[7] = e1.w;
    c_rk[0] = f0.x; c_rk[1] = f0.y; c_rk[2] = f0.z; c_rk[3] = f0.w; c_rk[4] = f1.x; c_rk[5] = f1.y; c_rk[6] = f1.z; c_rk[7] = f1.w; }
  bf16x8 cr8, ck8, pr8, pk8, a8; u16 rr[9], rk[9], rv[9], re[8], ra[8];
  { const int t = n * 32 + i2; const size_t ro = (size_t)(rowb + i2) * PCOLS + h * 64 + c0;
    cr8 = *reinterpret_cast<const bf16x8*>(PJ + ro); ck8 = *reinterpret_cast<const bf16x8*>(PJ + ro + 512);
    const size_t rop = t > 0 ? ro - PCOLS : ro;
    pr8 = *reinterpret_cast<const bf16x8*>(PJ + rop); pk8 = *reinterpret_cast<const bf16x8*>(PJ + rop + 512);
    if (t == 0) { pr8 = bf16x8{0, 0, 0, 0, 0, 0, 0, 0}; pk8 = pr8; }
    a8 = *reinterpret_cast<const bf16x8*>(DA + (size_t)(rowb + i2) * 512 + h * 64 + c0); }
#pragma unroll
  for (int q = 0; q < 9; ++q) { const int i = w * 8 - 1 + q; const bool ok = (n * 32 + i) >= 0;
    const size_t ro = (size_t)(rowb + (ok ? i : 0)) * PCOLS + ch; rr[q] = PJ[ro]; rk[q] = PJ[ro + 512]; rv[q] = PJ[ro + 1024];
    if (!ok) { rr[q] = 0; rk[q] = 0; rv[q] = 0; } }
#pragma unroll
  for (int q = 0; q < 8; ++q) { const size_t lo = (size_t)(rowb + w * 8 + q) * 512 + ch; re[q] = DE[lo]; ra[q] = DA[lo]; }
  __syncthreads();
  {
    float ss = 0.f, dt = 0.f;
#pragma unroll
    for (int q = 0; q < 8; ++q) {
      const float cr = bf2f((u16)cr8[q]), ck = bf2f((u16)ck8[q]);
      const float r = cr + (bf2f((u16)pr8[q]) - cr) * c_mr[q], k = ck + (bf2f((u16)pk8[q]) - ck) * c_mk[q];
      const float a = bf2f((u16)a8[q]); const float kr = k * c_kk[q];
      ss += kr * kr; dt += r * k * (1.f + (a - 1.f) * c_ka[q]) * c_rk[q];
    }
    ss += __shfl_xor(ss, 1); dt += __shfl_xor(dt, 1); ss += __shfl_xor(ss, 2); dt += __shfl_xor(dt, 2); ss += __shfl_xor(ss, 4); dt += __shfl_xor(dt, 4);
    if ((tid & 7) == 0) { rn[i2] = rsqrtf(ss + 1e-6f); dots[i2] = dt; ((float*)(rec + RO_DOT))[i2] = dt; }
  }
  float lsum = 0.f;
#pragma unroll
  for (int q = 0; q < 8; ++q) lsum -= bf2f(re[q]);
  gtot[w * 64 + lane] = lsum;
  __syncthreads();
  {
    const float g0 = gtot[lane], g1 = gtot[64 + lane], g2 = gtot[128 + lane], g3 = gtot[192 + lane];
    const float Ltot = (g0 + g1) + (g2 + g3);
    const float off = (w > 0 ? g0 : 0.f) + (w > 1 ? g1 : 0.f) + (w > 2 ? g2 : 0.f);
    if (w == 0) ((float*)(rec + RO_PC))[lane] = __expf(Ltot);
    float run = 0.f; bf16x8 vp, khp, bhp;
    u16* RTg = (u16*)(rec + RO_RT);
#pragma unroll
    for (int q = 0; q < 8; ++q) {
      const int i = w * 8 + q;
      const float cr = bf2f(rr[q + 1]), ck = bf2f(rk[q + 1]), cv = bf2f(rv[q + 1]);
      const float r = cr + (bf2f(rr[q]) - cr) * mur, k = ck + (bf2f(rk[q]) - ck) * muk, v = cv + (bf2f(rv[q]) - cv) * muv;
      const float e = bf2f(re[q]), a = bf2f(ra[q]);
      run -= e; const float Lc = off + run, Lp = Lc + e;
      const float kk = k * kkc * rn[i]; const float ain = -kk, bin = kk * a, kp = k * (1.f + (a - 1.f) * kac);
      const float eP = __expf(Lp), eC = __expf(Lc), eN = __expf(-Lc), eT = __expf(Ltot - Lc);
      const float at = ain * eP; const u16 rt = f2bf(r * eC);
      At[i * 72 + lane] = f2bf(at); Af[i * 64 + lane] = at; Rt[i * 72 + lane] = rt; RTg[i * 64 + lane] = rt;
      Bt[i * 72 + lane] = f2bf(bin * eN); Kt[i * 72 + lane] = f2bf(kp * eN);
      vp[q] = (short)f2bf(v); khp[q] = (short)f2bf(kp * eT); bhp[q] = (short)f2bf(bin * eT);
    }
    *reinterpret_cast<bf16x8*>((char*)VT + lane * 80 + w * 16) = vp;
    *reinterpret_cast<bf16x8*>((char*)KHT + lane * 80 + w * 16) = khp;
    *reinterpret_cast<bf16x8*>(rec + RO_VT + lane * 64 + w * 16) = vp;
    *reinterpret_cast<bf16x8*>(rec + RO_BHT + lane * 64 + w * 16) = bhp;
  }
  __syncthreads();
  {
    f32x4 cab = {0.f, 0.f, 0.f, 0.f}, cak = cab, crb = cab, crk = cab;
#pragma unroll
    for (int ks = 0; ks < 2; ++ks) {
      const bf16x8 fa = *reinterpret_cast<const bf16x8*>((char*)At + (mi * 16 + fr) * 144 + ks * 64 + fq * 16);
      const bf16x8 fr_ = *reinterpret_cast<const bf16x8*>((char*)Rt + (mi * 16 + fr) * 144 + ks * 64 + fq * 16);
      const bf16x8 fb = *reinterpret_cast<const bf16x8*>((char*)Bt + ((w & 1) * 16 + fr) * 144 + ks * 64 + fq * 16);
      const bf16x8 fk = *reinterpret_cast<const bf16x8*>((char*)Kt + ((w & 1) * 16 + fr) * 144 + ks * 64 + fq * 16);
      cab = __builtin_amdgcn_mfma_f32_16x16x32_bf16(fa, fb, cab, 0, 0, 0);
      cak = __builtin_amdgcn_mfma_f32_16x16x32_bf16(fa, fk, cak, 0, 0, 0);
      crb = __builtin_amdgcn_mfma_f32_16x16x32_bf16(fr_, fb, crb, 0, 0, 0);
      crk = __builtin_amdgcn_mfma_f32_16x16x32_bf16(fr_, fk, crk, 0, 0, 0);
    }
    __syncthreads();
    u16* ARBg = (u16*)(rec + RO_ARB);
#pragma unroll
    for (int jj = 0; jj < 4; ++jj) {
      const int i = mi * 16 + fq * 4 + jj, s = (w & 1) * 16 + fr;
      Ls[s * 32 + i] = (s < i) ? cab[jj] : 0.f;
      Aak[i * 40 + s] = f2bf((s < i) ? cak[jj] : 0.f);
      ARBg[i * 32 + s] = f2bf((s <= i) ? crb[jj] : 0.f);
      Ark[i * 40 + s] = f2bf((s <= i) ? crk[jj] : 0.f);
    }
  }
  __syncthreads();
  {
    const bf16x8 faak = *reinterpret_cast<const bf16x8*>((char*)Aak + (mi * 16 + fr) * 80 + fq * 16);
    const bf16x8 fark = *reinterpret_cast<const bf16x8*>((char*)Ark + (mi * 16 + fr) * 80 + fq * 16);
    const bf16x8 fkh = *reinterpret_cast<const bf16x8*>((char*)KHT + (w * 16 + fr) * 80 + fq * 16);
    const f32x4 z4 = {0.f, 0.f, 0.f, 0.f};
#pragma unroll
    for (int nt = 0; nt < 4; ++nt) {
      const bf16x8 vb = *reinterpret_cast<const bf16x8*>((char*)VT + (nt * 16 + fr) * 80 + fq * 16);
      const f32x4 sv = __builtin_amdgcn_mfma_f32_16x16x32_bf16(fkh, vb, z4, 0, 0, 0);
      { u16x4 o; o[0] = f2bf(sv[0]); o[1] = f2bf(sv[1]); o[2] = f2bf(sv[2]); o[3] = f2bf(sv[3]);
        *reinterpret_cast<u16x4*>(rec + RO_SV + (nt * 16 + fr) * 128 + (w * 16 + fq * 4) * 2) = o; }
      if (nt == nt0 || nt == nt0 + 1) {
        const f32x4 av = __builtin_amdgcn_mfma_f32_16x16x32_bf16(faak, vb, z4, 0, 0, 0);
        const f32x4 yv = __builtin_amdgcn_mfma_f32_16x16x32_bf16(fark, vb, z4, 0, 0, 0);
#pragma unroll
        for (int jj = 0; jj < 4; ++jj) AV[(mi * 16 + fq * 4 + jj) * 64 + nt * 16 + fr] = av[jj];
        u16x4 o; o[0] = f2bf(yv[0]); o[1] = f2bf(yv[1]); o[2] = f2bf(yv[2]); o[3] = f2bf(yv[3]);
        *reinterpret_cast<u16x4*>(rec + RO_YVT + (nt * 16 + fr) * 64 + (mi * 16 + fq * 4) * 2) = o;
      }
    }
  }
  __syncthreads();
  if (tid < 128) {
    float* xc = tid < 64 ? (Af + tid) : (AV + (tid - 64));
#pragma unroll 1
    for (int i0 = 0; i0 < 32; i0 += 8) {
      float acc[8];
#pragma unroll
      for (int r = 0; r < 8; ++r) acc[r] = xc[(i0 + r) * 64];
#pragma unroll 2
      for (int j = 0; j < i0; ++j) {
        const float xj = xc[j * 64];
        const float4 l0 = *reinterpret_cast<const float4*>(Ls + j * 32 + i0), l1 = *reinterpret_cast<const float4*>(Ls + j * 32 + i0 + 4);
        acc[0] += l0.x * xj; acc[1] += l0.y * xj; acc[2] += l0.z * xj; acc[3] += l0.w * xj;
        acc[4] += l1.x * xj; acc[5] += l1.y * xj; acc[6] += l1.z * xj; acc[7] += l1.w * xj;
      }
#pragma unroll
      for (int r2 = 0; r2 < 7; ++r2) {
        const float4 l0 = *reinterpret_cast<const float4*>(Ls + (i0 + r2) * 32 + i0), l1 = *reinterpret_cast<const float4*>(Ls + (i0 + r2) * 32 + i0 + 4);
        const float lv[8] = {l0.x, l0.y, l0.z, l0.w, l1.x, l1.y, l1.z, l1.w};
#pragma unroll
        for (int r = r2 + 1; r < 8; ++r) acc[r] += lv[r] * acc[r2];
      }
#pragma unroll
      for (int r = 0; r < 8; ++r) xc[(i0 + r) * 64] = acc[r];
    }
    if (tid < 64) {
      u16* WAg = (u16*)(rec + RO_WA);
#pragma unroll 4
      for (int i = 0; i < 32; ++i) WAg[i * 64 + tid] = f2bf(xc[i * 64]);
    } else {
#pragma unroll
      for (int q8 = 0; q8 < 4; ++q8) { bf16x8 o;
#pragma unroll
        for (int q = 0; q < 8; ++q) o[q] = (short)f2bf(xc[(q8 * 8 + q) * 64]);
        *reinterpret_cast<bf16x8*>(rec + RO_UVT + (tid - 64) * 64 + q8 * 16) = o; }
    }
  }
  __syncthreads();
}

struct RwRec { bf16x8 wa[2], rt[2], arb, bh, vt; u16x4 uv[2], yv[2], sv[4]; float4 pc; float4 d0, d1; u16 g[8]; };
__device__ __forceinline__ void rwkv_scan_seg(KP p, int chain, int seg, const unsigned char* recs, bool dry) {
  int tl = threadIdx.x; asm volatile("" : "+v"(tl));
  const int tid = tl, lane = tid & 63, w = tid >> 6, fr = lane & 15, fq = lane >> 4;
  const int i2 = tid >> 3, c0 = (tid & 7) * 8, mi = w >> 1, nt0 = (w & 1) * 2;
  const int b = chain >> 3, h = chain & 7, ch = h * 64 + lane;
  u16* St = (u16*)(smem);
  u16* Dt = (u16*)(smem + 9216);
  float* Ys = (float*)(smem + 14336);
  float* stat = (float*)(smem + 22528);
  u16* DA = (u16*)(p->ws + OFF_DA); const u16* DG = (const u16*)(p->ws + OFF_DG);
  const float lnw = p->in[19][ch], lnb = p->in[20][ch];
  float* so = p->out + OUT_WKV_P + (size_t)chain * 4096;
  f32x4 Sacc[4];
  const float keep = seg == 0 ? 0.f : 1.f;
#pragma unroll
  for (int nt = 0; nt < 4; ++nt) {
#pragma unroll
    for (int jj = 0; jj < 4; ++jj) Sacc[nt][jj] = fminf(fmaxf(so[(nt * 16 + fr) * 64 + w * 16 + fq * 4 + jj], -3e38f), 3e38f) * keep;
    u16x4 o; o[0] = f2bf(Sacc[nt][0]); o[1] = f2bf(Sacc[nt][1]); o[2] = f2bf(Sacc[nt][2]); o[3] = f2bf(Sacc[nt][3]);
    *reinterpret_cast<u16x4*>((char*)St + (nt * 16 + fr) * 144 + (w * 16 + fq * 4) * 2) = o;
  }
  auto load_rec = [&](int c, RwRec& R) {
    int cl = c; asm volatile("" : "+s"(cl));
    int ty = threadIdx.x; asm volatile("" : "+v"(ty));
    const int lane = ty & 63, w = ty >> 6, fr = lane & 15, fq = lane >> 4, mi = w >> 1, nt0 = (w & 1) * 2, ch = h * 64 + lane;
    const unsigned char* rec = recs + (size_t)(chain * 16 + cl) * RW_REC;
#pragma unroll
    for (int ks = 0; ks < 2; ++ks) {
      R.wa[ks] = *reinterpret_cast<const bf16x8*>(rec + RO_WA + (mi * 16 + fr) * 128 + ks * 64 + fq * 16);
      R.rt[ks] = *reinterpret_cast<const bf16x8*>(rec + RO_RT + (mi * 16 + fr) * 128 + ks * 64 + fq * 16);
    }
    R.arb = *reinterpret_cast<const bf16x8*>(rec + RO_ARB + (mi * 16 + fr) * 64 + fq * 16);
    R.bh = *reinterpret_cast<const bf16x8*>(rec + RO_BHT + (w * 16 + fr) * 64 + fq * 16);
    R.vt = *reinterpret_cast<const bf16x8*>(rec + RO_VT + lane * 64 + w * 16);
#pragma unroll
    for (int q2 = 0; q2 < 2; ++q2) {
      R.uv[q2] = *reinterpret_cast<const u16x4*>(rec + RO_UVT + ((nt0 + q2) * 16 + fr) * 64 + (mi * 16 + fq * 4) * 2);
      R.yv[q2] = *reinterpret_cast<const u16x4*>(rec + RO_YVT + ((nt0 + q2) * 16 + fr) * 64 + (mi * 16 + fq * 4) * 2);
    }
#pragma unroll
    for (int nt = 0; nt < 4; ++nt) R.sv[nt] = *reinterpret_cast<const u16x4*>(rec + RO_SV + (nt * 16 + fr) * 128 + (w * 16 + fq * 4) * 2);
    R.pc = *reinterpret_cast<const float4*>(rec + RO_PC + (w * 16 + fq * 4) * 4);
    R.d0 = *reinterpret_cast<const float4*>(rec + RO_DOT + w * 32); R.d1 = *reinterpret_cast<const float4*>(rec + RO_DOT + w * 32 + 16);
    const size_t rowg = (size_t)(b * SEQ + (seg * 16 + cl) * 32 + w * 8);
#pragma unroll
    for (int q = 0; q < 8; ++q) R.g[q] = DG[(rowg + q) * 512 + ch];
  };
  RwRec R; load_rec(0, R);
  __syncthreads();
  for (int c = 0; c < 16; ++c) {
    int cq = c; asm volatile("" : "+s"(cq));
    int tz = threadIdx.x; asm volatile("" : "+v"(tz));
    const int lane = tz & 63, w = tz >> 6, fr = lane & 15, fq = lane >> 4, i2 = tz >> 3, c0 = (tz & 7) * 8, mi = w >> 1, nt0 = (w & 1) * 2;
    f32x4 Dacc[2], Yacc[2];
#pragma unroll
    for (int q2 = 0; q2 < 2; ++q2) {
      Dacc[q2] = f32x4{bf2f(R.uv[q2][0]), bf2f(R.uv[q2][1]), bf2f(R.uv[q2][2]), bf2f(R.uv[q2][3])};
      Yacc[q2] = f32x4{bf2f(R.yv[q2][0]), bf2f(R.yv[q2][1]), bf2f(R.yv[q2][2]), bf2f(R.yv[q2][3])};
    }
#pragma unroll
    for (int ks = 0; ks < 2; ++ks)
#pragma unroll
      for (int q2 = 0; q2 < 2; ++q2) {
        const bf16x8 sb = *reinterpret_cast<const bf16x8*>((char*)St + ((nt0 + q2) * 16 + fr) * 144 + ks * 64 + fq * 16);
        Dacc[q2] = __builtin_amdgcn_mfma_f32_16x16x32_bf16(R.wa[ks], sb, Dacc[q2], 0, 0, 0);
        Yacc[q2] = __builtin_amdgcn_mfma_f32_16x16x32_bf16(R.rt[ks], sb, Yacc[q2], 0, 0, 0);
      }
#pragma unroll
    for (int q2 = 0; q2 < 2; ++q2) {
      u16x4 o; o[0] = f2bf(Dacc[q2][0]); o[1] = f2bf(Dacc[q2][1]); o[2] = f2bf(Dacc[q2][2]); o[3] = f2bf(Dacc[q2][3]);
      *reinterpret_cast<u16x4*>((char*)Dt + ((nt0 + q2) * 16 + fr) * 80 + (mi * 16 + fq * 4) * 2) = o;
    }
    __syncthreads();
    const float pc[4] = {R.pc.x, R.pc.y, R.pc.z, R.pc.w};
#pragma unroll
    for (int nt = 0; nt < 4; ++nt) {
      const bf16x8 db = *reinterpret_cast<const bf16x8*>((char*)Dt + (nt * 16 + fr) * 80 + fq * 16);
      if (nt == nt0 || nt == nt0 + 1) Yacc[nt - nt0] = __builtin_amdgcn_mfma_f32_16x16x32_bf16(R.arb, db, Yacc[nt - nt0], 0, 0, 0);
#pragma unroll
      for (int jj = 0; jj < 4; ++jj) Sacc[nt][jj] = Sacc[nt][jj] * pc[jj] + bf2f(R.sv[nt][jj]);
      Sacc[nt] = __builtin_amdgcn_mfma_f32_16x16x32_bf16(R.bh, db, Sacc[nt], 0, 0, 0);
      u16x4 o; o[0] = f2bf(Sacc[nt][0]); o[1] = f2bf(Sacc[nt][1]); o[2] = f2bf(Sacc[nt][2]); o[3] = f2bf(Sacc[nt][3]);
      *reinterpret_cast<u16x4*>((char*)St + (nt * 16 + fr) * 144 + (w * 16 + fq * 4) * 2) = o;
    }
#pragma unroll
    for (int q2 = 0; q2 < 2; ++q2)
#pragma unroll
      for (int jj = 0; jj < 4; ++jj) Ys[(mi * 16 + fq * 4 + jj) * 64 + (nt0 + q2) * 16 + fr] = Yacc[q2][jj];
    const bf16x8 vt = R.vt; const float dd[8] = {R.d0.x, R.d0.y, R.d0.z, R.d0.w, R.d1.x, R.d1.y, R.d1.z, R.d1.w};
    u16 gq[8];
#pragma unroll
    for (int q = 0; q < 8; ++q) gq[q] = R.g[q];
    if (c + 1 < 16) load_rec(c + 1, R);
    __syncthreads();
    {
      const float4 y0 = *reinterpret_cast<const float4*>(Ys + i2 * 64 + c0), y1 = *reinterpret_cast<const float4*>(Ys + i2 * 64 + c0 + 4);
      float sm = (y0.x + y0.y + y0.z + y0.w) + (y1.x + y1.y + y1.z + y1.w);
      sm += __shfl_xor(sm, 1); sm += __shfl_xor(sm, 2); sm += __shfl_xor(sm, 4);
      const float mean = sm * (1.f / 64.f);
      float d, vs = 0.f;
      d = y0.x - mean; vs += d * d; d = y0.y - mean; vs += d * d; d = y0.z - mean; vs += d * d; d = y0.w - mean; vs += d * d;
      d = y1.x - mean; vs += d * d; d = y1.y - mean; vs += d * d; d = y1.z - mean; vs += d * d; d = y1.w - mean; vs += d * d;
      vs += __shfl_xor(vs, 1); vs += __shfl_xor(vs, 2); vs += __shfl_xor(vs, 4);
      if ((tz & 7) == 0) { stat[i2 * 2] = mean; stat[i2 * 2 + 1] = rsqrtf(vs * (1.f / 64.f) + GN_EPS); }
    }
    __syncthreads();
    const size_t rowo = (size_t)(b * SEQ + (seg * 16 + cq) * 32 + w * 8);
#pragma unroll
    for (int q = 0; q < 8; ++q) {
      const int i = w * 8 + q;
      const float yn = (Ys[i * 64 + lane] - stat[i * 2]) * stat[i * 2 + 1];
      (dry ? (u16*)(p->ws + OFF_LIN) : DA)[((rowo + q) & (dry ? 8191 : 0xffffff)) * 512 + h * 64 + lane] = f2bf((yn * lnw + lnb + dd[q] * bf2f((u16)vt[q])) * bf2f(gq[q]));
    }
    __syncthreads();
  }
  if (!dry) {
#pragma unroll
  for (int nt = 0; nt < 4; ++nt)
#pragma unroll
    for (int jj = 0; jj < 4; ++jj) so[(nt * 16 + fr) * 64 + w * 16 + fq * 4 + jj] = Sacc[nt][jj];
  }
}

__device__ __forceinline__ void gdn_scan_chain(KP p, int b, int h, int seg, bool dry) {
  const int tid = ltid(), lane = tid & 63, w = tid >> 6, fr = lane & 15, fq = lane >> 4;
  unsigned char* St = smem;
  unsigned char* Vt = smem + 128 * 272;
  u16* ORAW = dry ? (u16*)(p->ws + OFF_LIN) : (u16*)(p->ws + OFF_DE);
  f32x4 Sacc[2][8];
  float* so = p->out + OUT_GDN_P + ((size_t)b * 4 + h) * 16384;
  const float keep = seg == 0 ? 0.f : 1.f;
#pragma unroll
  for (int m = 0; m < 2; ++m) {
    const float* sbm = so + (w * 32 + m * 16 + fq * 4) * 128 + fr;
#pragma unroll
    for (int nt = 0; nt < 8; ++nt) {
#pragma unroll
      for (int j = 0; j < 4; ++j) Sacc[m][nt][j] = fminf(fmaxf(sbm[j * 128 + nt * 16], -3e38f), 3e38f) * keep;
      u16x4 o; o[0] = f2bf(Sacc[m][nt][0]); o[1] = f2bf(Sacc[m][nt][1]); o[2] = f2bf(Sacc[m][nt][2]); o[3] = f2bf(Sacc[m][nt][3]);
      *reinterpret_cast<u16x4*>(St + (nt * 16 + fr) * 272 + (w * 32 + m * 16 + fq * 4) * 2) = o;
    }
  }
  bf16x8 wn[4], qg[4], qk[2], kd[2][2]; u16x4 un[8]; float gl;
  auto loadA = [&](int n_) {
    int n = n_; asm volatile("" : "+s"(n));
    const int t = ltid(), ln = t & 63, w_ = t >> 6, fr_ = ln & 15, fq_ = ln >> 4;
    const size_t eb = (size_t)((b * 4 + h) * 8 + (n & 7)) * 8192;
    const u16* EWN = (const u16*)((const unsigned char*)p->out + EO_WN) + eb;
    const u16* EQG = (const u16*)((const unsigned char*)p->out + EO_QG) + eb;
#pragma unroll
    for (int kk = 0; kk < 4; ++kk) { wn[kk] = *reinterpret_cast<const bf16x8*>(EWN + (w_ * 16 + fr_) * 128 + kk * 32 + fq_ * 8); qg[kk] = *reinterpret_cast<const bf16x8*>(EQG + (w_ * 16 + fr_) * 128 + kk * 32 + fq_ * 8); }
  };
  auto loadU = [&](int n_) {
    int n = n_; asm volatile("" : "+s"(n));
    const int t = ltid(), ln = t & 63, w_ = t >> 6, fr_ = ln & 15, fq_ = ln >> 4;
    const size_t eb = (size_t)((b * 4 + h) * 8 + (n & 7)) * 8192;
    const u16* EUT = (const u16*)((const unsigned char*)p->out + EO_UT) + eb;
#pragma unroll
    for (int nt = 0; nt < 8; ++nt) un[nt] = *reinterpret_cast<const u16x4*>(EUT + (nt * 16 + fr_) * 64 + w_ * 16 + fq_ * 4);
  };
  auto loadB = [&](int n_) {
    int n = n_; asm volatile("" : "+s"(n));
    const int t = ltid(), ln = t & 63, w_ = t >> 6, fr_ = ln & 15, fq_ = ln >> 4;
    const int item = (b * 4 + h) * 32 + n; const size_t eb = (size_t)((b * 4 + h) * 8 + (n & 7)) * 8192;
    const u16* EKD = (const u16*)((const unsigned char*)p->out + EO_KDT) + eb; const u16* QK = (const u16*)(p->ws + OFF_QK) + (size_t)item * 4096;
    gl = ((const float*)(p->ws + OFF_GL))[item];
#pragma unroll
    for (int k2 = 0; k2 < 2; ++k2) { qk[k2] = *reinterpret_cast<const bf16x8*>(QK + (w_ * 16 + fr_) * 64 + k2 * 32 + fq_ * 8);
#pragma unroll
      for (int m = 0; m < 2; ++m) kd[m][k2] = *reinterpret_cast<const bf16x8*>(EKD + (w_ * 32 + m * 16 + fr_) * 64 + k2 * 32 + fq_ * 8); }
  };
  loadA(seg * 8); loadU(seg * 8); loadB(seg * 8);
  __syncthreads();
  for (int n = seg * 8; n < seg * 8 + 8; ++n) {
    f32x4 Oacc[8];
#pragma unroll
    for (int nt = 0; nt < 8; ++nt) {
      f32x4 va = f32x4{bf2f(un[nt][0]), bf2f(un[nt][1]), bf2f(un[nt][2]), bf2f(un[nt][3])}; Oacc[nt] = f32x4{0.f, 0.f, 0.f, 0.f};
#pragma unroll
      for (int kk = 0; kk < 4; ++kk) {
        const bf16x8 sb = *reinterpret_cast<const bf16x8*>(St + (nt * 16 + fr) * 272 + kk * 64 + fq * 16);
        va = __builtin_amdgcn_mfma_f32_16x16x32_bf16(wn[kk], sb, va, 0, 0, 0);
        Oacc[nt] = __builtin_amdgcn_mfma_f32_16x16x32_bf16(qg[kk], sb, Oacc[nt], 0, 0, 0);
      }
      u16x4 o; o[0] = f2bf(va[0]); o[1] = f2bf(va[1]); o[2] = f2bf(va[2]); o[3] = f2bf(va[3]);
      *reinterpret_cast<u16x4*>(Vt + (nt * 16 + fr) * 144 + (w * 16 + fq * 4) * 2) = o;
    }
    if (n + 1 < seg * 8 + 8) loadA(n + 1);
    __syncthreads();
    if (n + 1 < seg * 8 + 8) loadU(n + 1);
#pragma unroll
    for (int m = 0; m < 2; ++m)
#pragma unroll
      for (int nt = 0; nt < 8; ++nt) Sacc[m][nt] *= gl;
#pragma unroll
    for (int nt = 0; nt < 8; ++nt)
#pragma unroll
      for (int k2 = 0; k2 < 2; ++k2) {
        const bf16x8 vb = *reinterpret_cast<const bf16x8*>(Vt + (nt * 16 + fr) * 144 + k2 * 64 + fq * 16);
        Oacc[nt] = __builtin_amdgcn_mfma_f32_16x16x32_bf16(qk[k2], vb, Oacc[nt], 0, 0, 0);
        Sacc[0][nt] = __builtin_amdgcn_mfma_f32_16x16x32_bf16(kd[0][k2], vb, Sacc[0][nt], 0, 0, 0);
        Sacc[1][nt] = __builtin_amdgcn_mfma_f32_16x16x32_bf16(kd[1][k2], vb, Sacc[1][nt], 0, 0, 0);
      }
    if (n + 1 < seg * 8 + 8) loadB(n + 1);
#pragma unroll
    for (int m = 0; m < 2; ++m)
#pragma unroll
      for (int nt = 0; nt < 8; ++nt) {
        u16x4 o; o[0] = f2bf(Sacc[m][nt][0]); o[1] = f2bf(Sacc[m][nt][1]); o[2] = f2bf(Sacc[m][nt][2]); o[3] = f2bf(Sacc[m][nt][3]);
        *reinterpret_cast<u16x4*>(St + (nt * 16 + fr) * 272 + (w * 32 + m * 16 + fq * 4) * 2) = o;
      }
    {
      int nq = n; asm volatile("" : "+s"(nq));
#pragma unroll
      for (int j = 0; j < 4; ++j) {
        const int row = b * SEQ + nq * 64 + w * 16 + fq * 4 + j;
        u16* op = ORAW + (size_t)(dry ? (row & 8191) : row) * 512 + h * 128 + fr;
#pragma unroll
        for (int nt = 0; nt < 8; ++nt) op[nt * 16] = f2bf(Oacc[nt][j]);
      }
    }
    __syncthreads();
  }
  if (!dry)
#pragma unroll
  for (int m = 0; m < 2; ++m)
#pragma unroll
    for (int nt = 0; nt < 8; ++nt)
#pragma unroll
      for (int j = 0; j < 4; ++j) so[(w * 32 + m * 16 + fq * 4 + j) * 128 + nt * 16 + fr] = Sacc[m][nt][j];
}

__device__ __forceinline__ void phase_gdn_out(KP p) {
  const int tid = threadIdx.x, lane = tid & 63, gw = blockIdx.x * 4 + (tid >> 6), nw = gridDim.x * 4;
  const u16* ORAW = (const u16*)(p->ws + OFF_DE); u16* PJ = (u16*)(p->ws + OFF_PROJ);
  const float* gnorm = p->in[24] + (lane & 15) * 8;
  const float4 g0 = *reinterpret_cast<const float4*>(gnorm), g1 = *reinterpret_cast<const float4*>(gnorm + 4);
  const float gg[8] = {g0.x, g0.y, g0.z, g0.w, g1.x, g1.y, g1.z, g1.w};
  for (int row = gw; row < NP; row += nw) {
    const bf16x8 o8 = *reinterpret_cast<const bf16x8*>(ORAW + (size_t)row * 512 + lane * 8);
    u16* zp = PJ + (size_t)row * PCOLS + 3328 + lane * 8;
    const bf16x8 z8 = *reinterpret_cast<const bf16x8*>(zp);
    float o[8], ss = 0.f;
#pragma unroll
    for (int q = 0; q < 8; ++q) { o[q] = bf2f((u16)o8[q]); ss += o[q] * o[q]; }
    const float rs = rsqrtf(sum16(ss) * (1.f / 128.f) + NORM_EPS);
    bf16x8 r8;
#pragma unroll
    for (int q = 0; q < 8; ++q) r8[q] = (short)f2bf(o[q] * rs * gg[q] * siluf_(bf2f((u16)z8[q])));
    *reinterpret_cast<bf16x8*>(zp) = r8;
  }
}

__device__ __forceinline__ void gdn_sample_item(KP p, int b, int h, bool dry) {
  const int tid = ltid(), lane = tid & 63;
  float* cs = (float*)smem;
  float* red = cs + 384;
  float* sc = red + 512;
  const int row = NP + b;
  const u16* PJ = (const u16*)(p->ws + OFF_PROJ);
  const float* st = p->in[6] + (size_t)b * 4608; const float* cw = p->in[21];
  for (int i = tid; i < 384; i += 256) {
    const int which = i >> 7, c = i & 127, ch = which * 512 + h * 128 + c;
    float acc = st[ch] * cw[ch] + st[1536 + ch] * cw[1536 + ch] + st[3072 + ch] * cw[3072 + ch] + bf2f(PJ[(size_t)row * PCOLS + A_COLS + ch]) * cw[4608 + ch];
    cs[i] = siluf_(acc);
  }
  __syncthreads();
  if (tid < 128) {
    const int which = tid >> 6;
    const float x0 = cs[which * 128 + lane], x1 = cs[which * 128 + 64 + lane];
    const float ss = sum64(x0 * x0 + x1 * x1);
    const float s = rsqrtf(ss + 1e-6f) * (which == 0 ? 0.08838834764831845f : 1.f);
    cs[which * 128 + lane] = x0 * s; cs[which * 128 + 64 + lane] = x1 * s;
  }
  if (tid == 128) {
    const float* AB = (const float*)(p->ws + OFF_AB) + (size_t)row * 8;
    sc[0] = sigmoidf_(AB[h]); sc[1] = __expf(-__expf(p->in[22][h]) * softplusf_(AB[4 + h] + p->in[23][h]));
  }
  __syncthreads();
  if (tid < 64) { const float d = sum64(cs[lane] * cs[128 + lane] + cs[64 + lane] * cs[192 + lane]); if (lane == 0) sc[2] = d; }
  const int v = tid & 127, kh = tid >> 7;
  const float* S0 = p->in[7] + ((size_t)b * 4 + h) * 16384;
  float S[64]; float ks = 0.f, qs = 0.f;
#pragma unroll
  for (int k = 0; k < 64; ++k) { S[k] = S0[(kh * 64 + k) * 128 + v]; ks += cs[128 + kh * 64 + k] * S[k]; qs += cs[kh * 64 + k] * S[k]; }
  red[kh * 128 + v] = ks; red[256 + kh * 128 + v] = qs;
  __syncthreads();
  const float beta = sc[0], eg = sc[1], qk = sc[2];
  const float kS = red[v] + red[128 + v], qS = red[256 + v] + red[384 + v];
  const float vnew = beta * (cs[256 + v] - eg * kS);
  const float o = eg * qS + qk * vnew;
  float* so = p->out + OUT_GDN_S + ((size_t)b * 4 + h) * 16384;
#pragma unroll
  for (int k = 0; k < 64; ++k) so[(kh * 64 + k) * 128 + v] = S[k] * eg + cs[128 + kh * 64 + k] * vnew;
  __syncthreads();
  if (tid < 128) red[tid] = o * o;
  __syncthreads();
  if (tid < 64) { const float s = sum64(red[lane] + red[64 + lane]); if (lane == 0) sc[3] = s; }
  __syncthreads();
  if (tid < 128) {
    const float rs = rsqrtf(sc[3] * (1.f / 128.f) + NORM_EPS);
    u16* zp = (u16*)(p->ws + OFF_PROJ) + (size_t)row * PCOLS + 3328 + h * 128 + v;
    const float z = bf2f(*zp);
    *(dry ? (u16*)(p->ws + OFF_LIN) + (size_t)(row & 8191) * 512 + h * 128 + v : zp) = f2bf(o * rs * p->in[24][v] * siluf_(z));
  }
  __syncthreads();
}

__device__ __forceinline__ void phase_branches(KP p) {
  constexpr int NRT = MR / 128;
  u16* PA = (u16*)(p->ws + OFF_DE); u16* PB = (u16*)p->out;
  const XTiles XT = xt_make(NRT, 16, 8);
  for (int t = XT.lb; t < XT.total; t += XT.nb) {
    int ct2, rt; xt_get(XT, t, rt, ct2); const int which = ct2 >> 3, ct = ct2 & 7;
    const int row0 = rt * 128, col0 = ct * 128;
    f32x4 acc[4][4];
    if (which == 0) gemm_mainloop((const u16*)(p->ws + OFF_DA) + (size_t)row0 * 512, 512, (const u16*)(p->ws + OFF_WAT) + (size_t)col0 * 512, 512, 512, acc);
    else gemm_mainloop((const u16*)(p->ws + OFF_PROJ) + (size_t)row0 * PCOLS + 3328, PCOLS, (const u16*)(p->ws + OFF_WBT) + (size_t)col0 * 512, 512, 512, acc);
    u16* O = which == 0 ? PA : PB;
    EPI_COORDS
#pragma unroll
    for (int m = 0; m < 4; ++m)
#pragma unroll
      for (int j = 0; j < 4; ++j)
#pragma unroll
        for (int n = 0; n < 4; ++n) ((u16*)smem)[(wr_ * 64 + m * 16 + fq_ * 4 + j) * 136 + wc_ * 64 + n * 16 + fr_] = f2bf(acc[m][n][j]);
    tile_flush_bf16<128>(O, 1024, row0, col0, 1024);
  }
  u16* PE = (u16*)(p->ws + OFF_LIN);
  const int gt = blockIdx.x * 256 + threadIdx.x, nt = gridDim.x * 256;
  for (int i = gt; i < MR * 64; i += nt) {
    const int row = i >> 6, c4 = (i & 63) * 4;
    const float* src = row < NP ? p->in[2] + (size_t)row * 256 : p->in[3] + (size_t)(row - NP) * 256;
    const float4 v = *reinterpret_cast<const float4*>(src + c4);
    u16x4 o; o[0] = f2bf(v.x); o[1] = f2bf(v.y); o[2] = f2bf(v.z); o[3] = f2bf(v.w);
    *reinterpret_cast<u16x4*>(PE + (size_t)row * 256 + c4) = o;
  }
}
__device__ __forceinline__ void phase_gates(KP p) {
  constexpr int NRT = MR / 128;
  u16* PA = (u16*)(p->ws + OFF_DE); const u16* PB = (const u16*)p->out;
  const XTiles XT = xt_make(NRT, 16, 8);
  for (int t = XT.lb; t < XT.total; t += XT.nb) {
    int ct, rt; xt_get(XT, t, rt, ct); const int row0 = rt * 128, col0 = ct * 128;
    f32x4 acc[4][4];
    gemm_mainloop((const u16*)(p->ws + OFF_U) + (size_t)row0 * 1024, 1024, (const u16*)(p->ws + OFF_WGI) + (size_t)col0 * 1024, 1024, 1024, acc);
    EPI_COORDS
#pragma unroll
    for (int m = 0; m < 4; ++m) {
      u16 pa[4][2], pb[4][2];
#pragma unroll
      for (int j = 0; j < 4; ++j) { const size_t ob = (size_t)(row0 + wr_ * 64 + m * 16 + fq_ * 4 + j) * 1024 + (col0 + wc_ * 64) / 2 + fr_;
#pragma unroll
        for (int q = 0; q < 2; ++q) { pa[j][q] = PA[ob + q * 16]; pb[j][q] = PB[ob + q * 16]; } }
#pragma unroll
      for (int j = 0; j < 4; ++j) { const size_t ob = (size_t)(row0 + wr_ * 64 + m * 16 + fq_ * 4 + j) * 1024 + (col0 + wc_ * 64) / 2 + fr_;
#pragma unroll
        for (int q = 0; q < 2; ++q)
          PA[ob + q * 16] = f2bf(sigmoidf_(acc[m][2 * q][j]) * bf2f(pa[j][q]) + sigmoidf_(acc[m][2 * q + 1][j]) * bf2f(pb[j][q]));
      }
    }
  }
}
__device__ __forceinline__ void phase_wout(KP p) {
  constexpr int NRT = MR / 128;
  u16* HG = (u16*)(p->ws + OFF_U); float* rss = (float*)(p->ws + OFF_RSS); const float* gain = p->in[28];
  const XTiles XT = xt_make(NRT, 8, 8);
  for (int t = XT.lb; t < XT.total; t += XT.nb) {
    int ct, rt; xt_get(XT, t, rt, ct); const int row0 = rt * 128, col0 = ct * 128;
    f32x4 acc[4][4];
    gemm_mainloop((const u16*)(p->ws + OFF_DE) + (size_t)row0 * 1024, 1024, (const u16*)(p->ws + OFF_WOT) + (size_t)col0 * 1024, 1024, 1024, acc);
    EPI_COORDS
    float* outp = p->out; float g4[4];
#pragma unroll
    for (int n = 0; n < 4; ++n) g4[n] = gain[col0 + wc_ * 64 + n * 16 + fr_];
#pragma unroll
    for (int m = 0; m < 4; ++m) {
      float res[4][4];
#pragma unroll
      for (int j = 0; j < 4; ++j) { const float* xr = xrow(p, row0 + wr_ * 64 + m * 16 + fq_ * 4 + j) + col0 + wc_ * 64 + fr_;
#pragma unroll
        for (int n = 0; n < 4; ++n) res[j][n] = xr[n * 16]; }
#pragma unroll
      for (int j = 0; j < 4; ++j) {
        const int row = row0 + wr_ * 64 + m * 16 + fq_ * 4 + j; float ss = 0.f;
        const size_t ob = (size_t)row * 1024 + col0 + wc_ * 64 + fr_;
#pragma unroll
        for (int n = 0; n < 4; ++n) {
          const float hv = res[j][n] + acc[m][n][j];
          outp[ob + n * 16] = hv; HG[ob + n * 16] = f2bf(hv * g4[n]); ss += hv * hv;
        }
        ss = sum16(ss);
        if (fr_ == 0) atomicAdd(rss + row, ss);
      }
    }
  }
}
__device__ __forceinline__ void phase_ffn_up(KP p) {
  constexpr int NRT = MR / 128;
  u16* ACT = (u16*)(p->ws + OFF_ACT); const float* rss = (const float*)(p->ws + OFF_RSS);
  const XTiles XT = xt_make(NRT, 44, 22);
  for (int t = XT.lb; t < XT.total; t += XT.nb) {
    int ct, rt; xt_get(XT, t, rt, ct); const int row0 = rt * 128, col0 = ct * 128;
    f32x4 acc[4][4];
    gemm_mainloop((const u16*)(p->ws + OFF_U) + (size_t)row0 * 1024, 1024, (const u16*)(p->ws + OFF_WGU) + (size_t)col0 * 1024, 1024, 1024, acc);
    EPI_COORDS
    float rsv[4][4];
#pragma unroll
    for (int m = 0; m < 4; ++m)
#pragma unroll
      for (int j = 0; j < 4; ++j) rsv[m][j] = rss[row0 + wr_ * 64 + m * 16 + fq_ * 4 + j];
#pragma unroll
    for (int m = 0; m < 4; ++m)
#pragma unroll
      for (int j = 0; j < 4; ++j) {
        const int row = row0 + wr_ * 64 + m * 16 + fq_ * 4 + j;
        const float rs = rsqrtf(rsv[m][j] * (1.f / 1024.f) + NORM_EPS);
#pragma unroll
        for (int q = 0; q < 2; ++q)
          ((u16*)smem)[(row - row0) * 72 + wc_ * 32 + q * 16 + fr_] = f2bf(siluf_(rs * acc[m][2 * q][j]) * (rs * acc[m][2 * q + 1][j]));
      }
    tile_flush_bf16<64>(ACT, DFF, row0, col0 / 2, DFF);
  }
}
__device__ __forceinline__ void phase_ffn_down(KP p) {
  constexpr int NRT = MR / 128;
  u16* HG = (u16*)(p->ws + OFF_U); float* rss = (float*)(p->ws + OFF_RSS) + MR; const float* gain = p->in[32];
  u16* PP = (u16*)(p->ws + OFF_PP);
  const XTiles XT = xt_make(NRT, 16, 8);
  for (int t = XT.lb; t < XT.total; t += XT.nb) {
    int ct2, rt; xt_get(XT, t, rt, ct2); const int which = ct2 >> 3, ct = ct2 & 7; const int row0 = rt * 128, col0 = ct * 128;
    f32x4 acc[4][4];
    if (which == 0) {
      gemm_mainloop((const u16*)(p->ws + OFF_ACT) + (size_t)row0 * DFF, DFF, (const u16*)(p->ws + OFF_WDT) + (size_t)col0 * DFF, DFF, DFF, acc);
      EPI_COORDS
      float* outp = p->out; float g4[4];
#pragma unroll
      for (int n = 0; n < 4; ++n) g4[n] = gain[col0 + wc_ * 64 + n * 16 + fr_];
#pragma unroll
      for (int m = 0; m < 4; ++m) {
        float res[4][4];
#pragma unroll
        for (int j = 0; j < 4; ++j) { const float* hr = outp + (size_t)(row0 + wr_ * 64 + m * 16 + fq_ * 4 + j) * 1024 + col0 + wc_ * 64 + fr_;
#pragma unroll
          for (int n = 0; n < 4; ++n) res[j][n] = hr[n * 16]; }
#pragma unroll
        for (int j = 0; j < 4; ++j) {
          const int row = row0 + wr_ * 64 + m * 16 + fq_ * 4 + j; float ss = 0.f;
          const size_t ob = (size_t)row * 1024 + col0 + wc_ * 64 + fr_;
#pragma unroll
          for (int n = 0; n < 4; ++n) {
            const float hv = res[j][n] + acc[m][n][j];
            outp[ob + n * 16] = hv; HG[ob + n * 16] = f2bf(hv * g4[n]); ss += hv * hv;
          }
          ss = sum16(ss);
          if (fr_ == 0) atomicAdd(rss + row, ss);
        }
      }
    } else {
      gemm_mainloop((const u16*)(p->ws + OFF_LIN) + (size_t)row0 * 256, 256, (const u16*)(p->ws + OFF_WPP) + (size_t)col0 * 256, 256, 256, acc);
      EPI_COORDS
#pragma unroll
      for (int m = 0; m < 4; ++m)
#pragma unroll
        for (int j = 0; j < 4; ++j) {
          const int row = row0 + wr_ * 64 + m * 16 + fq_ * 4 + j;
#pragma unroll
          for (int n = 0; n < 4; ++n) PP[(size_t)row * 1024 + col0 + wc_ * 64 + n * 16 + fr_] = f2bf(acc[m][n][j]);
        }
    }
  }
}
__device__ __forceinline__ void phase_ple(KP p) {
  constexpr int NRT = MR / 128;
  const float* rss2 = (const float*)(p->ws + OFF_RSS) + MR; float* rss3 = (float*)(p->ws + OFF_RSS) + 2 * MR;
  const u16* PP = (const u16*)(p->ws + OFF_PP);
  const XTiles XT = xt_make(NRT, 8, 8);
  for (int t = XT.lb; t < XT.total; t += XT.nb) {
    int ct, rt; xt_get(XT, t, rt, ct); const int row0 = rt * 128, col0 = ct * 128;
    f32x4 acc[4][4];
    gemm_mainloop((const u16*)(p->ws + OFF_U) + (size_t)row0 * 1024, 1024, (const u16*)(p->ws + OFF_WPG) + (size_t)col0 * 1024, 1024, 1024, acc);
    EPI_COORDS
    float* outp = p->out;
#pragma unroll
    for (int m = 0; m < 4; ++m) {
      float res[4][4]; u16 pp[4][4]; float rsv[4];
#pragma unroll
      for (int j = 0; j < 4; ++j) { const size_t ob = (size_t)(row0 + wr_ * 64 + m * 16 + fq_ * 4 + j) * 1024 + col0 + wc_ * 64 + fr_;
        rsv[j] = rss2[row0 + wr_ * 64 + m * 16 + fq_ * 4 + j];
#pragma unroll
        for (int n = 0; n < 4; ++n) { res[j][n] = outp[ob + n * 16]; pp[j][n] = PP[ob + n * 16]; } }
#pragma unroll
      for (int j = 0; j < 4; ++j) {
        const int row = row0 + wr_ * 64 + m * 16 + fq_ * 4 + j; float ss = 0.f;
        const float rs = rsqrtf(rsv[j] * (1.f / 1024.f) + NORM_EPS);
        const size_t ob = (size_t)row * 1024 + col0 + wc_ * 64 + fr_;
#pragma unroll
        for (int n = 0; n < 4; ++n) {
          const float hv = res[j][n] + sigmoidf_(rs * acc[m][n][j]) * bf2f(pp[j][n]);
          outp[ob + n * 16] = hv; ss += hv * hv;
        }
        ss = sum16(ss);
        if (fr_ == 0) atomicAdd(rss3 + row, ss);
      }
    }
  }
}
__device__ __forceinline__ void phase_final(KP p) {
  const float* rss3 = (const float*)(p->ws + OFF_RSS) + 2 * MR; const float* gain = p->in[35];
  const int gt = blockIdx.x * 256 + threadIdx.x, nt = gridDim.x * 256;
  for (int i = gt; i < MR * 256; i += nt) {
    const int row = i >> 8, c4 = (i & 255) * 4;
    const float rs = rsqrtf(rss3[row] * (1.f / 1024.f) + NORM_EPS);
    float4 v = *reinterpret_cast<float4*>(p->out + (size_t)row * 1024 + c4);
    const float4 g = *reinterpret_cast<const float4*>(gain + c4);
    v.x *= rs * g.x; v.y *= rs * g.y; v.z *= rs * g.z; v.w *= rs * g.w;
#ifdef PROBE_TS
    { const unsigned long long* ts = (const unsigned long long*)(p->ws + OFF_BAR + 14336);
      float d1 = 0.f, d2 = 0.f;
      PROBE_D1; PROBE_D2;
      if (row >= NP) { const float sc = 1.f + d1 * 1e-5f; v.x *= sc; v.y *= sc; v.z *= sc; v.w *= sc; }
      if (i == 0) v.x += d2 * 0.01f; }
#endif
    *reinterpret_cast<float4*>(p->out + (size_t)row * 1024 + c4) = v;
  }
}


#define XB_TMO      128
#define XB_XCNT(j)  (256  + 64 * (j))
#define XB_XSUB(j)  (1280 + 64 * (j))
#define XB_XGEN(j)  (2304 + 64 * (j))
#define XB_TOP      3328
#define XB_TOPGEN   3392
#define XCD_BAR_WORDS 3456
#define XB_SPIN_CAP (1u << 22)
#define LAS __attribute__((address_space(3)))
__device__ __forceinline__ unsigned xb_ld(unsigned* p) { return __hip_atomic_load(p, __ATOMIC_RELAXED, __HIP_MEMORY_SCOPE_AGENT); }
__device__ __forceinline__ unsigned xb_add(unsigned* p, unsigned v) { return __hip_atomic_fetch_add(p, v, __ATOMIC_RELAXED, __HIP_MEMORY_SCOPE_AGENT); }
__device__ __forceinline__ unsigned xb_xcc_id() { return (unsigned)__builtin_amdgcn_s_getreg((3 << 11) | 20) & 0xFu; }
#define XB_SPIN(cond, bar) do { unsigned _sp = 0; while (cond) { __builtin_amdgcn_s_sleep(1); \
    if ((++_sp & 255u) == 0u) { if (xb_ld(&(bar)[XB_TMO])) break; if (_sp > XB_SPIN_CAP) { atomicAdd(&(bar)[XB_TMO], 1u); break; } } } } while (0)
struct XcdBarrier { unsigned* bar; unsigned x; volatile LAS unsigned* st; };
__device__ __forceinline__ XcdBarrier xcd_barrier_post(unsigned* bar, volatile LAS unsigned* st) {
  XcdBarrier b; b.bar = bar; b.x = xb_xcc_id(); b.st = st;
  if (threadIdx.x == 0) (void)xb_add(&bar[XB_XCNT(b.x)], 1u);
  return b;
}
__device__ __forceinline__ void xcd_barrier_complete(unsigned* bar, unsigned x, unsigned& nloc, unsigned& nx) {
  const unsigned G = gridDim.x * gridDim.y * gridDim.z;
  unsigned sum, cnt, mine, sp = 0u;
  for (;;) {
    sum = 0u; cnt = 0u; mine = 0u;
#pragma unroll
    for (unsigned j = 0; j < 16; ++j) { const unsigned c = xb_ld(&bar[XB_XCNT(j)]); sum += c; cnt += (c > 0u) ? 1u : 0u; mine = (j == x) ? c : mine; }
    if (sum == G) break;
    __builtin_amdgcn_s_sleep(1);
    if ((++sp & 255u) == 0u) { if (xb_ld(&bar[XB_TMO])) break; if (sp > XB_SPIN_CAP) { atomicAdd(&bar[XB_TMO], 1u); break; } }
  }
  nloc = mine > 0u ? mine : 1u; nx = cnt > 0u ? cnt : 1u;
}
__device__ __forceinline__ void xcd_barrier(const XcdBarrier& b) {
  asm volatile("s_waitcnt vmcnt(0)" ::: "memory");
  __syncthreads();
  if (threadIdx.x == 0) {
    unsigned* bar = b.bar;
    __builtin_amdgcn_s_waitcnt(0);
    unsigned nloc = b.st[0], nx = b.st[1];
    if (nloc == 0u) { xcd_barrier_complete(bar, b.x, nloc, nx); b.st[0] = nloc; b.st[1] = nx; }
    const unsigned old = xb_add(&bar[XB_XSUB(b.x)], 1u);
    const unsigned gen = old / nloc;
    if (old + 1u == (gen + 1u) * nloc) {
      __builtin_amdgcn_fence(__ATOMIC_RELEASE, "agent");
      asm volatile("s_waitcnt vmcnt(0)" ::: "memory");
      const unsigned og = xb_add(&bar[XB_TOP], 1u);
      const unsigned tg = og / nx;
      if (og + 1u == (tg + 1u) * nx) xb_add(&bar[XB_TOPGEN], 1u);
      else XB_SPIN(xb_ld(&bar[XB_TOPGEN]) == tg, bar);
      __builtin_amdgcn_fence(__ATOMIC_ACQUIRE, "agent");
      xb_add(&bar[XB_XGEN(b.x)], 1u);
      asm volatile("s_waitcnt vmcnt(0)" ::: "memory");
    } else {
      XB_SPIN(xb_ld(&bar[XB_XGEN(b.x)]) == gen, bar);
      __builtin_amdgcn_fence(__ATOMIC_ACQUIRE, "agent");
      asm volatile("s_waitcnt vmcnt(0)" ::: "memory");
    }
  }
  __syncthreads();
}

#ifdef PROBE_TS
#define TS(k) do { if (blockIdx.x == 0 && threadIdx.x == 0) ((unsigned long long*)(p->ws + OFF_BAR + 14336))[k] = __builtin_amdgcn_s_memrealtime(); } while (0)
#else
#define TS(k) do { } while (0)
#endif
__global__ void __launch_bounds__(256, 2) hybrid_fwd(Params pv) {
  KP p = (KP)__builtin_amdgcn_kernarg_segment_ptr();
  cg::grid_group grid = cg::this_grid();
  volatile LAS unsigned* xst = (volatile LAS unsigned*)(smem + LDS_BYTES - 16);
  if (threadIdx.x == 0) { xst[0] = 0u; xst[1] = 0u; }
  __syncthreads();
  const XcdBarrier xb = xcd_barrier_post((unsigned*)(p->ws + OFF_BAR), xst);
  TS(0);
  phase_prep(p);
  if (p->ws == nullptr) grid.sync();
  xcd_barrier(xb); TS(1);
  phase_proj(p);
  xcd_barrier(xb); TS(2);
  phase_lora_in(p);
  xcd_barrier(xb); TS(3);
  phase_lora(p);
  xcd_barrier(xb); TS(4);
  {
    const int G = gridDim.x, bid = blockIdx.x;
    unsigned char* recs = (unsigned char*)p->out;
#pragma unroll 1
    for (int seg = 0; seg < 4; ++seg) {
      int sg = seg; asm volatile("" : "+s"(sg));
#ifndef PROBE_PREP_N
#define PROBE_PREP_N 1
#endif
#ifndef PROBE_SCAN_N
#define PROBE_SCAN_N 1
#endif
      int nprep = PROBE_PREP_N, nscan = PROBE_SCAN_N;
      if (PROBE_PREP_N > 1) asm volatile("" : "+s"(nprep));
      if (PROBE_SCAN_N > 1) asm volatile("" : "+s"(nscan));
      for (int rep = 0; rep < nprep; ++rep)
      for (int it = bid; it < 1024 + 256; it += G) {
        if (it < 1024) rwkv_prep_item(p, it >> 4, sg * 16 + (it & 15), recs + (size_t)it * RW_REC);
        else gdn_prep_item(p, ((it - 1024) >> 3) * 32 + sg * 8 + ((it - 1024) & 7));
      }
      xcd_barrier(xb); TS(5 + 2 * seg);
      for (int rep = 0; rep < nscan; ++rep) {
        const bool dry = rep + 1 < nscan;
#ifndef PROBE_SCAN_MASK
#define PROBE_SCAN_MASK 3
#endif
        if (bid < 64) { if (!dry || (PROBE_SCAN_MASK & 1)) rwkv_scan_seg(p, bid, sg, recs, dry); }
        else if (bid < 96) { if (!dry || (PROBE_SCAN_MASK & 2)) gdn_scan_chain(p, (bid - 64) >> 2, (bid - 64) & 3, sg, dry); }
        if (dry) xcd_barrier(xb);
      }
      if (bid < 96) { }
      else if (seg == 0) {
        for (int it = bid - 96; it < 1024; it += G - 96) rwkv_chain<true>(p, 8 + (it >> 3), it & 7, false);
        for (int it = (G - 1 - bid); it < 512; it += G - 96) gdn_sample_item(p, it >> 2, it & 3, false);
      }
      if (seg < 3) { xcd_barrier(xb); TS(6 + 2 * seg); }
    }
  }
  xcd_barrier(xb); TS(12);
  phase_gdn_out(p);
  xcd_barrier(xb);
  phase_branches(p);
  xcd_barrier(xb); TS(13);
  phase_gates(p);
  xcd_barrier(xb); TS(14);
  phase_wout(p);
  xcd_barrier(xb); TS(15);
  phase_ffn_up(p);
  xcd_barrier(xb); TS(16);
  phase_ffn_down(p);
  xcd_barrier(xb); TS(17);
  phase_ple(p);
  xcd_barrier(xb); TS(18);
  phase_final(p);
}

extern "C" void kernel_launch(void* const* d_in, const int* in_sizes, int n_in, void* d_out, int out_size, void* d_ws, size_t ws_size,
                              hipStream_t stream) {
  static int grid_blocks = 0;
  if (!grid_blocks) {
    int dev = 0, cus = 0, per_cu = 0;
    hipGetDevice(&dev);
    hipDeviceGetAttribute(&cus, hipDeviceAttributeMultiprocessorCount, dev);
    hipFuncSetAttribute((const void*)hybrid_fwd, hipFuncAttributeMaxDynamicSharedMemorySize, LDS_BYTES);
    hipOccupancyMaxActiveBlocksPerMultiprocessor(&per_cu, (const void*)hybrid_fwd, 256, LDS_BYTES);
    if (per_cu > 2) per_cu = 2;
    if (per_cu < 1) per_cu = 1;
    grid_blocks = cus * per_cu;
  }
  Params p{};
  for (int i = 0; i < 36; ++i) p.in[i] = (const float*)d_in[i];
  p.out = (float*)d_out; p.ws = (unsigned char*)d_ws;
  (void)hipMemsetAsync((unsigned char*)d_ws + OFF_BAR, 0, 16384, stream);
  void* args[] = {&p};
  hipError_t e = hipLaunchCooperativeKernel((const void*)hybrid_fwd, dim3(grid_blocks), dim3(256), args, LDS_BYTES, stream);
  if (e != hipSuccess) fprintf(stderr, "cooperative launch failed: %s (grid %d)\n", hipGetErrorString(e), grid_blocks);
}
```

```cpp
#include <hip/hip_runtime.h>
#include <hip/hip_bf16.h>
#include <hip/hip_cooperative_groups.h>
#include <cstdio>
namespace cg = cooperative_groups;

typedef unsigned short u16;
using bf16x8 = __attribute__((ext_vector_type(8))) short;
using u16x4 = __attribute__((ext_vector_type(4))) unsigned short;
using f32x4 = __attribute__((ext_vector_type(4))) float;

constexpr int D = 1024, NP = 16384, NS = 128, MR = NP + NS;
constexpr int SEQ = 2048;
constexpr int A_COLS = 1792, PCOLS = 3848;
constexpr int IN_COLS = 5896, DFF = 2816;
constexpr float NORM_EPS = 1e-6f, GN_EPS = 64e-5f;

constexpr long OUT_Y = 0;
constexpr long OUT_SHIFT_P = (long)MR * D;
constexpr long OUT_WKV_P = OUT_SHIFT_P + 8 * 1792;
constexpr long OUT_CONV_P = OUT_WKV_P + 8L * 8 * 64 * 64;
constexpr long OUT_GDN_P = OUT_CONV_P + 8 * 3 * 1536;
constexpr long OUT_SHIFT_S = OUT_GDN_P + 8L * 4 * 128 * 128;
constexpr long OUT_WKV_S = OUT_SHIFT_S + 128 * 1792;
constexpr long OUT_CONV_S = OUT_WKV_S + 128L * 8 * 64 * 64;
constexpr long OUT_GDN_S = OUT_CONV_S + 128 * 3 * 1536;

constexpr size_t OFF_WINT = 0;
constexpr size_t OFF_WGI = OFF_WINT + (size_t)PCOLS * 1024 * 2;
constexpr size_t OFF_W2T = OFF_WGI + (size_t)2048 * 1024 * 2;
constexpr size_t OFF_A2T = OFF_W2T + 512 * 64 * 2;
constexpr size_t OFF_G2T = OFF_A2T + 512 * 64 * 2;
constexpr size_t OFF_WAT = OFF_G2T + 512 * 128 * 2;
constexpr size_t OFF_WBT = OFF_WAT + 1024 * 512 * 2;
constexpr size_t OFF_WOT = OFF_WBT + 1024 * 512 * 2;
constexpr size_t OFF_WGU = OFF_WOT + 1024 * 1024 * 2;
constexpr size_t OFF_WDT = OFF_WGU + (size_t)5632 * 1024 * 2;
constexpr size_t OFF_WPG = OFF_WDT + (size_t)1024 * 2816 * 2;
constexpr size_t OFF_WPP = OFF_WPG + 1024 * 1024 * 2;
constexpr size_t OFF_U = OFF_WPP + 1024 * 256 * 2;
constexpr size_t OFF_PROJ = OFF_U + (size_t)MR * 1024 * 2;
constexpr size_t OFF_DA = OFF_PROJ + (size_t)MR * PCOLS * 2;
constexpr size_t OFF_DE = OFF_DA + (size_t)MR * 512 * 2;
constexpr size_t OFF_DG = OFF_DE + (size_t)MR * 512 * 2;
constexpr size_t OFF_QK = OFF_DG + (size_t)MR * 512 * 2;
constexpr size_t OFF_LIN = OFF_QK + (size_t)1024 * 64 * 64 * 2;
constexpr size_t OFF_RSS = OFF_LIN + (size_t)MR * 256 * 2;
constexpr size_t OFF_AB = OFF_RSS + (size_t)3 * MR * 4;
constexpr size_t OFF_GL = OFF_AB + (size_t)MR * 8 * 4;
constexpr size_t OFF_BAR = OFF_GL + 4096;
constexpr size_t OFF_END = OFF_BAR + 16384;
constexpr size_t OFF_ACT = OFF_PROJ;
constexpr size_t OFF_PP = OFF_PROJ + (size_t)MR * DFF * 2;
static_assert(OFF_PP + (size_t)MR * 1024 * 2 <= OFF_DA, "pp overflow");
static_assert(OFF_END <= 268435456ull, "ws overflow");
constexpr size_t EO_UT = 37748736, EO_WN = EO_UT + 4194304, EO_QG = EO_WN + 4194304, EO_KDT = EO_QG + 4194304;

struct Params { const float* in[36]; float* out; unsigned char* ws; };
typedef const __attribute__((address_space(4))) Params* KP;

extern __shared__ __attribute__((aligned(16))) unsigned char smem[];
constexpr int LDS_BYTES = 72192;

__device__ __forceinline__ int ltid() { int t = threadIdx.x; asm volatile("" : "+v"(t)); return t; }
__device__ __forceinline__ u16 f2bf(float f) { unsigned u = __float_as_uint(f); u += 0x7fffu + ((u >> 16) & 1u); return (u16)(u >> 16); }
__device__ __forceinline__ float bf2f(u16 h) { return __uint_as_float(((unsigned)h) << 16); }
__device__ __forceinline__ float sigmoidf_(float x) { return 1.f / (1.f + __expf(-x)); }
__device__ __forceinline__ float siluf_(float x) { return x / (1.f + __expf(-x)); }
__device__ __forceinline__ float softplusf_(float x) { return fmaxf(x, 0.f) + log1pf(__expf(-fabsf(x))); }
__device__ __forceinline__ float quad_sum(float x) {
  x += __int_as_float(__builtin_amdgcn_update_dpp(0, __float_as_int(x), 0xB1, 0xF, 0xF, true));
  x += __int_as_float(__builtin_amdgcn_update_dpp(0, __float_as_int(x), 0x4E, 0xF, 0xF, true));
  return x;
}
__device__ __forceinline__ float sum16(float x) {
  x += __shfl_xor(x, 1); x += __shfl_xor(x, 2); x += __shfl_xor(x, 4); x += __shfl_xor(x, 8); return x;
}
__device__ __forceinline__ float sum64(float x) { x = sum16(x); x += __shfl_xor(x, 16); x += __shfl_xor(x, 32); return x; }
__device__ __forceinline__ const float* xrow(KP p, int row) {
  return row < NP ? p->in[0] + (size_t)row * D : p->in[1] + (size_t)(row - NP) * D;
}

__device__ __forceinline__ void gemm_mainloop(const u16* __restrict__ A, long lda, const u16* __restrict__ Bt, long ldb, int K,
                                              f32x4 (&acc)[4][4]) {
  const int tid = threadIdx.x, lane = tid & 63, wid = tid >> 6, wr = wid >> 1, wc = wid & 1, fr = lane & 15, fq = lane >> 4;
  unsigned char* SA = smem; unsigned char* SB = smem + 16384;
#pragma unroll
  for (int m = 0; m < 4; ++m)
#pragma unroll
    for (int n = 0; n < 4; ++n) acc[m][n] = f32x4{0.f, 0.f, 0.f, 0.f};
  const int nk = K >> 6;
  for (int kt = 0; kt < nk; ++kt) {
#pragma unroll
    for (int i = 0; i < 4; ++i) {
      const int b = tid * 16 + i * 4096, r = b >> 7, c = (((b & 127) >> 4) ^ (r & 7)) * 8;
      __builtin_amdgcn_global_load_lds((const unsigned*)(A + (long)r * lda + kt * 64 + c), (unsigned*)(SA + b), 16, 0, 0);
      __builtin_amdgcn_global_load_lds((const unsigned*)(Bt + (long)r * ldb + kt * 64 + c), (unsigned*)(SB + b), 16, 0, 0);
    }
    asm volatile("s_waitcnt vmcnt(0)" ::: "memory");
    __syncthreads();
#pragma unroll
    for (int kk = 0; kk < 2; ++kk) {
      bf16x8 a[4], b[4];
#pragma unroll
      for (int m = 0; m < 4; ++m) { const int r = wr * 64 + m * 16 + fr; a[m] = *reinterpret_cast<const bf16x8*>(SA + r * 128 + (((kk * 4 + fq) ^ (r & 7)) << 4)); }
#pragma unroll
      for (int n = 0; n < 4; ++n) { const int r = wc * 64 + n * 16 + fr; b[n] = *reinterpret_cast<const bf16x8*>(SB + r * 128 + (((kk * 4 + fq) ^ (r & 7)) << 4)); }
#pragma unroll
      for (int m = 0; m < 4; ++m)
#pragma unroll
        for (int n = 0; n < 4; ++n) acc[m][n] = __builtin_amdgcn_mfma_f32_16x16x32_bf16(a[m], b[n], acc[m][n], 0, 0, 0);
    }
    __syncthreads();
  }
}

struct XTiles { int x, lb, nb, nr, nct, W, ng, total; };
__device__ __forceinline__ XTiles xt_make(int nrt, int nct, int W) {
  XTiles t; t.x = blockIdx.x & 7; t.lb = blockIdx.x >> 3; t.nb = gridDim.x >> 3;
  t.nr = (nrt - t.x + 7) >> 3; t.nct = nct; t.W = W; t.ng = (nct + W - 1) / W; t.total = t.nr * nct; return t;
}
__device__ __forceinline__ void xt_get(const XTiles& t, int u, int& rt, int& ct) {
  int g = u / (t.W * t.nr); if (g > t.ng - 1) g = t.ng - 1;
  const int rem = u - g * t.W * t.nr; const int wg = (g == t.ng - 1) ? t.nct - g * t.W : t.W;
  const int rl = rem / wg, cl = rem - rl * wg; rt = t.x + 8 * rl; ct = g * t.W + cl;
}
#define EPI_COORDS const int tid_ = threadIdx.x, lane_ = tid_ & 63, wid_ = tid_ >> 6, wr_ = wid_ >> 1, wc_ = wid_ & 1, fr_ = lane_ & 15, fq_ = lane_ >> 4; (void)wc_; (void)wr_; (void)fr_; (void)fq_;

template <int NC>
__device__ __forceinline__ void tile_flush_bf16(u16* __restrict__ dst, long ld, int row0, int col0, int col_limit) {
  __syncthreads();
  const u16* T = (const u16*)smem;
  constexpr int CPR = NC / 8;
#pragma unroll
  for (int i = 0; i < (128 * CPR) / 256; ++i) {
    const int c = threadIdx.x + i * 256, r = c / CPR, chk = c % CPR;
    const bf16x8 v = *reinterpret_cast<const bf16x8*>(T + r * (NC + 8) + chk * 8);
    if (col0 + chk * 8 < col_limit) *reinterpret_cast<bf16x8*>(dst + (long)(row0 + r) * ld + col0 + chk * 8) = v;
  }
  __syncthreads();
}

struct TJob { const float* src; int ld_src; int K; int N; u16* dst; int ld_dst; int ilv; };
__device__ __forceinline__ TJob get_job(KP p, int j) {
  unsigned char* ws = p->ws; TJob t;
  switch (j) {
    case 0: t = TJob{p->in[9], IN_COLS, 1024, PCOLS, (u16*)(ws + OFF_WINT), 1024, 0}; break;
    case 1: t = TJob{p->in[9] + PCOLS, IN_COLS, 1024, 1024, (u16*)(ws + OFF_WGI), 1024, 1}; break;
    case 2: t = TJob{p->in[9] + PCOLS + 1024, IN_COLS, 1024, 1024, (u16*)(ws + OFF_WGI), 1024, 2}; break;
    case 3: t = TJob{p->in[12], 512, 64, 512, (u16*)(ws + OFF_W2T), 64, 0}; break;
    case 4: t = TJob{p->in[14], 512, 64, 512, (u16*)(ws + OFF_A2T), 64, 0}; break;
    case 5: t = TJob{p->in[15], 512, 128, 512, (u16*)(ws + OFF_G2T), 128, 0}; break;
    case 6: t = TJob{p->in[25], 1024, 512, 1024, (u16*)(ws + OFF_WAT), 512, 0}; break;
    case 7: t = TJob{p->in[26], 1024, 512, 1024, (u16*)(ws + OFF_WBT), 512, 0}; break;
    case 8: t = TJob{p->in[27], 1024, 1024, 1024, (u16*)(ws + OFF_WOT), 1024, 0}; break;
    case 9: t = TJob{p->in[29], DFF, 1024, DFF, (u16*)(ws + OFF_WGU), 1024, 1}; break;
    case 10: t = TJob{p->in[30], DFF, 1024, DFF, (u16*)(ws + OFF_WGU), 1024, 2}; break;
    case 11: t = TJob{p->in[31], 1024, DFF, 1024, (u16*)(ws + OFF_WDT), DFF, 0}; break;
    case 12: t = TJob{p->in[33], 1024, 1024, 1024, (u16*)(ws + OFF_WPG), 1024, 0}; break;
    default: t = TJob{p->in[34], 1024, 256, 1024, (u16*)(ws + OFF_WPP), 256, 0}; break;
  }
  return t;
}
__device__ __forceinline__ int job_tiles(const TJob& t) { return (t.K >> 6) * ((t.N + 63) >> 6); }

__device__ __forceinline__ void phase_prep(KP p) {
  const int tid = threadIdx.x;
  float* T = (float*)smem;
  int total = 0;
  for (int j = 0; j < 14; ++j) { TJob t = get_job(p, j); total += job_tiles(t); }
  for (int g = blockIdx.x; g < total; g += gridDim.x) {
    int j = 0, rem = g; TJob t = get_job(p, 0);
    for (;;) { int nt_ = job_tiles(t); if (rem < nt_) break; rem -= nt_; ++j; t = get_job(p, j); }
    const int nkt = t.K >> 6; const int kt = rem % nkt, nt = rem / nkt;
#pragma unroll
    for (int i = 0; i < 4; ++i) {
      const int k = (tid >> 4) + 16 * i, n4 = (tid & 15) * 4, n = nt * 64 + n4;
      float4 v = *reinterpret_cast<const float4*>(t.src + (long)(kt * 64 + k) * t.ld_src + (n < t.N ? n : 0));
      if (n >= t.N) v = make_float4(0.f, 0.f, 0.f, 0.f);
      T[k * 65 + n4 + 0] = v.x; T[k * 65 + n4 + 1] = v.y; T[k * 65 + n4 + 2] = v.z; T[k * 65 + n4 + 3] = v.w;
    }
    __syncthreads();
    {
      const int nl = tid >> 2, kq = (tid & 3) * 16, n = nt * 64 + nl;
      if (n < t.N) {
        const int drow = t.ilv ? ((((n >> 4) * 2 + (t.ilv - 1)) << 4) + (n & 15)) : n;
        bf16x8 o0, o1;
#pragma unroll
        for (int q = 0; q < 8; ++q) { o0[q] = (short)f2bf(T[(kq + q) * 65 + nl]); o1[q] = (short)f2bf(T[(kq + 8 + q) * 65 + nl]); }
        u16* d = t.dst + (long)drow * t.ld_dst + kt * 64 + kq;
        *reinterpret_cast<bf16x8*>(d) = o0; *reinterpret_cast<bf16x8*>(d + 8) = o1;
      }
    }
    __syncthreads();
  }
  {
    const int lane = tid & 63, gw = blockIdx.x * 4 + (tid >> 6), nw = gridDim.x * 4;
    u16* U = (u16*)(p->ws + OFF_U);
    const float* gain = p->in[8];
    for (int row = gw; row < MR; row += nw) {
      const float* x = xrow(p, row);
      float4 v[4]; float ss = 0.f;
#pragma unroll
      for (int i = 0; i < 4; ++i) { v[i] = *reinterpret_cast<const float4*>(x + i * 256 + lane * 4); ss += v[i].x * v[i].x + v[i].y * v[i].y + v[i].z * v[i].z + v[i].w * v[i].w; }
      ss = sum64(ss);
      const float rs = rsqrtf(ss * (1.f / 1024.f) + NORM_EPS);
#pragma unroll
      for (int i = 0; i < 4; ++i) {
        const float4 g4 = *reinterpret_cast<const float4*>(gain + i * 256 + lane * 4);
        u16x4 o; o[0] = f2bf(v[i].x * rs * g4.x); o[1] = f2bf(v[i].y * rs * g4.y); o[2] = f2bf(v[i].z * rs * g4.z); o[3] = f2bf(v[i].w * rs * g4.w);
        *reinterpret_cast<u16x4*>(U + (size_t)row * 1024 + i * 256 + lane * 4) = o;
      }
    }
  }
  {
    float* rss = (float*)(p->ws + OFF_RSS);
    const int gt = blockIdx.x * 256 + tid, nt = gridDim.x * 256;
    for (int i = gt; i < 3 * MR; i += nt) rss[i] = 0.f;
    const float* sc = p->in[6];
    for (int i = gt; i < 128 * 2 * 1536; i += nt) {
      const int b = i / 3072, r = i - b * 3072;
      p->out[OUT_CONV_S + (long)b * 4608 + r] = sc[(long)b * 4608 + 1536 + r];
    }
  }
}

__device__ __forceinline__ void phase_proj(KP p) {
  const u16* U = (const u16*)(p->ws + OFF_U); const u16* W = (const u16*)(p->ws + OFF_WINT);
  u16* PJ = (u16*)(p->ws + OFF_PROJ); float* AB = (float*)(p->ws + OFF_AB);
  constexpr int NCT = 31, NRT = MR / 128;
  const XTiles XT = xt_make(NRT, NCT, 16);
  for (int t = XT.lb; t < XT.total; t += XT.nb) {
    int ct, rt; xt_get(XT, t, rt, ct); const int row0 = rt * 128, col0 = ct * 128;
    f32x4 acc[4][4];
    gemm_mainloop(U + (size_t)row0 * 1024, 1024, W + (size_t)col0 * 1024, 1024, 1024, acc);
    EPI_COORDS
    {
      u16* T = (u16*)smem;
#pragma unroll
      for (int m = 0; m < 4; ++m)
#pragma unroll
        for (int j = 0; j < 4; ++j)
#pragma unroll
          for (int n = 0; n < 4; ++n) T[(wr_ * 64 + m * 16 + fq_ * 4 + j) * 136 + wc_ * 64 + n * 16 + fr_] = f2bf(acc[m][n][j]);
    }
    const bool special = (rt & 15) == 15 || rt == NRT - 1 || ct == NCT - 1;
    if (special) {
#pragma unroll
    for (int m = 0; m < 4; ++m)
#pragma unroll
      for (int j = 0; j < 4; ++j) {
        const int row = row0 + wr_ * 64 + m * 16 + fq_ * 4 + j;
        int shift_b = -1; long shift_off = 0; int conv_j = -1; long conv_off = 0;
        if (row < NP) { const int tt = row & (SEQ - 1), b = row >> 11; if (tt == SEQ - 1) { shift_b = b; shift_off = OUT_SHIFT_P + (long)b * 1792; }
                        if (tt >= SEQ - 3) { conv_j = tt - (SEQ - 3); conv_off = OUT_CONV_P + ((long)b * 3 + conv_j) * 1536; } }
        else { const int b = row - NP; shift_b = b; shift_off = OUT_SHIFT_S + (long)b * 1792; conv_j = 2; conv_off = OUT_CONV_S + ((long)b * 3 + 2) * 1536; }
#pragma unroll
        for (int n = 0; n < 4; ++n) {
          const int col = col0 + wc_ * 64 + n * 16 + fr_;
          const float v = acc[m][n][j];
          if (col < PCOLS) {
            if (col >= 3840) AB[(size_t)row * 8 + (col - 3840)] = v;
            if (shift_b >= 0 && col < A_COLS) p->out[shift_off + col] = v;
            if (conv_j >= 0 && col >= A_COLS && col < A_COLS + 1536) p->out[conv_off + (col - A_COLS)] = v;
          }
        }
      }
    }
    tile_flush_bf16<128>(PJ, PCOLS, row0, col0, PCOLS);
  }
}

__device__ __forceinline__ void phase_lora_in(KP p) {
  const u16* PJ = (const u16*)(p->ws + OFF_PROJ); u16* LIN = (u16*)(p->ws + OFF_LIN);
  const float* mu = p->in[10]; const float* sh = p->in[4];
  const int gt = blockIdx.x * 256 + threadIdx.x, nt = gridDim.x * 256;
  for (int i = gt; i < MR * 64; i += nt) {
    const int row = i >> 6, c4 = (i & 63) * 4, col = 1536 + c4;
    const u16x4 cur = *reinterpret_cast<const u16x4*>(PJ + (size_t)row * PCOLS + col);
    float pv[4];
    {
      const bool hasprev = row < NP && (row & (SEQ - 1)) > 0;
      const u16x4 pr = *reinterpret_cast<const u16x4*>(PJ + (size_t)(hasprev ? row - 1 : row) * PCOLS + col);
      const float4 s4 = *reinterpret_cast<const float4*>(sh + (size_t)(row >= NP ? row - NP : 0) * 1792 + col);
      const float sv[4] = {s4.x, s4.y, s4.z, s4.w};
      for (int q = 0; q < 4; ++q) pv[q] = row >= NP ? sv[q] : (hasprev ? bf2f(pr[q]) : 0.f);
    }
    const float4 m4 = *reinterpret_cast<const float4*>(mu + col);
    const float mm[4] = {m4.x, m4.y, m4.z, m4.w};
    u16x4 o;
#pragma unroll
    for (int q = 0; q < 4; ++q) {
      const float c = bf2f(cur[q]); float x = c + (pv[q] - c) * mm[q];
      if (c4 < 64) x = tanhf(x); else if (c4 >= 128) x = sigmoidf_(x);
      o[q] = f2bf(x);
    }
    *reinterpret_cast<u16x4*>(LIN + (size_t)row * 256 + c4) = o;
  }
}

__device__ __forceinline__ void gdn_prep_item(KP p, int item) {
  const int tid = ltid(), lane = tid & 63, wid = tid >> 6, fr = lane & 15, fq = lane >> 4;
  const int n = item & 31, h = (item >> 5) & 3, b = item >> 7;
  const int rowb = b * SEQ + n * 64;
  const u16* PJ = (const u16*)(p->ws + OFF_PROJ);
  u16* qs = (u16*)smem; u16* ks = qs + 64 * 136; u16* vs = ks + 64 * 136;
  float* Ls = (float*)(smem + 3 * 64 * 136 * 2);
  float* gcs = Ls + 64 * 64; float* betas = gcs + 64; float* egcs = betas + 64;
  const float* cw = p->in[21];
  for (int it = tid; it < 64 * 48; it += 256) {
    const int t = it / 48, cg8 = it - t * 48; const int which = cg8 >> 4, cc = (cg8 & 15) * 8;
    const int ch = which * 512 + h * 128 + cc;
    float acc8[8];
#pragma unroll
    for (int q = 0; q < 8; ++q) acc8[q] = 0.f;
#pragma unroll
    for (int j = 0; j < 4; ++j) {
      const int tt = n * 64 + t - 3 + j; const float mk = tt >= 0 ? 1.f : 0.f;
      {
        const bf16x8 xv = *reinterpret_cast<const bf16x8*>(PJ + (size_t)(b * SEQ + (tt >= 0 ? tt : 0)) * PCOLS + A_COLS + ch);
        const float4 w0 = *reinterpret_cast<const float4*>(cw + j * 1536 + ch), w1 = *reinterpret_cast<const float4*>(cw + j * 1536 + ch + 4);
        const float wv[8] = {w0.x, w0.y, w0.z, w0.w, w1.x, w1.y, w1.z, w1.w};
#pragma unroll
        for (int q = 0; q < 8; ++q) acc8[q] += bf2f((u16)xv[q]) * (wv[q] * mk);
      }
    }
    bf16x8 o;
#pragma unroll
    for (int q = 0; q < 8; ++q) o[q] = (short)f2bf(siluf_(acc8[q]));
    u16* dst = (which == 0 ? qs : (which == 1 ? ks : vs)) + t * 136 + cc;
    *reinterpret_cast<bf16x8*>(dst) = o;
  }
  if (wid == 0) {
    const float* AB = (const float*)(p->ws + OFF_AB) + (size_t)(rowb + lane) * 8;
    const float braw = AB[h], araw = AB[4 + h];
    const float g = -__expf(p->in[22][h]) * softplusf_(araw + p->in[23][h]);
    float c = g;
#pragma unroll
    for (int o = 1; o < 64; o <<= 1) { const float up = __shfl_up(c, o); if (lane >= o) c += up; }
    gcs[lane] = c; betas[lane] = sigmoidf_(braw); egcs[lane] = __expf(c);
  }
  __syncthreads();
  {
    const int r = tid >> 2, part = tid & 3;
#pragma unroll
    for (int w2 = 0; w2 < 2; ++w2) {
      u16* base = (w2 == 0 ? qs : ks) + r * 136 + part * 32;
      float v[32]; float ss = 0.f;
#pragma unroll
      for (int q8 = 0; q8 < 4; ++q8) { const bf16x8 x = *reinterpret_cast<const bf16x8*>(base + q8 * 8);
#pragma unroll
        for (int q = 0; q < 8; ++q) { v[q8 * 8 + q] = bf2f((u16)x[q]); ss += v[q8 * 8 + q] * v[q8 * 8 + q]; } }
      ss = quad_sum(ss);
      const float sc = rsqrtf(ss + 1e-6f) * (w2 == 0 ? 0.08838834764831845f : 1.f);
#pragma unroll
      for (int q8 = 0; q8 < 4; ++q8) { bf16x8 o;
#pragma unroll
        for (int q = 0; q < 8; ++q) o[q] = (short)f2bf(v[q8 * 8 + q] * sc);
        *reinterpret_cast<bf16x8*>(base + q8 * 8) = o; }
    }
  }
  __syncthreads();
  {
    f32x4 aL[4], aQ[4];
#pragma unroll
    for (int nt = 0; nt < 4; ++nt) { aL[nt] = f32x4{0.f, 0.f, 0.f, 0.f}; aQ[nt] = f32x4{0.f, 0.f, 0.f, 0.f}; }
#pragma unroll
    for (int kk = 0; kk < 4; ++kk) {
      const bf16x8 ak = *reinterpret_cast<const bf16x8*>((char*)ks + (wid * 16 + fr) * 272 + kk * 64 + fq * 16);
      const bf16x8 aq = *reinterpret_cast<const bf16x8*>((char*)qs + (wid * 16 + fr) * 272 + kk * 64 + fq * 16);
#pragma unroll
      for (int nt = 0; nt < 4; ++nt) {
        const bf16x8 bk = *reinterpret_cast<const bf16x8*>((char*)ks + (nt * 16 + fr) * 272 + kk * 64 + fq * 16);
        aL[nt] = __builtin_amdgcn_mfma_f32_16x16x32_bf16(ak, bk, aL[nt], 0, 0, 0);
        aQ[nt] = __builtin_amdgcn_mfma_f32_16x16x32_bf16(aq, bk, aQ[nt], 0, 0, 0);
      }
    }
    u16* QK = (u16*)(p->ws + OFF_QK) + (size_t)item * 4096;
#pragma unroll
    for (int nt = 0; nt < 4; ++nt)
#pragma unroll
      for (int j = 0; j < 4; ++j) {
        const int i = wid * 16 + fq * 4 + j, jc = nt * 16 + fr;
        const float dec = (i >= jc) ? __expf(gcs[i] - gcs[jc]) : 0.f;
        Ls[i * 64 + jc] = (i > jc) ? betas[i] * aL[nt][j] * dec : 0.f;
        QK[i * 64 + jc] = f2bf(aQ[nt][j] * dec);
      }
  }
  __syncthreads();
  const size_t ebase = (size_t)((item >> 5) * 8 + (n & 7)) * 8192;
  u16* EUT = (u16*)((unsigned char*)p->out + EO_UT) + ebase; u16* EWN = (u16*)((unsigned char*)p->out + EO_WN) + ebase;
  u16* EQG = (u16*)((unsigned char*)p->out + EO_QG) + ebase; u16* EKD = (u16*)((unsigned char*)p->out + EO_KDT) + ebase;
  {
    float X[64];
    const bool isv = tid < 128; const u16* src = isv ? (vs + tid) : (ks + (tid - 128));
#pragma unroll
    for (int i = 0; i < 64; ++i) { float r = bf2f(src[i * 136]) * betas[i]; if (!isv) r *= egcs[i]; X[i] = r; }
#pragma unroll
    for (int i = 1; i < 64; ++i) {
      float s = X[i];
#pragma unroll
      for (int j4 = 0; j4 < (i + 3) / 4; ++j4) {
        const float4 l = *reinterpret_cast<const float4*>(Ls + i * 64 + j4 * 4);
        s -= l.x * X[4 * j4]; s -= l.y * X[4 * j4 + 1]; s -= l.z * X[4 * j4 + 2]; s -= l.w * X[4 * j4 + 3];
      }
      X[i] = s;
    }
    if (isv) {
#pragma unroll
      for (int q8 = 0; q8 < 8; ++q8) { bf16x8 o;
#pragma unroll
        for (int q = 0; q < 8; ++q) o[q] = (short)f2bf(X[q8 * 8 + q]);
        *reinterpret_cast<bf16x8*>(EUT + tid * 64 + q8 * 8) = o; }
    } else {
#pragma unroll
      for (int i = 0; i < 64; ++i) EWN[i * 128 + (tid - 128)] = f2bf(-X[i]);
    }
  }
  {
    const int i = tid >> 2, k0 = (tid & 3) * 32; const float eg = egcs[i];
#pragma unroll
    for (int q8 = 0; q8 < 4; ++q8) { const bf16x8 x = *reinterpret_cast<const bf16x8*>(qs + i * 136 + k0 + q8 * 8); bf16x8 o;
#pragma unroll
      for (int q = 0; q < 8; ++q) o[q] = (short)f2bf(bf2f((u16)x[q]) * eg);
      *reinterpret_cast<bf16x8*>(EQG + i * 128 + k0 + q8 * 8) = o; }
    const int k = tid >> 1, i0 = (tid & 1) * 32; const float gl = gcs[63];
#pragma unroll
    for (int q8 = 0; q8 < 4; ++q8) { bf16x8 o;
#pragma unroll
      for (int q = 0; q < 8; ++q) { const int ii = i0 + q8 * 8 + q; o[q] = (short)f2bf(bf2f(ks[ii * 136 + k]) * __expf(gl - gcs[ii])); }
      *reinterpret_cast<bf16x8*>(EKD + k * 64 + i0 + q8 * 8) = o; }
    if (tid == 0) ((float*)(p->ws + OFF_GL))[item] = __expf(gl);
  }
  __syncthreads();
}

__device__ __forceinline__ void phase_lora(KP p) {
  const u16* LIN = (const u16*)(p->ws + OFF_LIN);
  constexpr int NRT = MR / 128;
  for (int t = blockIdx.x; t < 3 * 4 * NRT; t += gridDim.x) {
    const int which = t / (4 * NRT), r2 = t - which * 4 * NRT; const int ct = r2 & 3, rt = r2 >> 2;
    const int row0 = rt * 128, col0 = ct * 128;
    f32x4 acc[4][4];
    const u16* A; const u16* Bt; int K; u16* O; const float* bias;
    if (which == 0) { A = LIN; Bt = (const u16*)(p->ws + OFF_W2T); K = 64; O = (u16*)(p->ws + OFF_DE); bias = p->in[11]; }
    else if (which == 1) { A = LIN + 64; Bt = (const u16*)(p->ws + OFF_A2T); K = 64; O = (u16*)(p->ws + OFF_DA); bias = p->in[13]; }
    else { A = LIN + 128; Bt = (const u16*)(p->ws + OFF_G2T); K = 128; O = (u16*)(p->ws + OFF_DG); bias = p->in[13]; }
    gemm_mainloop(A + (size_t)row0 * 256, 256, Bt + (size_t)col0 * K, K, K, acc);
    EPI_COORDS
#pragma unroll
    for (int n = 0; n < 4; ++n) {
      const int col = col0 + wc_ * 64 + n * 16 + fr_; const float bs = bias[col];
#pragma unroll
      for (int m = 0; m < 4; ++m)
#pragma unroll
        for (int j = 0; j < 4; ++j) {
          const int row = row0 + wr_ * 64 + m * 16 + fq_ * 4 + j; float v = acc[m][n][j];
          if (which == 0) { const float z = bs + v; v = __expf(-softplusf_(-z) - 0.5f); }
          else if (which == 1) v = sigmoidf_(bs + v);
          O[(size_t)row * 512 + col] = f2bf(v);
        }
    }
  }
}

struct RwRaw { u16x4 r, k, v, pr, pk, pv, e, a, g; float4 sr, sk, sv; };
template <bool samp>
__device__ __forceinline__ void rwkv_chain(KP p, int seq, int h, bool dry) {
  const int tid = ltid();
  constexpr int T = samp ? 1 : SEQ; const int rowb = samp ? NP + (seq - 8) : seq * SEQ;
  const u16* PJ = (const u16*)(p->ws + OFF_PROJ); u16* DA = (u16*)(p->ws + OFF_DA);
  const u16* DE = (const u16*)(p->ws + OFF_DE); const u16* DG = (const u16*)(p->ws + OFF_DG);
  float* buf = (float*)smem;
  float* ybuf = buf + 2 * 16 * 384;
  const int vrow = tid >> 2, part = tid & 3;
  const int tt = tid >> 4, jg = (tid & 15) * 4, ch = h * 64 + jg;
  float S[16];
  if (samp) { const float* s0 = p->in[5] + ((size_t)(seq - 8) * 8 + h) * 4096 + vrow * 64 + part * 16;
#pragma unroll
    for (int q = 0; q < 4; ++q) { const float4 x = *reinterpret_cast<const float4*>(s0 + q * 4); S[q * 4] = x.x; S[q * 4 + 1] = x.y; S[q * 4 + 2] = x.z; S[q * 4 + 3] = x.w; } }
  else {
#pragma unroll
    for (int q = 0; q < 16; ++q) S[q] = 0.f; }
  const float4 mur = *reinterpret_cast<const float4*>(p->in[10] + ch), muk = *reinterpret_cast<const float4*>(p->in[10] + 512 + ch), muv = *reinterpret_cast<const float4*>(p->in[10] + 1024 + ch);
  const float4 ckk = *reinterpret_cast<const float4*>(p->in[16] + ch), cka = *reinterpret_cast<const float4*>(p->in[17] + ch), crk = *reinterpret_cast<const float4*>(p->in[18] + ch);
  const float4 lnw = *reinterpret_cast<const float4*>(p->in[19] + ch), lnb = *reinterpret_cast<const float4*>(p->in[20] + ch);
  constexpr int nchunks = (T + 15) >> 4;
  auto load_raw = [&](int c, RwRaw& R) {
    const int t = c * 16 + tt;
    if (t < T) {
      const size_t ro = (size_t)(rowb + t) * PCOLS;
      R.r = *reinterpret_cast<const u16x4*>(PJ + ro + ch); R.k = *reinterpret_cast<const u16x4*>(PJ + ro + 512 + ch); R.v = *reinterpret_cast<const u16x4*>(PJ + ro + 1024 + ch);
      if (t > 0) { const size_t po = ro - PCOLS; R.pr = *reinterpret_cast<const u16x4*>(PJ + po + ch); R.pk = *reinterpret_cast<const u16x4*>(PJ + po + 512 + ch); R.pv = *reinterpret_cast<const u16x4*>(PJ + po + 1024 + ch); }
      else if (samp) { const float* sh = p->in[4] + (size_t)(seq - 8) * 1792; R.sr = *reinterpret_cast<const float4*>(sh + ch); R.sk = *reinterpret_cast<const float4*>(sh + 512 + ch); R.sv = *reinterpret_cast<const float4*>(sh + 1024 + ch); }
      const size_t lo = (size_t)(rowb + t) * 512 + ch;
      R.e = *reinterpret_cast<const u16x4*>(DE + lo); R.a = *reinterpret_cast<const u16x4*>(DA + lo); R.g = *reinterpret_cast<const u16x4*>(DG + lo);
    }
  };
  auto prep_write = [&](int c, const RwRaw& R) {
    const int t = c * 16 + tt;
    if (t < T) {
      float r4[4], k4[4], v4[4], pr4[4], pk4[4], pv4[4];
      const float mr[4] = {mur.x, mur.y, mur.z, mur.w}, mk[4] = {muk.x, muk.y, muk.z, muk.w}, mv[4] = {muv.x, muv.y, muv.z, muv.w};
      const float kkc[4] = {ckk.x, ckk.y, ckk.z, ckk.w}, kac[4] = {cka.x, cka.y, cka.z, cka.w};
      if (t > 0) { for (int q = 0; q < 4; ++q) { pr4[q] = bf2f(R.pr[q]); pk4[q] = bf2f(R.pk[q]); pv4[q] = bf2f(R.pv[q]); } }
      else if (samp) { pr4[0] = R.sr.x; pr4[1] = R.sr.y; pr4[2] = R.sr.z; pr4[3] = R.sr.w; pk4[0] = R.sk.x; pk4[1] = R.sk.y; pk4[2] = R.sk.z; pk4[3] = R.sk.w; pv4[0] = R.sv.x; pv4[1] = R.sv.y; pv4[2] = R.sv.z; pv4[3] = R.sv.w; }
      else { for (int q = 0; q < 4; ++q) { pr4[q] = 0.f; pk4[q] = 0.f; pv4[q] = 0.f; } }
      float kr[4], ss = 0.f, a4[4], w4[4];
#pragma unroll
      for (int q = 0; q < 4; ++q) {
        const float cr = bf2f(R.r[q]), ck = bf2f(R.k[q]), cv = bf2f(R.v[q]);
        r4[q] = cr + (pr4[q] - cr) * mr[q]; k4[q] = ck + (pk4[q] - ck) * mk[q]; v4[q] = cv + (pv4[q] - cv) * mv[q];
        kr[q] = k4[q] * kkc[q]; ss += kr[q] * kr[q];
        a4[q] = bf2f(R.a[q]); w4[q] = __expf(-bf2f(R.e[q]));
      }
      ss = sum16(ss);
      const float rn = rsqrtf(ss + 1e-6f);
      float* dst = buf + ((c & 1) * 16 + tt) * 384 + jg;
      float4 o;
      o = make_float4(w4[0], w4[1], w4[2], w4[3]); *reinterpret_cast<float4*>(dst) = o;
      o = make_float4(-kr[0] * rn, -kr[1] * rn, -kr[2] * rn, -kr[3] * rn); *reinterpret_cast<float4*>(dst + 64) = o;
      o = make_float4(kr[0] * rn * a4[0], kr[1] * rn * a4[1], kr[2] * rn * a4[2], kr[3] * rn * a4[3]); *reinterpret_cast<float4*>(dst + 128) = o;
      o = make_float4(k4[0] * (1.f + (a4[0] - 1.f) * kac[0]), k4[1] * (1.f + (a4[1] - 1.f) * kac[1]), k4[2] * (1.f + (a4[2] - 1.f) * kac[2]), k4[3] * (1.f + (a4[3] - 1.f) * kac[3]));
      *reinterpret_cast<float4*>(dst + 192) = o;
      o = make_float4(r4[0], r4[1], r4[2], r4[3]); *reinterpret_cast<float4*>(dst + 256) = o;
      o = make_float4(v4[0], v4[1], v4[2], v4[3]); *reinterpret_cast<float4*>(dst + 320) = o;
    }
  };
  RwRaw R; load_raw(0, R);
  for (int c = 0; c < nchunks; ++c) {
    prep_write(c, R);
    const u16x4 gcur = R.g;
    if (c + 1 < nchunks) load_raw(c + 1, R);
    __syncthreads();
    const int nsteps = min(16, T - c * 16);
    const float* cb = buf + (c & 1) * 16 * 384;
#pragma unroll 2
    for (int s = 0; s < nsteps; ++s) {
      const float* sb = cb + s * 384 + part * 16;
      float w[16], a[16], bb[16], kk[16], rr[16];
#pragma unroll
      for (int q = 0; q < 4; ++q) {
        const float4 x0 = *reinterpret_cast<const float4*>(sb + q * 4); w[q * 4] = x0.x; w[q * 4 + 1] = x0.y; w[q * 4 + 2] = x0.z; w[q * 4 + 3] = x0.w;
        const float4 x1 = *reinterpret_cast<const float4*>(sb + 64 + q * 4); a[q * 4] = x1.x; a[q * 4 + 1] = x1.y; a[q * 4 + 2] = x1.z; a[q * 4 + 3] = x1.w;
        const float4 x2 = *reinterpret_cast<const float4*>(sb + 128 + q * 4); bb[q * 4] = x2.x; bb[q * 4 + 1] = x2.y; bb[q * 4 + 2] = x2.z; bb[q * 4 + 3] = x2.w;
        const float4 x3 = *reinterpret_cast<const float4*>(sb + 192 + q * 4); kk[q * 4] = x3.x; kk[q * 4 + 1] = x3.y; kk[q * 4 + 2] = x3.z; kk[q * 4 + 3] = x3.w;
        const float4 x4 = *reinterpret_cast<const float4*>(sb + 256 + q * 4); rr[q * 4] = x4.x; rr[q * 4 + 1] = x4.y; rr[q * 4 + 2] = x4.z; rr[q * 4 + 3] = x4.w;
      }
      const float vv = cb[s * 384 + 320 + vrow];
      float s0 = 0.f, s1 = 0.f, s2 = 0.f, s3 = 0.f;
#pragma unroll
      for (int q = 0; q < 4; ++q) { s0 += S[q * 4] * a[q * 4]; s1 += S[q * 4 + 1] * a[q * 4 + 1]; s2 += S[q * 4 + 2] * a[q * 4 + 2]; s3 += S[q * 4 + 3] * a[q * 4 + 3]; }
      const float sa = quad_sum((s0 + s1) + (s2 + s3));
      float y0 = 0.f, y1 = 0.f, y2 = 0.f, y3 = 0.f;
#pragma unroll
      for (int q = 0; q < 16; ++q) S[q] = fmaf(sa, bb[q], fmaf(S[q], w[q], vv * kk[q]));
#pragma unroll
      for (int q = 0; q < 4; ++q) { y0 += S[q * 4] * rr[q * 4]; y1 += S[q * 4 + 1] * rr[q * 4 + 1]; y2 += S[q * 4 + 2] * rr[q * 4 + 2]; y3 += S[q * 4 + 3] * rr[q * 4 + 3]; }
      const float y = quad_sum((y0 + y1) + (y2 + y3));
      if (part == 0) ybuf[s * 64 + vrow] = y;
    }
    __syncthreads();
    {
      const int t = c * 16 + tt;
      if (t < T) {
        const float4 y4 = *reinterpret_cast<const float4*>(ybuf + tt * 64 + jg);
        const float* tb = cb + tt * 384 + jg;
        const float4 kq = *reinterpret_cast<const float4*>(tb + 192), rq = *reinterpret_cast<const float4*>(tb + 256), vq = *reinterpret_cast<const float4*>(tb + 320);
        const float mean = sum16(y4.x + y4.y + y4.z + y4.w) * (1.f / 64.f);
        const float d0 = y4.x - mean, d1 = y4.y - mean, d2 = y4.z - mean, d3 = y4.w - mean;
        const float var = sum16(d0 * d0 + d1 * d1 + d2 * d2 + d3 * d3) * (1.f / 64.f);
        const float rstd = rsqrtf(var + GN_EPS);
        const float dot = sum16(rq.x * kq.x * crk.x + rq.y * kq.y * crk.y + rq.z * kq.z * crk.z + rq.w * kq.w * crk.w);
        u16x4 o;
        o[0] = f2bf((d0 * rstd * lnw.x + lnb.x + dot * vq.x) * bf2f(gcur[0]));
        o[1] = f2bf((d1 * rstd * lnw.y + lnb.y + dot * vq.y) * bf2f(gcur[1]));
        o[2] = f2bf((d2 * rstd * lnw.z + lnb.z + dot * vq.z) * bf2f(gcur[2]));
        o[3] = f2bf((d3 * rstd * lnw.w + lnb.w + dot * vq.w) * bf2f(gcur[3]));
        *reinterpret_cast<u16x4*>((dry ? (u16*)(p->ws + OFF_LIN) : DA) + (size_t)((rowb + t) & (dry ? 8191 : 0xffffff)) * 512 + ch) = o;
      }
    }
  }
  {
    float* so = p->out + (samp ? OUT_WKV_S + ((size_t)(seq - 8) * 8 + h) * 4096 : OUT_WKV_P + ((size_t)seq * 8 + h) * 4096) + vrow * 64 + part * 16;
#pragma unroll
    for (int q = 0; q < 4; ++q) *reinterpret_cast<float4*>(so + q * 4) = make_float4(S[q * 4], S[q * 4 + 1], S[q * 4 + 2], S[q * 4 + 3]);
  }
  __syncthreads();
}

constexpr int RW_REC = 35328;
constexpr int RO_WA = 0, RO_RT = 4096, RO_UVT = 8192, RO_YVT = 12288, RO_BHT = 16384, RO_VT = 20480, RO_SV = 24576, RO_ARB = 32768, RO_PC = 34816, RO_DOT = 35072;
#define RWC_CARVE(L) \
  u16* At = (u16*)(L);\
  u16* Rt = (u16*)(L + 4608);\
  u16* Bt = (u16*)(L + 9216);\
  u16* Kt = (u16*)(L + 13824);\
  u16* Aak = (u16*)(L + 9216);\
  u16* Ark = (u16*)(L + 11776); \
  u16* Arb = (u16*)(L + 14336); \
  u16* VT = (u16*)(L + 18432);\
  u16* KHT = (u16*)(L + 23552);\
  float* Af = (float*)(L + 33792);\
  float* AV = (float*)(L + 41984);\
  float* Ls = (float*)(L + 50176);\
  float* rn = (float*)(L + 68608); float* dots = rn + 32; float* gtot = dots + 32; float* cst = gtot + 256;

__device__ __forceinline__ void rwkv_prep_item(KP p, int chain, int n, unsigned char* rec) {
  int tl = threadIdx.x; asm volatile("" : "+v"(tl));
  const int tid = tl, lane = tid & 63, w = tid >> 6, fr = lane & 15, fq = lane >> 4;
  const int i2 = tid >> 3, c0 = (tid & 7) * 8, mi = w >> 1, nt0 = (w & 1) * 2;
  const int b = chain >> 3, h = chain & 7;
  unsigned char* L = smem; RWC_CARVE(L)
  const int rowb = b * SEQ + n * 32, ch = h * 64 + lane;
  const u16* PJ = (const u16*)(p->ws + OFF_PROJ); const u16* DA = (const u16*)(p->ws + OFF_DA); const u16* DE = (const u16*)(p->ws + OFF_DE);
  const float mur = p->in[10][ch], muk = p->in[10][512 + ch], muv = p->in[10][1024 + ch];
  const float kkc = p->in[16][ch], kac = p->in[17][ch];
  float c_mr[8], c_mk[8], c_kk[8], c_ka[8], c_rk[8];
  { const int cc = h * 64 + c0;
    const float4 a0 = *reinterpret_cast<const float4*>(p->in[10] + cc), a1 = *reinterpret_cast<const float4*>(p->in[10] + cc + 4);
    const float4 b0 = *reinterpret_cast<const float4*>(p->in[10] + 512 + cc), b1 = *reinterpret_cast<const float4*>(p->in[10] + 512 + cc + 4);
    const float4 d0 = *reinterpret_cast<const float4*>(p->in[16] + cc), d1 = *reinterpret_cast<const float4*>(p->in[16] + cc + 4);
    const float4 e0 = *reinterpret_cast<const float4*>(p->in[17] + cc), e1 = *reinterpret_cast<const float4*>(p->in[17] + cc + 4);
    const float4 f0 = *reinterpret_cast<const float4*>(p->in[18] + cc), f1 = *reinterpret_cast<const float4*>(p->in[18] + cc + 4);
    c_mr[0] = a0.x; c_mr[1] = a0.y; c_mr[2] = a0.z; c_mr[3] = a0.w; c_mr[4] = a1.x; c_mr[5] = a1.y; c_mr[6] = a1.z; c_mr[7] = a1.w;
    c_mk[0] = b0.x; c_mk[1] = b0.y; c_mk[2] = b0.z; c_mk[3] = b0.w; c_mk[4] = b1.x; c_mk[5] = b1.y; c_mk[6] = b1.z; c_mk[7] = b1.w;
    c_kk[0] = d0.x; c_kk[1] = d0.y; c_kk[2] = d0.z; c_kk[3] = d0.w; c_kk[4] = d1.x; c_kk[5] = d1.y; c_kk[6] = d1.z; c_kk[7] = d1.w;
    c_ka[0] = e0.x; c_ka[1] = e0.y; c_ka[2] = e0.z; c_ka[3] = e0.w; c_ka[4] = e1.x; c_ka[5] = e1.y; c_ka[6] = e1.z; c_ka[7] = e1.w;
    c_rk[0] = f0.x; c_rk[1] = f0.y; c_rk[2] = f0.z; c_rk[3] = f0.w; c_rk[4] = f1.x; c_rk[5] = f1.y; c_rk[6] = f1.z; c_rk[7] = f1.w; }
  bf16x8 cr8, ck8, pr8, pk8, a8; u16 rr[9], rk[9], rv[9], re[8], ra[8];
  { const int t = n * 32 + i2; const size_t ro = (size_t)(rowb + i2) * PCOLS + h * 64 + c0;
    cr8 = *reinterpret_cast<const bf16x8*>(PJ + ro); ck8 = *reinterpret_cast<const bf16x8*>(PJ + ro + 512);
    const size_t rop = t > 0 ? ro - PCOLS : ro;
    pr8 = *reinterpret_cast<const bf16x8*>(PJ + rop); pk8 = *reinterpret_cast<const bf16x8*>(PJ + rop + 512);
    if (t == 0) { pr8 = bf16x8{0, 0, 0, 0, 0, 0, 0, 0}; pk8 = pr8; }
    a8 = *reinterpret_cast<const bf16x8*>(DA + (size_t)(rowb + i2) * 512 + h * 64 + c0); }
#pragma unroll
  for (int q = 0; q < 9; ++q) { const int i = w * 8 - 1 + q; const bool ok = (n * 32 + i) >= 0;
    const size_t ro = (size_t)(rowb + (ok ? i : 0)) * PCOLS + ch; rr[q] = PJ[ro]; rk[q] = PJ[ro + 512]; rv[q] = PJ[ro + 1024];
    if (!ok) { rr[q] = 0; rk[q] = 0; rv[q] = 0; } }
#pragma unroll
  for (int q = 0; q < 8; ++q) { const size_t lo = (size_t)(rowb + w * 8 + q) * 512 + ch; re[q] = DE[lo]; ra[q] = DA[lo]; }
  __syncthreads();
  {
    float ss = 0.f, dt = 0.f;
#pragma unroll
    for (int q = 0; q < 8; ++q) {
      const float cr = bf2f((u16)cr8[q]), ck = bf2f((u16)ck8[q]);
      const float r = cr + (bf2f((u16)pr8[q]) - cr) * c_mr[q], k = ck + (bf2f((u16)pk8[q]) - ck) * c_mk[q];
      const float a = bf2f((u16)a8[q]); const float kr = k * c_kk[q];
      ss += kr * kr; dt += r * k * (1.f + (a - 1.f) * c_ka[q]) * c_rk[q];
    }
    ss += __shfl_xor(ss, 1); dt += __shfl_xor(dt, 1); ss += __shfl_xor(ss, 2); dt += __shfl_xor(dt, 2); ss += __shfl_xor(ss, 4); dt += __shfl_xor(dt, 4);
    if ((tid & 7) == 0) { rn[i2] = rsqrtf(ss + 1e-6f); dots[i2] = dt; ((float*)(rec + RO_DOT))[i2] = dt; }
  }
  float lsum = 0.f;
#pragma unroll
  for (int q = 0; q < 8; ++q) lsum -= bf2f(re[q]);
  gtot[w * 64 + lane] = lsum;
  __syncthreads();
  {
    const float g0 = gtot[lane], g1 = gtot[64 + lane], g2 = gtot[128 + lane], g3 = gtot[192 + lane];
    const float Ltot = (g0 + g1) + (g2 + g3);
    const float off = (w > 0 ? g0 : 0.f) + (w > 1 ? g1 : 0.f) + (w > 2 ? g2 : 0.f);
    if (w == 0) ((float*)(rec + RO_PC))[lane] = __expf(Ltot);
    float run = 0.f; bf16x8 vp, khp, bhp;
    u16* RTg = (u16*)(rec + RO_RT);
#pragma unroll
    for (int q = 0; q < 8; ++q) {
      const int i = w * 8 + q;
      const float cr = bf2f(rr[q + 1]), ck = bf2f(rk[q + 1]), cv = bf2f(rv[q + 1]);
      const float r = cr + (bf2f(rr[q]) - cr) * mur, k = ck + (bf2f(rk[q]) - ck) * muk, v = cv + (bf2f(rv[q]) - cv) * muv;
      const float e = bf2f(re[q]), a = bf2f(ra[q]);
      run -= e; const float Lc = off + run, Lp = Lc + e;
      const float kk = k * kkc * rn[i]; const float ain = -kk, bin = kk * a, kp = k * (1.f + (a - 1.f) * kac);
      const float eP = __expf(Lp), eC = __expf(Lc), eN = __expf(-Lc), eT = __expf(Ltot - Lc);
      const float at = ain * eP; const u16 rt = f2bf(r * eC);
      At[i * 72 + lane] = f2bf(at); Af[i * 64 + lane] = at; Rt[i * 72 + lane] = rt; RTg[i * 64 + lane] = rt;
      Bt[i * 72 + lane] = f2bf(bin * eN); Kt[i * 72 + lane] = f2bf(kp * eN);
      vp[q] = (short)f2bf(v); khp[q] = (short)f2bf(kp * eT); bhp[q] = (short)f2bf(bin * eT);
    }
    *reinterpret_cast<bf16x8*>((char*)VT + lane * 80 + w * 16) = vp;
    *reinterpret_cast<bf16x8*>((char*)KHT + lane * 80 + w * 16) = khp;
    *reinterpret_cast<bf16x8*>(rec + RO_VT + lane * 64 + w * 16) = vp;
    *reinterpret_cast<bf16x8*>(rec + RO_BHT + lane * 64 + w * 16) = bhp;
  }
  __syncthreads();
  {
    f32x4 cab = {0.f, 0.f, 0.f, 0.f}, cak = cab, crb = cab, crk = cab;
#pragma unroll
    for (int ks = 0; ks < 2; ++ks) {
      const bf16x8 fa = *reinterpret_cast<const bf16x8*>((char*)At + (mi * 16 + fr) * 144 + ks * 64 + fq * 16);
      const bf16x8 fr_ = *reinterpret_cast<const bf16x8*>((char*)Rt + (mi * 16 + fr) * 144 + ks * 64 + fq * 16);
      const bf16x8 fb = *reinterpret_cast<const bf16x8*>((char*)Bt + ((w & 1) * 16 + fr) * 144 + ks * 64 + fq * 16);
      const bf16x8 fk = *reinterpret_cast<const bf16x8*>((char*)Kt + ((w & 1) * 16 + fr) * 144 + ks * 64 + fq * 16);
      cab = __builtin_amdgcn_mfma_f32_16x16x32_bf16(fa, fb, cab, 0, 0, 0);
      cak = __builtin_amdgcn_mfma_f32_16x16x32_bf16(fa, fk, cak, 0, 0, 0);
      crb = __builtin_amdgcn_mfma_f32_16x16x32_bf16(fr_, fb, crb, 0, 0, 0);
      crk = __builtin_amdgcn_mfma_f32_16x16x32_bf16(fr_, fk, crk, 0, 0, 0);
    }
    __syncthreads();
    u16* ARBg = (u16*)(rec + RO_ARB);
#pragma unroll
    for (int jj = 0; jj < 4; ++jj) {
      const int i = mi * 16 + fq * 4 + jj, s = (w & 1) * 16 + fr;
      Ls[s * 32 + i] = (s < i) ? cab[jj] : 0.f;
      Aak[i * 40 + s] = f2bf((s < i) ? cak[jj] : 0.f);
      ARBg[i * 32 + s] = f2bf((s <= i) ? crb[jj] : 0.f);
      Ark[i * 40 + s] = f2bf((s <= i) ? crk[jj] : 0.f);
    }
  }
  __syncthreads();
  {
    const bf16x8 faak = *reinterpret_cast<const bf16x8*>((char*)Aak + (mi * 16 + fr) * 80 + fq * 16);
    const bf16x8 fark = *reinterpret_cast<const bf16x8*>((char*)Ark + (mi * 16 + fr) * 80 + fq * 16);
    const bf16x8 fkh = *reinterpret_cast<const bf16x8*>((char*)KHT + (w * 16 + fr) * 80 + fq * 16);
    const f32x4 z4 = {0.f, 0.f, 0.f, 0.f};
#pragma unroll
    for (int nt = 0; nt < 4; ++nt) {
      const bf16x8 vb = *reinterpret_cast<const bf16x8*>((char*)VT + (nt * 16 + fr) * 80 + fq * 16);
      const f32x4 sv = __builtin_amdgcn_mfma_f32_16x16x32_bf16(fkh, vb, z4, 0, 0, 0);
      { u16x4 o; o[0] = f2bf(sv[0]); o[1] = f2bf(sv[1]); o[2] = f2bf(sv[2]); o[3] = f2bf(sv[3]);
        *reinterpret_cast<u16x4*>(rec + RO_SV + (nt * 16 + fr) * 128 + (w * 16 + fq * 4) * 2) = o; }
      if (nt == nt0 || nt == nt0 + 1) {
        const f32x4 av = __builtin_amdgcn_mfma_f32_16x16x32_bf16(faak, vb, z4, 0, 0, 0);
        const f32x4 yv = __builtin_amdgcn_mfma_f32_16x16x32_bf16(fark, vb, z4, 0, 0, 0);
#pragma unroll
        for (int jj = 0; jj < 4; ++jj) AV[(mi * 16 + fq * 4 + jj) * 64 + nt * 16 + fr] = av[jj];
        u16x4 o; o[0] = f2bf(yv[0]); o[1] = f2bf(yv[1]); o[2] = f2bf(yv[2]); o[3] = f2bf(yv[3]);
        *reinterpret_cast<u16x4*>(rec + RO_YVT + (nt * 16 + fr) * 64 + (mi * 16 + fq * 4) * 2) = o;
      }
    }
  }
  __syncthreads();
  if (tid < 128) {
    float* xc = tid < 64 ? (Af + tid) : (AV + (tid - 64));
#pragma unroll 1
    for (int i0 = 0; i0 < 32; i0 += 8) {
      float acc[8];
#pragma unroll
      for (int r = 0; r < 8; ++r) acc[r] = xc[(i0 + r) * 64];
#pragma unroll 2
      for (int j = 0; j < i0; ++j) {
        const float xj = xc[j * 64];
        const float4 l0 = *reinterpret_cast<const float4*>(Ls + j * 32 + i0), l1 = *reinterpret_cast<const float4*>(Ls + j * 32 + i0 + 4);
        acc[0] += l0.x * xj; acc[1] += l0.y * xj; acc[2] += l0.z * xj; acc[3] += l0.w * xj;
        acc[4] += l1.x * xj; acc[5] += l1.y * xj; acc[6] += l1.z * xj; acc[7] += l1.w * xj;
      }
#pragma unroll
      for (int r2 = 0; r2 < 7; ++r2) {
        const float4 l0 = *reinterpret_cast<const float4*>(Ls + (i0 + r2) * 32 + i0), l1 = *reinterpret_cast<const float4*>(Ls + (i0 + r2) * 32 + i0 + 4);
        const float lv[8] = {l0.x, l0.y, l0.z, l0.w, l1.x, l1.y, l1.z, l1.w};
#pragma unroll
        for (int r = r2 + 1; r < 8; ++r) acc[r] += lv[r] * acc[r2];
      }
#pragma unroll
      for (int r = 0; r < 8; ++r) xc[(i0 + r) * 64] = acc[r];
    }
    if (tid < 64) {
      u16* WAg = (u16*)(rec + RO_WA);
#pragma unroll 4
      for (int i = 0; i < 32; ++i) WAg[i * 64 + tid] = f2bf(xc[i * 64]);
    } else {
#pragma unroll
      for (int q8 = 0; q8 < 4; ++q8) { bf16x8 o;
#pragma unroll
        for (int q = 0; q < 8; ++q) o[q] = (short)f2bf(xc[(q8 * 8 + q) * 64]);
        *reinterpret_cast<bf16x8*>(rec + RO_UVT + (tid - 64) * 64 + q8 * 16) = o; }
    }
  }
  __syncthreads();
}

struct RwRec { bf16x8 wa[2], rt[2], arb, bh, vt; u16x4 uv[2], yv[2], sv[4]; float4 pc; float4 d0, d1; u16 g[8]; };
__device__ __forceinline__ void rwkv_scan_seg(KP p, int chain, int seg, const unsigned char* recs, bool dry) {
  int tl = threadIdx.x; asm volatile("" : "+v"(tl));
  const int tid = tl, lane = tid & 63, w = tid >> 6, fr = lane & 15, fq = lane >> 4;
  const int i2 = tid >> 3, c0 = (tid & 7) * 8, mi = w >> 1, nt0 = (w & 1) * 2;
  const int b = chain >> 3, h = chain & 7, ch = h * 64 + lane;
  u16* St = (u16*)(smem);
  u16* Dt = (u16*)(smem + 9216);
  float* Ys = (float*)(smem + 14336);
  float* stat = (float*)(smem + 22528);
  u16* DA = (u16*)(p->ws + OFF_DA); const u16* DG = (const u16*)(p->ws + OFF_DG);
  const float lnw = p->in[19][ch], lnb = p->in[20][ch];
  float* so = p->out + OUT_WKV_P + (size_t)chain * 4096;
  f32x4 Sacc[4];
  const float keep = seg == 0 ? 0.f : 1.f;
#pragma unroll
  for (int nt = 0; nt < 4; ++nt) {
#pragma unroll
    for (int jj = 0; jj < 4; ++jj) Sacc[nt][jj] = fminf(fmaxf(so[(nt * 16 + fr) * 64 + w * 16 + fq * 4 + jj], -3e38f), 3e38f) * keep;
    u16x4 o; o[0] = f2bf(Sacc[nt][0]); o[1] = f2bf(Sacc[nt][1]); o[2] = f2bf(Sacc[nt][2]); o[3] = f2bf(Sacc[nt][3]);
    *reinterpret_cast<u16x4*>((char*)St + (nt * 16 + fr) * 144 + (w * 16 + fq * 4) * 2) = o;
  }
  auto load_rec = [&](int c, RwRec& R) {
    int cl = c; asm volatile("" : "+s"(cl));
    int ty = threadIdx.x; asm volatile("" : "+v"(ty));
    const int lane = ty & 63, w = ty >> 6, fr = lane & 15, fq = lane >> 4, mi = w >> 1, nt0 = (w & 1) * 2, ch = h * 64 + lane;
    const unsigned char* rec = recs + (size_t)(chain * 16 + cl) * RW_REC;
#pragma unroll
    for (int ks = 0; ks < 2; ++ks) {
      R.wa[ks] = *reinterpret_cast<const bf16x8*>(rec + RO_WA + (mi * 16 + fr) * 128 + ks * 64 + fq * 16);
      R.rt[ks] = *reinterpret_cast<const bf16x8*>(rec + RO_RT + (mi * 16 + fr) * 128 + ks * 64 + fq * 16);
    }
    R.arb = *reinterpret_cast<const bf16x8*>(rec + RO_ARB + (mi * 16 + fr) * 64 + fq * 16);
    R.bh = *reinterpret_cast<const bf16x8*>(rec + RO_BHT + (w * 16 + fr) * 64 + fq * 16);
    R.vt = *reinterpret_cast<const bf16x8*>(rec + RO_VT + lane * 64 + w * 16);
#pragma unroll
    for (int q2 = 0; q2 < 2; ++q2) {
      R.uv[q2] = *reinterpret_cast<const u16x4*>(rec + RO_UVT + ((nt0 + q2) * 16 + fr) * 64 + (mi * 16 + fq * 4) * 2);
      R.yv[q2] = *reinterpret_cast<const u16x4*>(rec + RO_YVT + ((nt0 + q2) * 16 + fr) * 64 + (mi * 16 + fq * 4) * 2);
    }
#pragma unroll
    for (int nt = 0; nt < 4; ++nt) R.sv[nt] = *reinterpret_cast<const u16x4*>(rec + RO_SV + (nt * 16 + fr) * 128 + (w * 16 + fq * 4) * 2);
    R.pc = *reinterpret_cast<const float4*>(rec + RO_PC + (w * 16 + fq * 4) * 4);
    R.d0 = *reinterpret_cast<const float4*>(rec + RO_DOT + w * 32); R.d1 = *reinterpret_cast<const float4*>(rec + RO_DOT + w * 32 + 16);
    const size_t rowg = (size_t)(b * SEQ + (seg * 16 + cl) * 32 + w * 8);
#pragma unroll
    for (int q = 0; q < 8; ++q) R.g[q] = DG[(rowg + q) * 512 + ch];
  };
  RwRec R; load_rec(0, R);
  __syncthreads();
  for (int c = 0; c < 16; ++c) {
    int cq = c; asm volatile("" : "+s"(cq));
    int tz = threadIdx.x; asm volatile("" : "+v"(tz));
    const int lane = tz & 63, w = tz >> 6, fr = lane & 15, fq = lane >> 4, i2 = tz >> 3, c0 = (tz & 7) * 8, mi = w >> 1, nt0 = (w & 1) * 2;
    f32x4 Dacc[2], Yacc[2];
#pragma unroll
    for (int q2 = 0; q2 < 2; ++q2) {
      Dacc[q2] = f32x4{bf2f(R.uv[q2][0]), bf2f(R.uv[q2][1]), bf2f(R.uv[q2][2]), bf2f(R.uv[q2][3])};
      Yacc[q2] = f32x4{bf2f(R.yv[q2][0]), bf2f(R.yv[q2][1]), bf2f(R.yv[q2][2]), bf2f(R.yv[q2][3])};
    }
#pragma unroll
    for (int ks = 0; ks < 2; ++ks)
#pragma unroll
      for (int q2 = 0; q2 < 2; ++q2) {
        const bf16x8 sb = *reinterpret_cast<const bf16x8*>((char*)St + ((nt0 + q2) * 16 + fr) * 144 + ks * 64 + fq * 16);
        Dacc[q2] = __builtin_amdgcn_mfma_f32_16x16x32_bf16(R.wa[ks], sb, Dacc[q2], 0, 0, 0);
        Yacc[q2] = __builtin_amdgcn_mfma_f32_16x16x32_bf16(R.rt[ks], sb, Yacc[q2], 0, 0, 0);
      }
#pragma unroll
    for (int q2 = 0; q2 < 2; ++q2) {
      u16x4 o; o[0] = f2bf(Dacc[q2][0]); o[1] = f2bf(Dacc[q2][1]); o[2] = f2bf(Dacc[q2][2]); o[3] = f2bf(Dacc[q2][3]);
      *reinterpret_cast<u16x4*>((char*)Dt + ((nt0 + q2) * 16 + fr) * 80 + (mi * 16 + fq * 4) * 2) = o;
    }
    __syncthreads();
    const float pc[4] = {R.pc.x, R.pc.y, R.pc.z, R.pc.w};
#pragma unroll
    for (int nt = 0; nt < 4; ++nt) {
      const bf16x8 db = *reinterpret_cast<const bf16x8*>((char*)Dt + (nt * 16 + fr) * 80 + fq * 16);
      if (nt == nt0 || nt == nt0 + 1) Yacc[nt - nt0] = __builtin_amdgcn_mfma_f32_16x16x32_bf16(R.arb, db, Yacc[nt - nt0], 0, 0, 0);
#pragma unroll
      for (int jj = 0; jj < 4; ++jj) Sacc[nt][jj] = Sacc[nt][jj] * pc[jj] + bf2f(R.sv[nt][jj]);
      Sacc[nt] = __builtin_amdgcn_mfma_f32_16x16x32_bf16(R.bh, db, Sacc[nt], 0, 0, 0);
      u16x4 o; o[0] = f2bf(Sacc[nt][0]); o[1] = f2bf(Sacc[nt][1]); o[2] = f2bf(Sacc[nt][2]); o[3] = f2bf(Sacc[nt][3]);
      *reinterpret_cast<u16x4*>((char*)St + (nt * 16 + fr) * 144 + (w * 16 + fq * 4) * 2) = o;
    }
#pragma unroll
    for (int q2 = 0; q2 < 2; ++q2)
#pragma unroll
      for (int jj = 0; jj < 4; ++jj) Ys[(mi * 16 + fq * 4 + jj) * 64 + (nt0 + q2) * 16 + fr] = Yacc[q2][jj];
    const bf16x8 vt = R.vt; const float dd[8] = {R.d0.x, R.d0.y, R.d0.z, R.d0.w, R.d1.x, R.d1.y, R.d1.z, R.d1.w};
    u16 gq[8];
#pragma unroll
    for (int q = 0; q < 8; ++q) gq[q] = R.g[q];
    if (c + 1 < 16) load_rec(c + 1, R);
    __syncthreads();
    {
      const float4 y0 = *reinterpret_cast<const float4*>(Ys + i2 * 64 + c0), y1 = *reinterpret_cast<const float4*>(Ys + i2 * 64 + c0 + 4);
      float sm = (y0.x + y0.y + y0.z + y0.w) + (y1.x + y1.y + y1.z + y1.w);
      sm += __shfl_xor(sm, 1); sm += __shfl_xor(sm, 2); sm += __shfl_xor(sm, 4);
      const float mean = sm * (1.f / 64.f);
      float d, vs = 0.f;
      d = y0.x - mean; vs += d * d; d = y0.y - mean; vs += d * d; d = y0.z - mean; vs += d * d; d = y0.w - mean; vs += d * d;
      d = y1.x - mean; vs += d * d; d = y1.y - mean; vs += d * d; d = y1.z - mean; vs += d * d; d = y1.w - mean; vs += d * d;
      vs += __shfl_xor(vs, 1); vs += __shfl_xor(vs, 2); vs += __shfl_xor(vs, 4);
      if ((tz & 7) == 0) { stat[i2 * 2] = mean; stat[i2 * 2 + 1] = rsqrtf(vs * (1.f / 64.f) + GN_EPS); }
    }
    __syncthreads();
    const size_t rowo = (size_t)(b * SEQ + (seg * 16 + cq) * 32 + w * 8);
#pragma unroll
    for (int q = 0; q < 8; ++q) {
      const int i = w * 8 + q;
      const float yn = (Ys[i * 64 + lane] - stat[i * 2]) * stat[i * 2 + 1];
      (dry ? (u16*)(p->ws + OFF_LIN) : DA)[((rowo + q) & (dry ? 8191 : 0xffffff)) * 512 + h * 64 + lane] = f2bf((yn * lnw + lnb + dd[q] * bf2f((u16)vt[q])) * bf2f(gq[q]));
    }
  }
  if (!dry) {
#pragma unroll
  for (int nt = 0; nt < 4; ++nt)
#pragma unroll
    for (int jj = 0; jj < 4; ++jj) so[(nt * 16 + fr) * 64 + w * 16 + fq * 4 + jj] = Sacc[nt][jj];
  }
}

__device__ __forceinline__ void gdn_scan_chain(KP p, int b, int h, int seg, bool dry) {
  const int tid = ltid(), lane = tid & 63, w = tid >> 6, fr = lane & 15, fq = lane >> 4;
  unsigned char* St = smem;
  unsigned char* Vt = smem + 128 * 272;
  u16* ORAW = dry ? (u16*)(p->ws + OFF_LIN) : (u16*)(p->ws + OFF_DE);
  f32x4 Sacc[2][8];
  float* so = p->out + OUT_GDN_P + ((size_t)b * 4 + h) * 16384;
  const float keep = seg == 0 ? 0.f : 1.f;
#pragma unroll
  for (int m = 0; m < 2; ++m) {
    const float* sbm = so + (w * 32 + m * 16 + fq * 4) * 128 + fr;
#pragma unroll
    for (int nt = 0; nt < 8; ++nt) {
#pragma unroll
      for (int j = 0; j < 4; ++j) Sacc[m][nt][j] = fminf(fmaxf(sbm[j * 128 + nt * 16], -3e38f), 3e38f) * keep;
      u16x4 o; o[0] = f2bf(Sacc[m][nt][0]); o[1] = f2bf(Sacc[m][nt][1]); o[2] = f2bf(Sacc[m][nt][2]); o[3] = f2bf(Sacc[m][nt][3]);
      *reinterpret_cast<u16x4*>(St + (nt * 16 + fr) * 272 + (w * 32 + m * 16 + fq * 4) * 2) = o;
    }
  }
  bf16x8 wn[4], qg[4], qk[2], kd[2][2]; u16x4 un[8]; float gl;
  auto loadA = [&](int n_) {
    int n = n_; asm volatile("" : "+s"(n));
    const int t = ltid(), ln = t & 63, w_ = t >> 6, fr_ = ln & 15, fq_ = ln >> 4;
    const size_t eb = (size_t)((b * 4 + h) * 8 + (n & 7)) * 8192;
    const u16* EWN = (const u16*)((const unsigned char*)p->out + EO_WN) + eb;
    const u16* EQG = (const u16*)((const unsigned char*)p->out + EO_QG) + eb;
#pragma unroll
    for (int kk = 0; kk < 4; ++kk) { wn[kk] = *reinterpret_cast<const bf16x8*>(EWN + (w_ * 16 + fr_) * 128 + kk * 32 + fq_ * 8); qg[kk] = *reinterpret_cast<const bf16x8*>(EQG + (w_ * 16 + fr_) * 128 + kk * 32 + fq_ * 8); }
  };
  auto loadU = [&](int n_) {
    int n = n_; asm volatile("" : "+s"(n));
    const int t = ltid(), ln = t & 63, w_ = t >> 6, fr_ = ln & 15, fq_ = ln >> 4;
    const size_t eb = (size_t)((b * 4 + h) * 8 + (n & 7)) * 8192;
    const u16* EUT = (const u16*)((const unsigned char*)p->out + EO_UT) + eb;
#pragma unroll
    for (int nt = 0; nt < 8; ++nt) un[nt] = *reinterpret_cast<const u16x4*>(EUT + (nt * 16 + fr_) * 64 + w_ * 16 + fq_ * 4);
  };
  auto loadB = [&](int n_) {
    int n = n_; asm volatile("" : "+s"(n));
    const int t = ltid(), ln = t & 63, w_ = t >> 6, fr_ = ln & 15, fq_ = ln >> 4;
    const int item = (b * 4 + h) * 32 + n; const size_t eb = (size_t)((b * 4 + h) * 8 + (n & 7)) * 8192;
    const u16* EKD = (const u16*)((const unsigned char*)p->out + EO_KDT) + eb; const u16* QK = (const u16*)(p->ws + OFF_QK) + (size_t)item * 4096;
    gl = ((const float*)(p->ws + OFF_GL))[item];
#pragma unroll
    for (int k2 = 0; k2 < 2; ++k2) { qk[k2] = *reinterpret_cast<const bf16x8*>(QK + (w_ * 16 + fr_) * 64 + k2 * 32 + fq_ * 8);
#pragma unroll
      for (int m = 0; m < 2; ++m) kd[m][k2] = *reinterpret_cast<const bf16x8*>(EKD + (w_ * 32 + m * 16 + fr_) * 64 + k2 * 32 + fq_ * 8); }
  };
  loadA(seg * 8); loadU(seg * 8); loadB(seg * 8);
  __syncthreads();
  for (int n = seg * 8; n < seg * 8 + 8; ++n) {
    f32x4 Oacc[8];
#pragma unroll
    for (int nt = 0; nt < 8; ++nt) {
      f32x4 va = f32x4{bf2f(un[nt][0]), bf2f(un[nt][1]), bf2f(un[nt][2]), bf2f(un[nt][3])}; Oacc[nt] = f32x4{0.f, 0.f, 0.f, 0.f};
#pragma unroll
      for (int kk = 0; kk < 4; ++kk) {
        const bf16x8 sb = *reinterpret_cast<const bf16x8*>(St + (nt * 16 + fr) * 272 + kk * 64 + fq * 16);
        va = __builtin_amdgcn_mfma_f32_16x16x32_bf16(wn[kk], sb, va, 0, 0, 0);
        Oacc[nt] = __builtin_amdgcn_mfma_f32_16x16x32_bf16(qg[kk], sb, Oacc[nt], 0, 0, 0);
      }
      u16x4 o; o[0] = f2bf(va[0]); o[1] = f2bf(va[1]); o[2] = f2bf(va[2]); o[3] = f2bf(va[3]);
      *reinterpret_cast<u16x4*>(Vt + (nt * 16 + fr) * 144 + (w * 16 + fq * 4) * 2) = o;
    }
    if (n + 1 < seg * 8 + 8) loadA(n + 1);
    __syncthreads();
    if (n + 1 < seg * 8 + 8) loadU(n + 1);
#pragma unroll
    for (int m = 0; m < 2; ++m)
#pragma unroll
      for (int nt = 0; nt < 8; ++nt) Sacc[m][nt] *= gl;
#pragma unroll
    for (int nt = 0; nt < 8; ++nt)
#pragma unroll
      for (int k2 = 0; k2 < 2; ++k2) {
        const bf16x8 vb = *reinterpret_cast<const bf16x8*>(Vt + (nt * 16 + fr) * 144 + k2 * 64 + fq * 16);
        Oacc[nt] = __builtin_amdgcn_mfma_f32_16x16x32_bf16(qk[k2], vb, Oacc[nt], 0, 0, 0);
        Sacc[0][nt] = __builtin_amdgcn_mfma_f32_16x16x32_bf16(kd[0][k2], vb, Sacc[0][nt], 0, 0, 0);
        Sacc[1][nt] = __builtin_amdgcn_mfma_f32_16x16x32_bf16(kd[1][k2], vb, Sacc[1][nt], 0, 0, 0);
      }
    if (n + 1 < seg * 8 + 8) loadB(n + 1);
#pragma unroll
    for (int m = 0; m < 2; ++m)
#pragma unroll
      for (int nt = 0; nt < 8; ++nt) {
        u16x4 o; o[0] = f2bf(Sacc[m][nt][0]); o[1] = f2bf(Sacc[m][nt][1]); o[2] = f2bf(Sacc[m][nt][2]); o[3] = f2bf(Sacc[m][nt][3]);
        *reinterpret_cast<u16x4*>(St + (nt * 16 + fr) * 272 + (w * 32 + m * 16 + fq * 4) * 2) = o;
      }
    {
      int nq = n; asm volatile("" : "+s"(nq));
#pragma unroll
      for (int j = 0; j < 4; ++j) {
        const int row = b * SEQ + nq * 64 + w * 16 + fq * 4 + j;
        u16* op = ORAW + (size_t)(dry ? (row & 8191) : row) * 512 + h * 128 + fr;
#pragma unroll
        for (int nt = 0; nt < 8; ++nt) op[nt * 16] = f2bf(Oacc[nt][j]);
      }
    }
    __syncthreads();
  }
  if (!dry)
#pragma unroll
  for (int m = 0; m < 2; ++m)
#pragma unroll
    for (int nt = 0; nt < 8; ++nt)
#pragma unroll
      for (int j = 0; j < 4; ++j) so[(w * 32 + m * 16 + fq * 4 + j) * 128 + nt * 16 + fr] = Sacc[m][nt][j];
}

__device__ __forceinline__ void phase_gdn_out(KP p) {
  const int tid = threadIdx.x, lane = tid & 63, gw = blockIdx.x * 4 + (tid >> 6), nw = gridDim.x * 4;
  const u16* ORAW = (const u16*)(p->ws + OFF_DE); u16* PJ = (u16*)(p->ws + OFF_PROJ);
  const float* gnorm = p->in[24] + (lane & 15) * 8;
  const float4 g0 = *reinterpret_cast<const float4*>(gnorm), g1 = *reinterpret_cast<const float4*>(gnorm + 4);
  const float gg[8] = {g0.x, g0.y, g0.z, g0.w, g1.x, g1.y, g1.z, g1.w};
  for (int row = gw; row < NP; row += nw) {
    const bf16x8 o8 = *reinterpret_cast<const bf16x8*>(ORAW + (size_t)row * 512 + lane * 8);
    u16* zp = PJ + (size_t)row * PCOLS + 3328 + lane * 8;
    const bf16x8 z8 = *reinterpret_cast<const bf16x8*>(zp);
    float o[8], ss = 0.f;
#pragma unroll
    for (int q = 0; q < 8; ++q) { o[q] = bf2f((u16)o8[q]); ss += o[q] * o[q]; }
    const float rs = rsqrtf(sum16(ss) * (1.f / 128.f) + NORM_EPS);
    bf16x8 r8;
#pragma unroll
    for (int q = 0; q < 8; ++q) r8[q] = (short)f2bf(o[q] * rs * gg[q] * siluf_(bf2f((u16)z8[q])));
    *reinterpret_cast<bf16x8*>(zp) = r8;
  }
}

__device__ __forceinline__ void gdn_sample_item(KP p, int b, int h, bool dry) {
  const int tid = ltid(), lane = tid & 63;
  float* cs = (float*)smem;
  float* red = cs + 384;
  float* sc = red + 512;
  const int row = NP + b;
  const u16* PJ = (const u16*)(p->ws + OFF_PROJ);
  const float* st = p->in[6] + (size_t)b * 4608; const float* cw = p->in[21];
  for (int i = tid; i < 384; i += 256) {
    const int which = i >> 7, c = i & 127, ch = which * 512 + h * 128 + c;
    float acc = st[ch] * cw[ch] + st[1536 + ch] * cw[1536 + ch] + st[3072 + ch] * cw[3072 + ch] + bf2f(PJ[(size_t)row * PCOLS + A_COLS + ch]) * cw[4608 + ch];
    cs[i] = siluf_(acc);
  }
  __syncthreads();
  if (tid < 128) {
    const int which = tid >> 6;
    const float x0 = cs[which * 128 + lane], x1 = cs[which * 128 + 64 + lane];
    const float ss = sum64(x0 * x0 + x1 * x1);
    const float s = rsqrtf(ss + 1e-6f) * (which == 0 ? 0.08838834764831845f : 1.f);
    cs[which * 128 + lane] = x0 * s; cs[which * 128 + 64 + lane] = x1 * s;
  }
  if (tid == 128) {
    const float* AB = (const float*)(p->ws + OFF_AB) + (size_t)row * 8;
    sc[0] = sigmoidf_(AB[h]); sc[1] = __expf(-__expf(p->in[22][h]) * softplusf_(AB[4 + h] + p->in[23][h]));
  }
  __syncthreads();
  if (tid < 64) { const float d = sum64(cs[lane] * cs[128 + lane] + cs[64 + lane] * cs[192 + lane]); if (lane == 0) sc[2] = d; }
  const int v = tid & 127, kh = tid >> 7;
  const float* S0 = p->in[7] + ((size_t)b * 4 + h) * 16384;
  float S[64]; float ks = 0.f, qs = 0.f;
#pragma unroll
  for (int k = 0; k < 64; ++k) { S[k] = S0[(kh * 64 + k) * 128 + v]; ks += cs[128 + kh * 64 + k] * S[k]; qs += cs[kh * 64 + k] * S[k]; }
  red[kh * 128 + v] = ks; red[256 + kh * 128 + v] = qs;
  __syncthreads();
  const float beta = sc[0], eg = sc[1], qk = sc[2];
  const float kS = red[v] + red[128 + v], qS = red[256 + v] + red[384 + v];
  const float vnew = beta * (cs[256 + v] - eg * kS);
  const float o = eg * qS + qk * vnew;
  float* so = p->out + OUT_GDN_S + ((size_t)b * 4 + h) * 16384;
#pragma unroll
  for (int k = 0; k < 64; ++k) so[(kh * 64 + k) * 128 + v] = S[k] * eg + cs[128 + kh * 64 + k] * vnew;
  __syncthreads();
  if (tid < 128) red[tid] = o * o;
  __syncthreads();
  if (tid < 64) { const float s = sum64(red[lane] + red[64 + lane]); if (lane == 0) sc[3] = s; }
  __syncthreads();
  if (tid < 128) {
    const float rs = rsqrtf(sc[3] * (1.f / 128.f) + NORM_EPS);
    u16* zp = (u16*)(p->ws + OFF_PROJ) + (size_t)row * PCOLS + 3328 + h * 128 + v;
    const float z = bf2f(*zp);
    *(dry ? (u16*)(p->ws + OFF_LIN) + (size_t)(row & 8191) * 512 + h * 128 + v : zp) = f2bf(o * rs * p->in[24][v] * siluf_(z));
  }
  __syncthreads();
}

__device__ __forceinline__ void phase_branches(KP p) {
  constexpr int NRT = MR / 128;
  u16* PA = (u16*)(p->ws + OFF_DE); u16* PB = (u16*)p->out;
  const XTiles XT = xt_make(NRT, 16, 8);
  for (int t = XT.lb; t < XT.total; t += XT.nb) {
    int ct2, rt; xt_get(XT, t, rt, ct2); const int which = ct2 >> 3, ct = ct2 & 7;
    const int row0 = rt * 128, col0 = ct * 128;
    f32x4 acc[4][4];
    if (which == 0) gemm_mainloop((const u16*)(p->ws + OFF_DA) + (size_t)row0 * 512, 512, (const u16*)(p->ws + OFF_WAT) + (size_t)col0 * 512, 512, 512, acc);
    else gemm_mainloop((const u16*)(p->ws + OFF_PROJ) + (size_t)row0 * PCOLS + 3328, PCOLS, (const u16*)(p->ws + OFF_WBT) + (size_t)col0 * 512, 512, 512, acc);
    u16* O = which == 0 ? PA : PB;
    EPI_COORDS
#pragma unroll
    for (int m = 0; m < 4; ++m)
#pragma unroll
      for (int j = 0; j < 4; ++j)
#pragma unroll
        for (int n = 0; n < 4; ++n) ((u16*)smem)[(wr_ * 64 + m * 16 + fq_ * 4 + j) * 136 + wc_ * 64 + n * 16 + fr_] = f2bf(acc[m][n][j]);
    tile_flush_bf16<128>(O, 1024, row0, col0, 1024);
  }
  u16* PE = (u16*)(p->ws + OFF_LIN);
  const int gt = blockIdx.x * 256 + threadIdx.x, nt = gridDim.x * 256;
  for (int i = gt; i < MR * 64; i += nt) {
    const int row = i >> 6, c4 = (i & 63) * 4;
    const float* src = row < NP ? p->in[2] + (size_t)row * 256 : p->in[3] + (size_t)(row - NP) * 256;
    const float4 v = *reinterpret_cast<const float4*>(src + c4);
    u16x4 o; o[0] = f2bf(v.x); o[1] = f2bf(v.y); o[2] = f2bf(v.z); o[3] = f2bf(v.w);
    *reinterpret_cast<u16x4*>(PE + (size_t)row * 256 + c4) = o;
  }
}
__device__ __forceinline__ void phase_gates(KP p) {
  constexpr int NRT = MR / 128;
  u16* PA = (u16*)(p->ws + OFF_DE); const u16* PB = (const u16*)p->out;
  const XTiles XT = xt_make(NRT, 16, 8);
  for (int t = XT.lb; t < XT.total; t += XT.nb) {
    int ct, rt; xt_get(XT, t, rt, ct); const int row0 = rt * 128, col0 = ct * 128;
    f32x4 acc[4][4];
    gemm_mainloop((const u16*)(p->ws + OFF_U) + (size_t)row0 * 1024, 1024, (const u16*)(p->ws + OFF_WGI) + (size_t)col0 * 1024, 1024, 1024, acc);
    EPI_COORDS
#pragma unroll
    for (int m = 0; m < 4; ++m) {
      u16 pa[4][2], pb[4][2];
#pragma unroll
      for (int j = 0; j < 4; ++j) { const size_t ob = (size_t)(row0 + wr_ * 64 + m * 16 + fq_ * 4 + j) * 1024 + (col0 + wc_ * 64) / 2 + fr_;
#pragma unroll
        for (int q = 0; q < 2; ++q) { pa[j][q] = PA[ob + q * 16]; pb[j][q] = PB[ob + q * 16]; } }
#pragma unroll
      for (int j = 0; j < 4; ++j) { const size_t ob = (size_t)(row0 + wr_ * 64 + m * 16 + fq_ * 4 + j) * 1024 + (col0 + wc_ * 64) / 2 + fr_;
#pragma unroll
        for (int q = 0; q < 2; ++q)
          PA[ob + q * 16] = f2bf(sigmoidf_(acc[m][2 * q][j]) * bf2f(pa[j][q]) + sigmoidf_(acc[m][2 * q + 1][j]) * bf2f(pb[j][q]));
      }
    }
  }
}
__device__ __forceinline__ void phase_wout(KP p) {
  constexpr int NRT = MR / 128;
  u16* HG = (u16*)(p->ws + OFF_U); float* rss = (float*)(p->ws + OFF_RSS); const float* gain = p->in[28];
  const XTiles XT = xt_make(NRT, 8, 8);
  for (int t = XT.lb; t < XT.total; t += XT.nb) {
    int ct, rt; xt_get(XT, t, rt, ct); const int row0 = rt * 128, col0 = ct * 128;
    f32x4 acc[4][4];
    gemm_mainloop((const u16*)(p->ws + OFF_DE) + (size_t)row0 * 1024, 1024, (const u16*)(p->ws + OFF_WOT) + (size_t)col0 * 1024, 1024, 1024, acc);
    EPI_COORDS
    float* outp = p->out; float g4[4];
#pragma unroll
    for (int n = 0; n < 4; ++n) g4[n] = gain[col0 + wc_ * 64 + n * 16 + fr_];
#pragma unroll
    for (int m = 0; m < 4; ++m) {
      float res[4][4];
#pragma unroll
      for (int j = 0; j < 4; ++j) { const float* xr = xrow(p, row0 + wr_ * 64 + m * 16 + fq_ * 4 + j) + col0 + wc_ * 64 + fr_;
#pragma unroll
        for (int n = 0; n < 4; ++n) res[j][n] = xr[n * 16]; }
#pragma unroll
      for (int j = 0; j < 4; ++j) {
        const int row = row0 + wr_ * 64 + m * 16 + fq_ * 4 + j; float ss = 0.f;
        const size_t ob = (size_t)row * 1024 + col0 + wc_ * 64 + fr_;
#pragma unroll
        for (int n = 0; n < 4; ++n) {
          const float hv = res[j][n] + acc[m][n][j];
          outp[ob + n * 16] = hv; HG[ob + n * 16] = f2bf(hv * g4[n]); ss += hv * hv;
        }
        ss = sum16(ss);
        if (fr_ == 0) atomicAdd(rss + row, ss);
      }
    }
  }
}
__device__ __forceinline__ void phase_ffn_up(KP p) {
  constexpr int NRT = MR / 128;
  u16* ACT = (u16*)(p->ws + OFF_ACT); const float* rss = (const float*)(p->ws + OFF_RSS);
  const XTiles XT = xt_make(NRT, 44, 22);
  for (int t = XT.lb; t < XT.total; t += XT.nb) {
    int ct, rt; xt_get(XT, t, rt, ct); const int row0 = rt * 128, col0 = ct * 128;
    f32x4 acc[4][4];
    gemm_mainloop((const u16*)(p->ws + OFF_U) + (size_t)row0 * 1024, 1024, (const u16*)(p->ws + OFF_WGU) + (size_t)col0 * 1024, 1024, 1024, acc);
    EPI_COORDS
    float rsv[4][4];
#pragma unroll
    for (int m = 0; m < 4; ++m)
#pragma unroll
      for (int j = 0; j < 4; ++j) rsv[m][j] = rss[row0 + wr_ * 64 + m * 16 + fq_ * 4 + j];
#pragma unroll
    for (int m = 0; m < 4; ++m)
#pragma unroll
      for (int j = 0; j < 4; ++j) {
        const int row = row0 + wr_ * 64 + m * 16 + fq_ * 4 + j;
        const float rs = rsqrtf(rsv[m][j] * (1.f / 1024.f) + NORM_EPS);
#pragma unroll
        for (int q = 0; q < 2; ++q)
          ((u16*)smem)[(row - row0) * 72 + wc_ * 32 + q * 16 + fr_] = f2bf(siluf_(rs * acc[m][2 * q][j]) * (rs * acc[m][2 * q + 1][j]));
      }
    tile_flush_bf16<64>(ACT, DFF, row0, col0 / 2, DFF);
  }
}
__device__ __forceinline__ void phase_ffn_down(KP p) {
  constexpr int NRT = MR / 128;
  u16* HG = (u16*)(p->ws + OFF_U); float* rss = (float*)(p->ws + OFF_RSS) + MR; const float* gain = p->in[32];
  u16* PP = (u16*)(p->ws + OFF_PP);
  const XTiles XT = xt_make(NRT, 16, 8);
  for (int t = XT.lb; t < XT.total; t += XT.nb) {
    int ct2, rt; xt_get(XT, t, rt, ct2); const int which = ct2 >> 3, ct = ct2 & 7; const int row0 = rt * 128, col0 = ct * 128;
    f32x4 acc[4][4];
    if (which == 0) {
      gemm_mainloop((const u16*)(p->ws + OFF_ACT) + (size_t)row0 * DFF, DFF, (const u16*)(p->ws + OFF_WDT) + (size_t)col0 * DFF, DFF, DFF, acc);
      EPI_COORDS
      float* outp = p->out; float g4[4];
#pragma unroll
      for (int n = 0; n < 4; ++n) g4[n] = gain[col0 + wc_ * 64 + n * 16 + fr_];
#pragma unroll
      for (int m = 0; m < 4; ++m) {
        float res[4][4];
#pragma unroll
        for (int j = 0; j < 4; ++j) { const float* hr = outp + (size_t)(row0 + wr_ * 64 + m * 16 + fq_ * 4 + j) * 1024 + col0 + wc_ * 64 + fr_;
#pragma unroll
          for (int n = 0; n < 4; ++n) res[j][n] = hr[n * 16]; }
#pragma unroll
        for (int j = 0; j < 4; ++j) {
          const int row = row0 + wr_ * 64 + m * 16 + fq_ * 4 + j; float ss = 0.f;
          const size_t ob = (size_t)row * 1024 + col0 + wc_ * 64 + fr_;
#pragma unroll
          for (int n = 0; n < 4; ++n) {
            const float hv = res[j][n] + acc[m][n][j];
            outp[ob + n * 16] = hv; HG[ob + n * 16] = f2bf(hv * g4[n]); ss += hv * hv;
          }
          ss = sum16(ss);
          if (fr_ == 0) atomicAdd(rss + row, ss);
        }
      }
    } else {
      gemm_mainloop((const u16*)(p->ws + OFF_LIN) + (size_t)row0 * 256, 256, (const u16*)(p->ws + OFF_WPP) + (size_t)col0 * 256, 256, 256, acc);
      EPI_COORDS
#pragma unroll
      for (int m = 0; m < 4; ++m)
#pragma unroll
        for (int j = 0; j < 4; ++j) {
          const int row = row0 + wr_ * 64 + m * 16 + fq_ * 4 + j;
#pragma unroll
          for (int n = 0; n < 4; ++n) PP[(size_t)row * 1024 + col0 + wc_ * 64 + n * 16 + fr_] = f2bf(acc[m][n][j]);
        }
    }
  }
}
__device__ __forceinline__ void phase_ple(KP p) {
  constexpr int NRT = MR / 128;
  const float* rss2 = (const float*)(p->ws + OFF_RSS) + MR; float* rss3 = (float*)(p->ws + OFF_RSS) + 2 * MR;
  const u16* PP = (const u16*)(p->ws + OFF_PP);
  const XTiles XT = xt_make(NRT, 8, 8);
  for (int t = XT.lb; t < XT.total; t += XT.nb) {
    int ct, rt; xt_get(XT, t, rt, ct); const int row0 = rt * 128, col0 = ct * 128;
    f32x4 acc[4][4];
    gemm_mainloop((const u16*)(p->ws + OFF_U) + (size_t)row0 * 1024, 1024, (const u16*)(p->ws + OFF_WPG) + (size_t)col0 * 1024, 1024, 1024, acc);
    EPI_COORDS
    float* outp = p->out;
#pragma unroll
    for (int m = 0; m < 4; ++m) {
      float res[4][4]; u16 pp[4][4]; float rsv[4];
#pragma unroll
      for (int j = 0; j < 4; ++j) { const size_t ob = (size_t)(row0 + wr_ * 64 + m * 16 + fq_ * 4 + j) * 1024 + col0 + wc_ * 64 + fr_;
        rsv[j] = rss2[row0 + wr_ * 64 + m * 16 + fq_ * 4 + j];
#pragma unroll
        for (int n = 0; n < 4; ++n) { res[j][n] = outp[ob + n * 16]; pp[j][n] = PP[ob + n * 16]; } }
#pragma unroll
      for (int j = 0; j < 4; ++j) {
        const int row = row0 + wr_ * 64 + m * 16 + fq_ * 4 + j; float ss = 0.f;
        const float rs = rsqrtf(rsv[j] * (1.f / 1024.f) + NORM_EPS);
        const size_t ob = (size_t)row * 1024 + col0 + wc_ * 64 + fr_;
#pragma unroll
        for (int n = 0; n < 4; ++n) {
          const float hv = res[j][n] + sigmoidf_(rs * acc[m][n][j]) * bf2f(pp[j][n]);
          outp[ob + n * 16] = hv; ss += hv * hv;
        }
        ss = sum16(ss);
        if (fr_ == 0) atomicAdd(rss3 + row, ss);
      }
    }
  }
}
__device__ __forceinline__ void phase_final(KP p) {
  const float* rss3 = (const float*)(p->ws + OFF_RSS) + 2 * MR; const float* gain = p->in[35];
  const int gt = blockIdx.x * 256 + threadIdx.x, nt = gridDim.x * 256;
  for (int i = gt; i < MR * 256; i += nt) {
    const int row = i >> 8, c4 = (i & 255) * 4;
    const float rs = rsqrtf(rss3[row] * (1.f / 1024.f) + NORM_EPS);
    float4 v = *reinterpret_cast<float4*>(p->out + (size_t)row * 1024 + c4);
    const float4 g = *reinterpret_cast<const float4*>(gain + c4);
    v.x *= rs * g.x; v.y *= rs * g.y; v.z *= rs * g.z; v.w *= rs * g.w;
#ifdef PROBE_TS
    { const unsigned long long* ts = (const unsigned long long*)(p->ws + OFF_BAR + 14336);
      float d1 = 0.f, d2 = 0.f;
      PROBE_D1; PROBE_D2;
      if (row >= NP) { const float sc = 1.f + d1 * 1e-5f; v.x *= sc; v.y *= sc; v.z *= sc; v.w *= sc; }
      if (i == 0) v.x += d2 * 0.01f; }
#endif
    *reinterpret_cast<float4*>(p->out + (size_t)row * 1024 + c4) = v;
  }
}


#define XB_TMO      128
#define XB_XCNT(j)  (256  + 64 * (j))
#define XB_XSUB(j)  (1280 + 64 * (j))
#define XB_XGEN(j)  (2304 + 64 * (j))
#define XB_TOP      3328
#define XB_TOPGEN   3392
#define XCD_BAR_WORDS 3456
#define XB_SPIN_CAP (1u << 22)
#define LAS __attribute__((address_space(3)))
__device__ __forceinline__ unsigned xb_ld(unsigned* p) { return __hip_atomic_load(p, __ATOMIC_RELAXED, __HIP_MEMORY_SCOPE_AGENT); }
__device__ __forceinline__ unsigned xb_add(unsigned* p, unsigned v) { return __hip_atomic_fetch_add(p, v, __ATOMIC_RELAXED, __HIP_MEMORY_SCOPE_AGENT); }
__device__ __forceinline__ unsigned xb_xcc_id() { return (unsigned)__builtin_amdgcn_s_getreg((3 << 11) | 20) & 0xFu; }
#define XB_SPIN(cond, bar) do { unsigned _sp = 0; while (cond) { __builtin_amdgcn_s_sleep(1); \
    if ((++_sp & 255u) == 0u) { if (xb_ld(&(bar)[XB_TMO])) break; if (_sp > XB_SPIN_CAP) { atomicAdd(&(bar)[XB_TMO], 1u); break; } } } } while (0)
struct XcdBarrier { unsigned* bar; unsigned x; volatile LAS unsigned* st; };
__device__ __forceinline__ XcdBarrier xcd_barrier_post(unsigned* bar, volatile LAS unsigned* st) {
  XcdBarrier b; b.bar = bar; b.x = xb_xcc_id(); b.st = st;
  if (threadIdx.x == 0) (void)xb_add(&bar[XB_XCNT(b.x)], 1u);
  return b;
}
__device__ __forceinline__ void xcd_barrier_complete(unsigned* bar, unsigned x, unsigned& nloc, unsigned& nx) {
  const unsigned G = gridDim.x * gridDim.y * gridDim.z;
  unsigned sum, cnt, mine, sp = 0u;
  for (;;) {
    sum = 0u; cnt = 0u; mine = 0u;
#pragma unroll
    for (unsigned j = 0; j < 16; ++j) { const unsigned c = xb_ld(&bar[XB_XCNT(j)]); sum += c; cnt += (c > 0u) ? 1u : 0u; mine = (j == x) ? c : mine; }
    if (sum == G) break;
    __builtin_amdgcn_s_sleep(1);
    if ((++sp & 255u) == 0u) { if (xb_ld(&bar[XB_TMO])) break; if (sp > XB_SPIN_CAP) { atomicAdd(&bar[XB_TMO], 1u); break; } }
  }
  nloc = mine > 0u ? mine : 1u; nx = cnt > 0u ? cnt : 1u;
}
__device__ __forceinline__ void xcd_barrier(const XcdBarrier& b) {
  asm volatile("s_waitcnt vmcnt(0)" ::: "memory");
  __syncthreads();
  if (threadIdx.x == 0) {
    unsigned* bar = b.bar;
    __builtin_amdgcn_s_waitcnt(0);
    unsigned nloc = b.st[0], nx = b.st[1];
    if (nloc == 0u) { xcd_barrier_complete(bar, b.x, nloc, nx); b.st[0] = nloc; b.st[1] = nx; }
    const unsigned old = xb_add(&bar[XB_XSUB(b.x)], 1u);
    const unsigned gen = old / nloc;
    if (old + 1u == (gen + 1u) * nloc) {
      __builtin_amdgcn_fence(__ATOMIC_RELEASE, "agent");
      asm volatile("s_waitcnt vmcnt(0)" ::: "memory");
      const unsigned og = xb_add(&bar[XB_TOP], 1u);
      const unsigned tg = og / nx;
      if (og + 1u == (tg + 1u) * nx) xb_add(&bar[XB_TOPGEN], 1u);
      else XB_SPIN(xb_ld(&bar[XB_TOPGEN]) == tg, bar);
      __builtin_amdgcn_fence(__ATOMIC_ACQUIRE, "agent");
      xb_add(&bar[XB_XGEN(b.x)], 1u);
      asm volatile("s_waitcnt vmcnt(0)" ::: "memory");
    } else {
      XB_SPIN(xb_ld(&bar[XB_XGEN(b.x)]) == gen, bar);
      __builtin_amdgcn_fence(__ATOMIC_ACQUIRE, "agent");
      asm volatile("s_waitcnt vmcnt(0)" ::: "memory");
    }
  }
  __syncthreads();
}

#ifdef PROBE_TS
#define TS(k) do { if (blockIdx.x == 0 && threadIdx.x == 0) ((unsigned long long*)(p->ws + OFF_BAR + 14336))[k] = __builtin_amdgcn_s_memrealtime(); } while (0)
#else
#define TS(k) do { } while (0)
#endif
__global__ void __launch_bounds__(256, 2) hybrid_fwd(Params pv) {
  KP p = (KP)__builtin_amdgcn_kernarg_segment_ptr();
  cg::grid_group grid = cg::this_grid();
  volatile LAS unsigned* xst = (volatile LAS unsigned*)(smem + LDS_BYTES - 16);
  if (threadIdx.x == 0) { xst[0] = 0u; xst[1] = 0u; }
  __syncthreads();
  const XcdBarrier xb = xcd_barrier_post((unsigned*)(p->ws + OFF_BAR), xst);
  TS(0);
  phase_prep(p);
  if (p->ws == nullptr) grid.sync();
  xcd_barrier(xb); TS(1);
  phase_proj(p);
  xcd_barrier(xb); TS(2);
  phase_lora_in(p);
  xcd_barrier(xb); TS(3);
  phase_lora(p);
  xcd_barrier(xb); TS(4);
  {
    const int G = gridDim.x, bid = blockIdx.x;
    unsigned char* recs = (unsigned char*)p->out;
#pragma unroll 1
    for (int seg = 0; seg < 4; ++seg) {
      int sg = seg; asm volatile("" : "+s"(sg));
#ifndef PROBE_PREP_N
#define PROBE_PREP_N 1
#endif
#ifndef PROBE_SCAN_N
#define PROBE_SCAN_N 1
#endif
      int nprep = PROBE_PREP_N, nscan = PROBE_SCAN_N;
      if (PROBE_PREP_N > 1) asm volatile("" : "+s"(nprep));
      if (PROBE_SCAN_N > 1) asm volatile("" : "+s"(nscan));
      for (int rep = 0; rep < nprep; ++rep)
      for (int it = bid; it < 1024 + 256; it += G) {
        if (it < 1024) rwkv_prep_item(p, it >> 4, sg * 16 + (it & 15), recs + (size_t)it * RW_REC);
        else gdn_prep_item(p, ((it - 1024) >> 3) * 32 + sg * 8 + ((it - 1024) & 7));
      }
      xcd_barrier(xb); TS(5 + 2 * seg);
      for (int rep = 0; rep < nscan; ++rep) {
        const bool dry = rep + 1 < nscan;
#ifndef PROBE_SCAN_MASK
#define PROBE_SCAN_MASK 3
#endif
        if (bid < 64) { if (!dry || (PROBE_SCAN_MASK & 1)) rwkv_scan_seg(p, bid, sg, recs, dry); }
        else if (bid < 96) { if (!dry || (PROBE_SCAN_MASK & 2)) gdn_scan_chain(p, (bid - 64) >> 2, (bid - 64) & 3, sg, dry); }
        if (dry) xcd_barrier(xb);
      }
      if (bid < 96) { }
      else if (seg == 0) {
        for (int it = bid - 96; it < 1024; it += G - 96) rwkv_chain<true>(p, 8 + (it >> 3), it & 7, false);
        for (int it = (G - 1 - bid); it < 512; it += G - 96) gdn_sample_item(p, it >> 2, it & 3, false);
      }
      if (seg < 3) { xcd_barrier(xb); TS(6 + 2 * seg); }
    }
  }
  xcd_barrier(xb); TS(12);
  phase_gdn_out(p);
  xcd_barrier(xb);
  phase_branches(p);
  xcd_barrier(xb); TS(13);
  phase_gates(p);
  xcd_barrier(xb); TS(14);
  phase_wout(p);
  xcd_barrier(xb); TS(15);
  phase_ffn_up(p);
  xcd_barrier(xb); TS(16);
  phase_ffn_down(p);
  xcd_barrier(xb); TS(17);
  phase_ple(p);
  xcd_barrier(xb); TS(18);
  phase_final(p);
}

extern "C" void kernel_launch(void* const* d_in, const int* in_sizes, int n_in, void* d_out, int out_size, void* d_ws, size_t ws_size,
                              hipStream_t stream) {
  static int grid_blocks = 0;
  if (!grid_blocks) {
    int dev = 0, cus = 0, per_cu = 0;
    hipGetDevice(&dev);
    hipDeviceGetAttribute(&cus, hipDeviceAttributeMultiprocessorCount, dev);
    hipFuncSetAttribute((const void*)hybrid_fwd, hipFuncAttributeMaxDynamicSharedMemorySize, LDS_BYTES);
    hipOccupancyMaxActiveBlocksPerMultiprocessor(&per_cu, (const void*)hybrid_fwd, 256, LDS_BYTES);
    if (per_cu > 2) per_cu = 2;
    if (per_cu < 1) per_cu = 1;
    grid_blocks = cus * per_cu;
  }
  Params p{};
  for (int i = 0; i < 36; ++i) p.in[i] = (const float*)d_in[i];
  p.out = (float*)d_out; p.ws = (unsigned char*)d_ws;
  (void)hipMemsetAsync((unsigned char*)d_ws + OFF_BAR, 0, 16384, stream);
  void* args[] = {&p};
  hipError_t e = hipLaunchCooperativeKernel((const void*)hybrid_fwd, dim3(grid_blocks), dim3(256), args, LDS_BYTES, stream);
  if (e != hipSuccess) fprintf(stderr, "cooperative launch failed: %s (grid %d)\n", hipGetErrorString(e), grid_blocks);
}
```
